# Optimizing an MI355X kernel written in HIP

```python
import math
import jax, jax.numpy as jnp
from jax import lax
import numpy as np

D_MODEL = 1024
BATCH = 8
SEQ = 4096
DEPTH = 2

N_META = 16
MIX_WIDTH = D_MODEL
ATTN_WIDTH = MIX_WIDTH // 2
HGRN_WIDTH = MIX_WIDTH - ATTN_WIDTH
ATTN_HEADS = 8
ATTN_HEAD_DIM = ATTN_WIDTH // ATTN_HEADS
KV_RANK = 128
IDX_HEADS = 4
IDX_DIM = 64
TOPK_MAX = 256
Q_BLOCK = 128
HGRN_EXPAND = 128
HGRN_HEADS = HGRN_WIDTH // HGRN_EXPAND
HGRN_CHUNK = 64
REL_BUCKETS = 32
REL_MAX_DIST = 128
DN_ALPHA = (2 * DEPTH) ** 0.25
DN_BETA = (8 * DEPTH) ** -0.25
EPS = 1e-6

IN_SIZES = (ATTN_WIDTH, KV_RANK, IDX_HEADS * IDX_DIM, IDX_DIM, IDX_HEADS, ATTN_WIDTH,
            HGRN_WIDTH, HGRN_WIDTH, HGRN_WIDTH, HGRN_WIDTH)
N_IN = sum(IN_SIZES)
IN_OFFSETS = tuple(int(v) for v in np.cumsum(IN_SIZES)[:-1])

kernel_name = "hymba_dsa_hgrn2_deepnorm"


def layer_norm(x, g, b):
    xf = x.astype(jnp.float32)
    mu = jnp.mean(xf, axis=-1, keepdims=True)
    var = jnp.mean(jnp.square(xf - mu), axis=-1, keepdims=True)
    return ((xf - mu) * lax.rsqrt(var + EPS) * g + b).astype(x.dtype)


def rms_norm(x, g):
    xf = x.astype(jnp.float32)
    return (xf * lax.rsqrt(jnp.mean(jnp.square(xf), axis=-1, keepdims=True) + EPS) * g).astype(x.dtype)


def t5_bucket(dist):
    n = jnp.maximum(dist, 0)
    max_exact = REL_BUCKETS // 2
    nf = jnp.maximum(n, 1).astype(jnp.float32)
    large = max_exact + (jnp.log(nf / max_exact) / math.log(REL_MAX_DIST / max_exact)
                         * (REL_BUCKETS - max_exact)).astype(jnp.int32)
    large = jnp.minimum(large, REL_BUCKETS - 1)
    return jnp.where(n < max_exact, n, large)


def dsa_attention(q, c, qi, ki, wi, rel_bias, w_uk, w_uv):
    B, E = c.shape[0], c.shape[1]
    S = E - N_META
    k_top = min(TOPK_MAX, S // 4)
    scale = ATTN_HEAD_DIM ** -0.5
    q_lat = jnp.einsum('bthd,hdc->bthc', q, w_uk)
    c_m, c_r = c[:, :N_META], c[:, N_META:]
    ql_m, ql_r = q_lat[:, :N_META], q_lat[:, N_META:]
    qi_r, ki_r = qi[:, N_META:], ki[:, N_META:]
    wi_r = wi[:, N_META:] * (IDX_HEADS ** -0.5)
    meta_pos = jnp.arange(N_META)
    key_pos = jnp.arange(S)
    b_idx = jnp.arange(B)[:, None, None]

    lg = jnp.einsum('bqhc,bmc->bqhm', ql_m, c_m).astype(jnp.float32) * scale
    bm = rel_bias[t5_bucket(meta_pos[:, None] - meta_pos[None, :])]
    lg = lg + jnp.transpose(bm, (0, 2, 1))[None].astype(jnp.float32)
    lg = jnp.where((meta_pos[:, None] >= meta_pos[None, :])[None, :, None, :], lg, -jnp.inf)
    o_m = jnp.einsum('bqhm,bmc->bqhc', jax.nn.softmax(lg, axis=-1).astype(c.dtype), c_m)

    def block(bi):
        start = bi * Q_BLOCK
        q_pos = start + jnp.arange(Q_BLOCK)
        ql = lax.dynamic_slice_in_dim(ql_r, start, Q_BLOCK, axis=1)
        qib = lax.dynamic_slice_in_dim(qi_r, start, Q_BLOCK, axis=1)
        wib = lax.dynamic_slice_in_dim(wi_r, start, Q_BLOCK, axis=1)
        s_h = jax.nn.relu(jnp.einsum('bqhd,bkd->bqhk', qib, ki_r).astype(jnp.float32) * (IDX_DIM ** -0.5))
        s_idx = jnp.einsum('bqhk,bqh->bqk', s_h, wib.astype(jnp.float32))
        causal = key_pos[None, :] <= q_pos[:, None]
        s_idx = jnp.where(causal[None], s_idx, -jnp.inf)
        _, sel = lax.top_k(s_idx, k_top)
        valid = sel <= q_pos[None, :, None]
        c_sel = c_r[b_idx, sel]
        lg_s = jnp.einsum('bqhc,bqkc->bqhk', ql, c_sel).astype(jnp.float32) * scale
        bs = rel_bias[t5_bucket(q_pos[None, :, None] - sel)]
        lg_s = lg_s + jnp.moveaxis(bs, -1, 2).astype(jnp.float32)
        lg_s = jnp.where(valid[:, :, None, :], lg_s, -jnp.inf)
        lg_m = jnp.einsum('bqhc,bmc->bqhm', ql, c_m).astype(jnp.float32) * scale
        bmr = rel_bias[t5_bucket(N_META + q_pos[:, None] - meta_pos[None, :])]
        lg_m = lg_m + jnp.transpose(bmr, (0, 2, 1))[None].astype(jnp.float32)
        p = jax.nn.softmax(jnp.concatenate([lg_m, lg_s], axis=-1), axis=-1).astype(c.dtype)
        return (jnp.einsum('bqhm,bmc->bqhc', p[..., :N_META], c_m)
                + jnp.einsum('bqhk,bqkc->bqhc', p[..., N_META:], c_sel))

    o_r = lax.map(block, jnp.arange(S // Q_BLOCK))
    o_r = jnp.moveaxis(o_r, 0, 1).reshape(B, S, ATTN_HEADS, KV_RANK)
    o_lat = jnp.concatenate([o_m, o_r], axis=1)
    return jnp.einsum('bthc,hcd->bthd', o_lat, w_uv).reshape(B, E, ATTN_WIDTH)


def hgrn2(q, f_raw, i, lb):
    B, E = q.shape[0], q.shape[1]
    dt = q.dtype
    qf = jax.nn.silu(q.astype(jnp.float32)) * (HGRN_EXPAND ** -0.5)
    f = lb + (1.0 - lb) * jax.nn.sigmoid(f_raw.astype(jnp.float32))
    g = jnp.log(f)
    k = 1.0 - f
    v = i.astype(jnp.float32)
    pad = HGRN_CHUNK - N_META

    def to_chunks(a):
        a = jnp.pad(a, ((0, 0), (pad, 0), (0, 0)))
        n = a.shape[1] // HGRN_CHUNK
        return a.reshape(B, n, HGRN_CHUNK, HGRN_HEADS, HGRN_EXPAND).transpose(1, 0, 3, 2, 4)

    tri = jnp.tril(jnp.ones((HGRN_CHUNK, HGRN_CHUNK), dtype=bool))

    def step(state, inp):
        qc, kc, vc, gc = inp
        bcum = jnp.cumsum(gc, axis=2)
        o_inter = jnp.einsum('bhtk,bhkv->bhtv', qc * jnp.exp(bcum), state)
        diff = bcum[:, :, :, None, :] - bcum[:, :, None, :, :]
        decay = jnp.exp(jnp.where(tri[:, :, None], diff, -jnp.inf))
        scores = jnp.sum(qc[:, :, :, None, :] * decay * kc[:, :, None, :, :], axis=-1)
        o_intra = jnp.einsum('bhts,bhsv->bhtv', scores, vc)
        b_last = bcum[:, :, -1:, :]
        new_state = (jnp.exp(b_last[:, :, 0, :])[..., None] * state
                     + jnp.einsum('bhsk,bhsv->bhkv', kc * jnp.exp(b_last - bcum), vc))
        return new_state, o_inter + o_intra

    s0 = jnp.zeros((B, HGRN_HEADS, HGRN_EXPAND, HGRN_EXPAND), jnp.float32)
    _, outs = lax.scan(step, s0, (to_chunks(qf), to_chunks(k), to_chunks(v), to_chunks(g)))
    n = outs.shape[0]
    o = outs.transpose(1, 0, 3, 2, 4).reshape(B, n * HGRN_CHUNK, HGRN_HEADS, HGRN_EXPAND)[:, pad:]
    return o.astype(dt)


def setup_inputs(seed: int = 0) -> dict:
    key = jax.random.key(seed)
    ks = jax.random.split(key, 12)
    nrm = jax.random.normal
    x = nrm(ks[0], (BATCH, SEQ, D_MODEL), jnp.float32)
    meta_tokens = nrm(ks[1], (N_META, D_MODEL), jnp.float32)
    rel_bias = 0.5 * nrm(ks[2], (REL_BUCKETS, ATTN_HEADS), jnp.float32)
    hgrn_lb_raw = nrm(ks[3], (DEPTH, HGRN_WIDTH), jnp.float32)
    w_in = nrm(ks[4], (DEPTH, D_MODEL, N_IN), jnp.float32) * D_MODEL ** -0.5
    kv_norm_g = 1.0 + 0.1 * nrm(ks[5], (DEPTH, KV_RANK), jnp.float32)
    w_uk = nrm(ks[6], (DEPTH, ATTN_HEADS, ATTN_HEAD_DIM, KV_RANK), jnp.float32) * ATTN_HEAD_DIM ** -0.5
    w_uv = nrm(ks[7], (DEPTH, ATTN_HEADS, KV_RANK, ATTN_HEAD_DIM), jnp.float32) * (KV_RANK ** -0.5 * DN_BETA)
    hgrn_norm_g = 1.0 + 0.1 * nrm(ks[8], (DEPTH, HGRN_EXPAND), jnp.float32)
    w_out = nrm(ks[9], (DEPTH, MIX_WIDTH, D_MODEL), jnp.float32) * (MIX_WIDTH ** -0.5 * DN_BETA)
    ln_g = 1.0 + 0.1 * nrm(ks[10], (DEPTH, D_MODEL), jnp.float32)
    ln_b = 0.02 * nrm(ks[11], (DEPTH, D_MODEL), jnp.float32)
    return {"x": x, "meta_tokens": meta_tokens, "rel_bias": rel_bias, "hgrn_lb_raw": hgrn_lb_raw,
            "w_in": w_in, "kv_norm_g": kv_norm_g, "w_uk": w_uk, "w_uv": w_uv,
            "hgrn_norm_g": hgrn_norm_g, "w_out": w_out, "ln_g": ln_g, "ln_b": ln_b}


def reference(x, meta_tokens, rel_bias, hgrn_lb_raw, w_in, kv_norm_g, w_uk, w_uv,
              hgrn_norm_g, w_out, ln_g, ln_b):
    B = x.shape[0]
    h = jnp.concatenate([jnp.broadcast_to(meta_tokens[None].astype(x.dtype), (B, N_META, D_MODEL)), x], axis=1)
    E = h.shape[1]
    lb_p = jax.nn.softmax(hgrn_lb_raw.astype(jnp.float32), axis=0)
    lb_all = jnp.cumsum(lb_p, axis=0) - lb_p[0:1]
    for l in range(DEPTH):
        proj = h @ w_in[l]
        (q_a, c_kv, q_idx, k_idx, w_idx, gate_a,
         q_h, f_h, i_h, gate_h) = jnp.split(proj, IN_OFFSETS, axis=-1)
        a = dsa_attention(q_a.reshape(B, E, ATTN_HEADS, ATTN_HEAD_DIM), rms_norm(c_kv, kv_norm_g[l]),
                          q_idx.reshape(B, E, IDX_HEADS, IDX_DIM), k_idx, w_idx,
                          rel_bias, w_uk[l], w_uv[l])
        a = a * jax.nn.silu(gate_a)
        r = hgrn2(q_h, f_h, i_h, lb_all[l])
        r = rms_norm(r, hgrn_norm_g[l]).reshape(B, E, HGRN_WIDTH) * jax.nn.silu(gate_h)
        y = jnp.concatenate([a, r], axis=-1) @ w_out[l]
        h = layer_norm(DN_ALPHA * h + y, ln_g[l], ln_b[l])
    return h[:, N_META:]
```

```cpp
#include <hip/hip_runtime.h>
#include <hip/hip_cooperative_groups.h>
#include <stdint.h>

namespace {
typedef unsigned short bf16_t;
constexpr int D = 1024, NB = 8, S = 4096, NM = 16, NIN = 3524, DEPTH = 2;
constexpr int R = NB * S;
constexpr int O_QA = 0, O_CKV = 512, O_QI = 640, O_KI = 896, O_WI = 960, O_GA = 964, O_QH = 1476, O_FH = 1988, O_IH = 2500, O_GH = 3012;
constexpr int TOPK = 256;
constexpr float EPS = 1e-6f;
constexpr float DN_ALPHA = 1.4142135623730951f;

__constant__ unsigned char c_bucket[128] = {
  0, 1, 2, 3, 4, 5, 6, 7, 8, 9, 10, 11, 12, 13, 14, 15, 16, 16, 16, 17, 17, 18, 18, 18, 19, 19, 19, 20, 20, 20, 20, 21,
  21, 21, 21, 22, 22, 22, 22, 22, 23, 23, 23, 23, 23, 23, 24, 24, 24, 24, 24, 24, 25, 25, 25, 25, 25, 25, 25, 26, 26, 26, 26, 26,
  26, 26, 26, 27, 27, 27, 27, 27, 27, 27, 27, 27, 27, 28, 28, 28, 28, 28, 28, 28, 28, 28, 28, 29, 29, 29, 29, 29, 29, 29, 29, 29,
  29, 29, 29, 30, 30, 30, 30, 30, 30, 30, 30, 30, 30, 30, 30, 30, 30, 31, 31, 31, 31, 31, 31, 31, 31, 31, 31, 31, 31, 31, 31, 31};

__device__ __forceinline__ int t5_bucket(int dist) { int n = dist < 0 ? 0 : dist; return n >= 128 ? 31 : (int)c_bucket[n]; }
__device__ __forceinline__ float sigmoidf_(float x) { return 1.0f / (1.0f + expf(-x)); }
__device__ __forceinline__ float siluf_(float x) { return x / (1.0f + expf(-x)); }
__device__ __forceinline__ bf16_t f2bf(float f) { unsigned u = __float_as_uint(f); u += 0x7fffu + ((u >> 16) & 1u); return (bf16_t)(u >> 16); }
__device__ __forceinline__ float bf2f(bf16_t h) { return __uint_as_float(((unsigned)h) << 16); }

struct Params {
  const float *x, *meta, *rel_bias, *lbraw, *w_in, *kvg, *w_uk, *w_uv, *hng, *w_out, *ln_g, *ln_b;
  float* out;
  float *hF, *hFm;
  bf16_t *hHi, *hHim, *hLo, *hLom;
  bf16_t *qa, *qam;
  bf16_t *cN, *cNm;
  bf16_t *gates, *gatesm;
  bf16_t *qf, *qfm;
  float *gl, *glm;
  bf16_t *vv, *vvm;
  bf16_t *qiH, *qiL;
  bf16_t *kiH, *kiL;
  float* wi;
  int* sel; int* nsel;
  float* proj;
  float* ych;
  bf16_t* WmT;
  bf16_t* WsT;
  bf16_t* WoT;
  float* lbv;
  float* stats;
  float* statsm;
  float* vm;
  bf16_t* wukT;
  bf16_t* wuvT;
};

template <typename TA>
__global__ __launch_bounds__(256) void k_sgemm(const TA* __restrict__ A, int lda, const float* __restrict__ Bm, int ldb,
                                               float* __restrict__ C, int ldc, int M, int N, int K) {
  __shared__ float As[16][64 + 4];
  __shared__ float Bs[16][64 + 4];
  const int tx = threadIdx.x & 15, ty = threadIdx.x >> 4;
  const int m0 = blockIdx.y * 64, n0 = blockIdx.x * 64;
  float acc[4][4] = {};
  for (int k0 = 0; k0 < K; k0 += 16) {
    for (int i = threadIdx.x; i < 64 * 16; i += 256) {
      int r = i >> 4, c = i & 15; int gm = m0 + r;
      float v = 0.f;
      if (gm < M) { if constexpr (sizeof(TA) == 2) v = bf2f(A[(size_t)gm * lda + k0 + c]); else v = A[(size_t)gm * lda + k0 + c]; }
      As[c][r] = v;
    }
    for (int i = threadIdx.x; i < 16 * 64; i += 256) {
      int r = i >> 6, c = i & 63; int gn = n0 + c;
      Bs[r][c] = gn < N ? Bm[(size_t)(k0 + r) * ldb + gn] : 0.f;
    }
    __syncthreads();
#pragma unroll
    for (int kk = 0; kk < 16; ++kk) {
      float a[4], b[4];
#pragma unroll
      for (int i = 0; i < 4; ++i) a[i] = As[kk][ty * 4 + i];
#pragma unroll
      for (int j = 0; j < 4; ++j) b[j] = Bs[kk][tx * 4 + j];
#pragma unroll
      for (int i = 0; i < 4; ++i)
#pragma unroll
        for (int j = 0; j < 4; ++j) acc[i][j] = fmaf(a[i], b[j], acc[i][j]);
    }
    __syncthreads();
  }
#pragma unroll
  for (int i = 0; i < 4; ++i) {
    int gm = m0 + ty * 4 + i; if (gm >= M) continue;
#pragma unroll
    for (int j = 0; j < 4; ++j) { int gn = n0 + tx * 4 + j; if (gn < N) C[(size_t)gm * ldc + gn] = acc[i][j]; }
  }
}

__global__ __launch_bounds__(256) void k_epi(Params p, int layer, int row0, int is_meta) {
  const int lr = blockIdx.x, tid = threadIdx.x;
  const float* pr = p.proj + (size_t)lr * NIN;
  const size_t r = (size_t)row0 + lr;
  bf16_t* qa = (is_meta ? p.qam : p.qa) + r * 512;
  bf16_t* cN = (is_meta ? p.cNm : p.cN) + r * 128;
  bf16_t* gates = (is_meta ? p.gatesm : p.gates) + r * 1024;
  bf16_t* qf = (is_meta ? p.qfm : p.qf) + r * 512;
  float* gl = (is_meta ? p.glm : p.gl) + r * 512;
  bf16_t* vv = (is_meta ? p.vvm : p.vv) + r * 512;
  __shared__ float red[256];
  for (int c = tid; c < 512; c += 256) {
    qa[c] = f2bf(pr[O_QA + c]);
    gates[c] = f2bf(siluf_(pr[O_GA + c]));
    gates[512 + c] = f2bf(siluf_(pr[O_GH + c]));
    qf[c] = f2bf(siluf_(pr[O_QH + c]) * 0.08838834764831845f);
    vv[c] = f2bf(pr[O_IH + c]);
    int hk = c;
    float lb = 0.f;
    if (layer == 1) { float r0 = p.lbraw[hk], r1 = p.lbraw[512 + hk]; float m = fmaxf(r0, r1); float e0 = expf(r0 - m), e1 = expf(r1 - m); lb = e1 / (e0 + e1); }
    float f = lb + (1.0f - lb) * sigmoidf_(pr[O_FH + c]);
    gl[c] = logf(f);
  }
  float v = tid < 128 ? pr[O_CKV + tid] : 0.f;
  red[tid] = v * v; __syncthreads();
  for (int s = 128; s > 0; s >>= 1) { if (tid < s) red[tid] += red[tid + s]; __syncthreads(); }
  float rstd = rsqrtf(red[0] / 128.f + EPS);
  if (tid < 128) cN[tid] = f2bf(v * rstd * p.kvg[layer * 128 + tid]);
  if (!is_meta) {
    { float q = pr[O_QI + tid] * 0.125f; bf16_t h = f2bf(q); p.qiH[r * 256 + tid] = h; p.qiL[r * 256 + tid] = f2bf(q - bf2f(h)); }
    if (tid < 64) { float k = pr[O_KI + tid]; bf16_t h = f2bf(k); p.kiH[r * 64 + tid] = h; p.kiL[r * 64 + tid] = f2bf(k - bf2f(h)); }
    if (tid < 4) p.wi[r * 4 + tid] = pr[O_WI + tid] * 0.5f;
  }
}

__device__ __forceinline__ unsigned f2key(float f) { unsigned u = __float_as_uint(f); return (u & 0x80000000u) ? ~u : (u | 0x80000000u); }

__global__ __launch_bounds__(256) void k_topk(Params p) {
  const int gq = blockIdx.x, b = gq / S, t = gq % S, tid = threadIdx.x;
  const int n = t + 1;
  int* sel = p.sel + (size_t)gq * TOPK;
  if (n <= TOPK) {
    for (int i = tid; i < TOPK; i += 256) sel[i] = i < n ? i : 0;
    if (tid == 0) p.nsel[gq] = n;
    return;
  }
  __shared__ float q[256];
  __shared__ float w[4];
  __shared__ unsigned keys[S];
  __shared__ unsigned hist[256];
  __shared__ unsigned s_prefix, s_need;
  __shared__ unsigned cg[256], ce[256];
  q[tid] = bf2f(p.qiH[(size_t)gq * 256 + tid]) + bf2f(p.qiL[(size_t)gq * 256 + tid]);
  if (tid < 4) w[tid] = p.wi[(size_t)gq * 4 + tid];
  __syncthreads();
  for (int s = tid; s < n; s += 256) {
    const bf16_t* kh = p.kiH + ((size_t)b * S + s) * 64;
    const bf16_t* kl = p.kiL + ((size_t)b * S + s) * 64;
    float sc = 0.f;
#pragma unroll 1
    for (int h = 0; h < 4; ++h) {
      float d = 0.f;
#pragma unroll 8
      for (int j = 0; j < 64; ++j) d = fmaf(q[h * 64 + j], bf2f(kh[j]) + bf2f(kl[j]), d);
      sc = fmaf(w[h], fmaxf(d, 0.f), sc);
    }
    keys[s] = f2key(sc);
  }
  if (tid == 0) { s_prefix = 0; s_need = TOPK; }
  __syncthreads();
  for (int d = 3; d >= 0; --d) {
    hist[tid] = 0; __syncthreads();
    unsigned prefix = s_prefix;
    for (int s = tid; s < n; s += 256) {
      unsigned k = keys[s];
      bool match = (d == 3) ? true : ((k >> (8 * (d + 1))) == prefix);
      if (match) atomicAdd(&hist[(k >> (8 * d)) & 255u], 1u);
    }
    __syncthreads();
    if (tid == 0) {
      unsigned need = s_need, cum = 0; int bin = 255;
      for (; bin > 0; --bin) { if (cum + hist[bin] >= need) break; cum += hist[bin]; }
      s_prefix = (prefix << 8) | (unsigned)bin; s_need = need - cum;
    }
    __syncthreads();
  }
  const unsigned T = s_prefix, need = s_need;
  const int per = (n + 255) / 256;
  const int s0 = tid * per, s1 = min(n, s0 + per);
  unsigned ng = 0, ne = 0;
  for (int s = s0; s < s1; ++s) { unsigned k = keys[s]; ng += k > T; ne += k == T; }
  cg[tid] = ng; ce[tid] = ne; __syncthreads();
  if (tid == 0) { unsigned a = 0, bb = 0; for (int i = 0; i < 256; ++i) { unsigned xx = cg[i], yy = ce[i]; cg[i] = a; ce[i] = bb; a += xx; bb += yy; } }
  __syncthreads();
  unsigned og = cg[tid], oe = ce[tid];
  const unsigned ngt = TOPK - need;
  for (int s = s0; s < s1; ++s) {
    unsigned k = keys[s];
    if (k > T) sel[og++] = s;
    else if (k == T) { if (oe < need) sel[ngt + oe] = s; oe++; }
  }
  if (tid == 0) p.nsel[gq] = TOPK;
}

__global__ __launch_bounds__(256) void k_attn(Params p, int layer) {
  const int tid = threadIdx.x;
  const bool is_meta = blockIdx.x >= R;
  const int gq = is_meta ? (int)blockIdx.x - R : (int)blockIdx.x;
  const int b = is_meta ? 0 : gq / S, t = is_meta ? gq : gq % S;
  const int e = is_meta ? gq : NM + t;
  __shared__ float qa[512];
  __shared__ float ql[8 * 128];
  __shared__ int kidx[NM + TOPK];
  __shared__ float lg[8][NM + TOPK];
  __shared__ float ol[8 * 128];
  __shared__ float red[8];
  const bf16_t* qrow = (is_meta ? p.qam : p.qa) + (size_t)gq * 512;
  qa[tid] = bf2f(qrow[tid]); qa[tid + 256] = bf2f(qrow[tid + 256]);
  int nk;
  if (is_meta) { nk = gq + 1; for (int i = tid; i < nk; i += 256) kidx[i] = -1 - i; }
  else {
    int ns = p.nsel[gq]; nk = NM + ns;
    for (int i = tid; i < nk; i += 256) kidx[i] = i < NM ? -1 - i : p.sel[(size_t)gq * TOPK + (i - NM)];
  }
  __syncthreads();
  const float* w_uk = p.w_uk + (size_t)layer * 8 * 64 * 128;
  const float* w_uv = p.w_uv + (size_t)layer * 8 * 128 * 64;
  for (int o = tid; o < 1024; o += 256) {
    int h = o >> 7, cc = o & 127; float a = 0.f;
    const float* wk = w_uk + (size_t)h * 64 * 128 + cc;
#pragma unroll 8
    for (int d = 0; d < 64; ++d) a = fmaf(qa[h * 64 + d], wk[(size_t)d * 128], a);
    ql[o] = a;
  }
  __syncthreads();
  for (int pp = tid; pp < 8 * nk; pp += 256) {
    int h = pp / nk, j = pp % nk; int kr = kidx[j];
    const bf16_t* cr = kr < 0 ? p.cNm + (size_t)(-1 - kr) * 128 : p.cN + ((size_t)b * S + kr) * 128;
    int kpos = kr < 0 ? (-1 - kr) : NM + kr;
    float a = 0.f;
#pragma unroll 8
    for (int cc = 0; cc < 128; ++cc) a = fmaf(ql[h * 128 + cc], bf2f(cr[cc]), a);
    lg[h][j] = a * 0.125f + p.rel_bias[t5_bucket(e - kpos) * 8 + h];
  }
  __syncthreads();
  {
    int h = tid >> 5, l = tid & 31;
    float m = -INFINITY;
    for (int j = l; j < nk; j += 32) m = fmaxf(m, lg[h][j]);
    for (int o = 16; o > 0; o >>= 1) m = fmaxf(m, __shfl_xor(m, o));
    float s = 0.f;
    for (int j = l; j < nk; j += 32) { float pr = expf(lg[h][j] - m); lg[h][j] = pr; s += pr; }
    for (int o = 16; o > 0; o >>= 1) s += __shfl_xor(s, o);
    if (l == 0) red[h] = 1.0f / s;
  }
  __syncthreads();
  for (int o = tid; o < 1024; o += 256) {
    int h = o >> 7, cc = o & 127; float a = 0.f;
#pragma unroll 4
    for (int j = 0; j < nk; ++j) { int kr = kidx[j]; const bf16_t* cr = kr < 0 ? p.cNm + (size_t)(-1 - kr) * 128 : p.cN + ((size_t)b * S + kr) * 128; a = fmaf(lg[h][j], bf2f(cr[cc]), a); }
    ol[o] = a * red[h];
  }
  __syncthreads();
  bf16_t* grow = (is_meta ? p.gatesm : p.gates) + (size_t)gq * 1024;
  for (int o = tid; o < 512; o += 256) {
    int h = o >> 6, d = o & 63; float a = 0.f;
    const float* wv = w_uv + (size_t)h * 128 * 64 + d;
#pragma unroll 8
    for (int cc = 0; cc < 128; ++cc) a = fmaf(ol[h * 128 + cc], wv[(size_t)cc * 64], a);
    grow[o] = f2bf(a * bf2f(grow[o]));
  }
}

__global__ __launch_bounds__(256) void k_hgrn(Params p, int layer) {
  const int b = blockIdx.x >> 2, h = blockIdx.x & 3, tid = threadIdx.x, v = tid & 127, kh = tid >> 7;
  __shared__ float sq[128], sf[128], sk[128], sv[128];
  __shared__ float so[2][128];
  __shared__ float sred[128];
  const float* gnorm = p.hng + layer * 128;
  float St[64];
#pragma unroll
  for (int i = 0; i < 64; ++i) St[i] = 0.f;
  for (int e = 0; e < NM + S; ++e) {
    const bool im = e < NM;
    const size_t r = im ? (size_t)e : (size_t)b * S + (e - NM);
    const bf16_t* qf = (im ? p.qfm : p.qf) + r * 512 + h * 128;
    const float* gl = (im ? p.glm : p.gl) + r * 512 + h * 128;
    const bf16_t* vv = (im ? p.vvm : p.vv) + r * 512 + h * 128;
    bf16_t* gt = (im ? p.gatesm : p.gates) + r * 1024 + 512 + h * 128;
    if (tid < 128) {
      float f = expf(gl[tid]);
      sq[tid] = bf2f(qf[tid]); sf[tid] = f; sk[tid] = 1.0f - f; sv[tid] = bf2f(vv[tid]);
    }
    __syncthreads();
    float vval = sv[v], o = 0.f;
#pragma unroll
    for (int i = 0; i < 64; ++i) { int k = kh * 64 + i; St[i] = fmaf(sf[k], St[i], sk[k] * vval); o = fmaf(sq[k], St[i], o); }
    so[kh][v] = o;
    __syncthreads();
    if (tid < 128) { float ot = so[0][tid] + so[1][tid]; so[0][tid] = ot; sred[tid] = ot * ot; }
    __syncthreads();
    for (int s = 64; s > 0; s >>= 1) { if (tid < s) sred[tid] += sred[tid + s]; __syncthreads(); }
    if (tid < 128 && (!im || b == 0)) {
      float rstd = rsqrtf(sred[0] / 128.f + EPS);
      gt[tid] = f2bf(so[0][tid] * rstd * gnorm[tid] * bf2f(gt[tid]));
    }
    __syncthreads();
  }
}

__global__ __launch_bounds__(256) void k_ln(const float* __restrict__ h, const float* __restrict__ y, const float* __restrict__ g,
                                            const float* __restrict__ bb, float* __restrict__ dst, bf16_t* __restrict__ hi, bf16_t* __restrict__ lo) {
  const int row = blockIdx.x, tid = threadIdx.x;
  __shared__ float red[256];
  float v[4]; float s = 0.f;
  for (int i = 0; i < 4; ++i) { int c = tid + 256 * i; v[i] = DN_ALPHA * h[(size_t)row * D + c] + y[(size_t)row * D + c]; s += v[i]; }
  red[tid] = s; __syncthreads();
  for (int o = 128; o > 0; o >>= 1) { if (tid < o) red[tid] += red[tid + o]; __syncthreads(); }
  float mu = red[0] / D; __syncthreads();
  float q = 0.f;
  for (int i = 0; i < 4; ++i) { float d = v[i] - mu; q += d * d; }
  red[tid] = q; __syncthreads();
  for (int o = 128; o > 0; o >>= 1) { if (tid < o) red[tid] += red[tid + o]; __syncthreads(); }
  float rstd = rsqrtf(red[0] / D + EPS);
  for (int i = 0; i < 4; ++i) {
    int c = tid + 256 * i; float o = (v[i] - mu) * rstd * g[c] + bb[c];
    dst[(size_t)row * D + c] = o;
    if (hi) { bf16_t hh = f2bf(o); hi[(size_t)row * D + c] = hh; lo[(size_t)row * D + c] = f2bf(o - bf2f(hh)); }
  }
}
#define LAS __attribute__((address_space(3)))
typedef short bf16x8 __attribute__((ext_vector_type(8)));
typedef float f32x4 __attribute__((ext_vector_type(4)));
typedef unsigned u32x2 __attribute__((ext_vector_type(2)));
typedef unsigned u32x4 __attribute__((ext_vector_type(4)));
constexpr int NTHREADS = 512;
constexpr int LDS_BYTES = 160 * 1024;
constexpr int BM = 256, BK = 64, HALF = 128, HTB = HALF * BK * 2, STAGE_BYTES = 8 * HTB;
constexpr int LDS_EXTRA = STAGE_BYTES;

__device__ __forceinline__ unsigned pack_bf16(float lo, float hi) { return (unsigned)f2bf(lo) | ((unsigned)f2bf(hi) << 16); }
__device__ __forceinline__ float fast_sigmoid(float x) { return 1.0f / (1.0f + __expf(-x)); }
__device__ __forceinline__ float fast_silu(float x) { return x / (1.0f + __expf(-x)); }

__device__ __forceinline__ int lds_byte(int r, int c) { const int st = (r >> 4) * 2 + (c >> 5), rr = r & 15, cc = c & 31, ob = rr * 64 + cc * 2; return st * 1024 + (ob ^ (((ob >> 9) & 1) << 5)); }
__device__ __forceinline__ void stage_rc(int b, int& Rr, int& Cc) { const int st = b / 1024, sb = b % 1024, swz = sb ^ (((sb >> 9) & 1) << 5); Rr = (st >> 1) * 16 + swz / 64; Cc = (st & 1) * 32 + (swz % 64) / 2; }

struct GUnit { int pm, pn; };
__device__ __forceinline__ bool unit_next(int i, int nM, int nN, GUnit& u) {
  const int nwg = nM * nN; const long L = (long)i * gridDim.x + blockIdx.x; if (L >= nwg) return false;
  int wgid = (int)L; { const int q = nwg / 8, r = nwg % 8, xcd = wgid % 8, off = wgid / 8; wgid = (xcd < r ? xcd * (q + 1) : r * (q + 1) + (xcd - r) * q) + off; }
  const int nig = 8 * nN, gid = wgid / nig, fm = gid * 8, gsz = (nM - fm) < 8 ? (nM - fm) : 8;
  u.pm = fm + ((wgid % nig) % gsz); u.pn = (wgid % nig) / gsz; return true;
}

struct SrcP1 {
  const char* Ahi; const char* Alo; const char* Wm; const char* Ws;
  __device__ __forceinline__ int nt(const GUnit& u) const { return u.pn < 12 ? 16 : 48; }
  __device__ __forceinline__ int ldb(const GUnit& u) const { return u.pn < 12 ? 1024 : 3072; }
  __device__ __forceinline__ const char* a(const GUnit& u, int kt) const { const char* b = (kt >= 16 && kt < 32) ? Alo : Ahi; return b + (size_t)u.pm * (256 * 1024 * 2) + (size_t)(kt & 15) * 128; }
  __device__ __forceinline__ const char* b(const GUnit& u, int kt) const { return u.pn < 12 ? Wm + (size_t)u.pn * (256 * 1024 * 2) + (size_t)kt * 128 : Ws + (size_t)(u.pn - 12) * (256 * 3072 * 2) + (size_t)kt * 128; }
};
struct SrcP3 {
  const char* A; const char* W;
  __device__ __forceinline__ int nt(const GUnit&) const { return 16; }
  __device__ __forceinline__ int ldb(const GUnit&) const { return 1024; }
  __device__ __forceinline__ const char* a(const GUnit& u, int kt) const { return A + (size_t)u.pm * (256 * 1024 * 2) + (size_t)kt * 128; }
  __device__ __forceinline__ const char* b(const GUnit& u, int kt) const { return W + (size_t)u.pn * (256 * 1024 * 2) + (size_t)kt * 128; }
};

struct EpiP1 {
  Params p; int layer;
  __device__ __forceinline__ void operator()(const f32x4 (&acc)[2][2][4][2], const GUnit& u, int wr, int wc, int fr, int fq, LAS unsigned char* lds) const {
    const int row0 = u.pm * BM + wr * 64 + fr;
    if (u.pn < 12) {
      const int kind = u.pn >> 1; const int c00 = (u.pn & 1) * 256 + wc * 32 + 4 * fq;
#pragma unroll
      for (int ai = 0; ai < 2; ++ai)
#pragma unroll
        for (int m = 0; m < 4; ++m) {
          const size_t row = (size_t)(row0 + ai * HALF + m * 16);
#pragma unroll
          for (int bj = 0; bj < 2; ++bj)
#pragma unroll
            for (int n = 0; n < 2; ++n) {
              const int c = c00 + bj * HALF + n * 16; f32x4 v = acc[ai][bj][m][n];
              if (kind == 3) {
                const f32x4 lb = *(const f32x4*)(p.lbv + layer * 512 + c); f32x4 o;
#pragma unroll
                for (int j = 0; j < 4; ++j) o[j] = __logf(lb[j] + (1.0f - lb[j]) * fast_sigmoid(v[j]));
                *(f32x4*)(p.gl + row * 512 + c) = o;
              } else {
                if (kind == 1 || kind == 5) {
#pragma unroll
                  for (int j = 0; j < 4; ++j) v[j] = fast_silu(v[j]);
                } else if (kind == 2) {
#pragma unroll
                  for (int j = 0; j < 4; ++j) v[j] = fast_silu(v[j]) * 0.08838834764831845f;
                }
                u32x2 w; w.x = pack_bf16(v[0], v[1]); w.y = pack_bf16(v[2], v[3]);
                bf16_t* dst = kind == 0 ? p.qa + row * 512 + c : kind == 1 ? p.gates + row * 1024 + c : kind == 2 ? p.qf + row * 512 + c
                            : kind == 4 ? p.vv + row * 512 + c : p.gates + row * 1024 + 512 + c;
                *(u32x2*)dst = w;
              }
            }
        }
    } else if (u.pn == 12) {
      const int c00 = wc * 32 + 4 * fq;
#pragma unroll
      for (int ai = 0; ai < 2; ++ai)
#pragma unroll
        for (int m = 0; m < 4; ++m) {
          const size_t row = (size_t)(row0 + ai * HALF + m * 16);
#pragma unroll
          for (int bj = 0; bj < 2; ++bj)
#pragma unroll
            for (int n = 0; n < 2; ++n) {
              const int c = c00 + bj * HALF + n * 16; const f32x4 v = acc[ai][bj][m][n] * 0.125f;
              bf16_t h[4], l[4];
#pragma unroll
              for (int j = 0; j < 4; ++j) { h[j] = f2bf(v[j]); l[j] = f2bf(v[j] - bf2f(h[j])); }
              u32x2 wh, wl; wh.x = (unsigned)h[0] | ((unsigned)h[1] << 16); wh.y = (unsigned)h[2] | ((unsigned)h[3] << 16);
              wl.x = (unsigned)l[0] | ((unsigned)l[1] << 16); wl.y = (unsigned)l[2] | ((unsigned)l[3] << 16);
              *(u32x2*)(p.qiH + row * 256 + c) = wh; *(u32x2*)(p.qiL + row * 256 + c) = wl;
            }
        }
    } else {
      LAS float* red = (LAS float*)(lds + LDS_EXTRA);
#pragma unroll
      for (int ai = 0; ai < 2; ++ai)
#pragma unroll
        for (int m = 0; m < 4; ++m) {
          float s = 0.f;
#pragma unroll
          for (int n = 0; n < 2; ++n) { const f32x4 v = acc[ai][0][m][n]; s += (v[0] * v[0] + v[1] * v[1]) + (v[2] * v[2] + v[3] * v[3]); }
          s += __shfl_xor(s, 16); s += __shfl_xor(s, 32);
          if (fq == 0) red[(ai * HALF + wr * 64 + m * 16 + fr) * 4 + wc] = s;
        }
      asm volatile("s_waitcnt lgkmcnt(0)" ::: "memory"); __builtin_amdgcn_s_barrier(); asm volatile("" ::: "memory");
#pragma unroll
      for (int ai = 0; ai < 2; ++ai)
#pragma unroll
        for (int m = 0; m < 4; ++m) {
          const int lr = ai * HALF + wr * 64 + m * 16 + fr; const size_t row = (size_t)(u.pm * BM + lr);
          const f32x4 pr = *(const LAS f32x4*)(red + lr * 4);
          const float rstd = rsqrtf(((pr[0] + pr[1]) + (pr[2] + pr[3])) * (1.0f / 128.0f) + EPS);
#pragma unroll
          for (int n = 0; n < 2; ++n) {
            const int c = wc * 32 + n * 16 + 4 * fq; const f32x4 g = *(const f32x4*)(p.kvg + layer * 128 + c); const f32x4 v = acc[ai][0][m][n] * rstd * g;
            u32x2 w; w.x = pack_bf16(v[0], v[1]); w.y = pack_bf16(v[2], v[3]); *(u32x2*)(p.cN + row * 128 + c) = w;
          }
          if (wc < 2) {
#pragma unroll
            for (int n = 0; n < 2; ++n) {
              const int c = wc * 32 + n * 16 + 4 * fq; const f32x4 v = acc[ai][1][m][n];
              bf16_t h[4], l[4];
#pragma unroll
              for (int j = 0; j < 4; ++j) { h[j] = f2bf(v[j]); l[j] = f2bf(v[j] - bf2f(h[j])); }
              u32x2 wh, wl; wh.x = (unsigned)h[0] | ((unsigned)h[1] << 16); wh.y = (unsigned)h[2] | ((unsigned)h[3] << 16);
              wl.x = (unsigned)l[0] | ((unsigned)l[1] << 16); wl.y = (unsigned)l[2] | ((unsigned)l[3] << 16);
              *(u32x2*)(p.kiH + row * 64 + c) = wh; *(u32x2*)(p.kiL + row * 64 + c) = wl;
            }
          } else if (wc == 2 && fq == 0) {
            *(f32x4*)(p.wi + row * 4) = acc[ai][1][m][0] * 0.5f;
          }
        }
    }
  }
};

struct EpiP3 {
  Params p; const float* hres;
  __device__ __forceinline__ void operator()(const f32x4 (&acc)[2][2][4][2], const GUnit& u, int wr, int wc, int fr, int fq, LAS unsigned char* lds) const {
    const int row0 = u.pm * BM + wr * 64 + fr; const int c00 = u.pn * BM + wc * 32 + 4 * fq;
#pragma unroll
    for (int ai = 0; ai < 2; ++ai)
#pragma unroll
      for (int m = 0; m < 4; ++m) {
        const size_t row = (size_t)(row0 + ai * HALF + m * 16); float s = 0.f, q = 0.f;
#pragma unroll
        for (int bj = 0; bj < 2; ++bj)
#pragma unroll
          for (int n = 0; n < 2; ++n) {
            const int c = c00 + bj * HALF + n * 16; const f32x4 h = *(const f32x4*)(hres + row * D + c);
            const f32x4 v = h * DN_ALPHA + acc[ai][bj][m][n];
            *(f32x4*)(p.hF + row * D + c) = v;
            s += (v[0] + v[1]) + (v[2] + v[3]); q += (v[0] * v[0] + v[1] * v[1]) + (v[2] * v[2] + v[3] * v[3]);
          }
        s += __shfl_xor(s, 16); s += __shfl_xor(s, 32); q += __shfl_xor(q, 16); q += __shfl_xor(q, 32);
        if (fq == 0) { float2 st; st.x = s; st.y = q; *(float2*)(p.stats + (row * 16 + u.pn * 4 + wc) * 2) = st; }
        asm volatile("" ::: "memory");
      }
  }
};

template <class Src, class Epi>
__device__ __forceinline__ void gemm_phase(LAS unsigned char* lds, const Src S, const int nM, const int nN, const Epi& E) {
  int tid_ = threadIdx.x; asm volatile("" : "+v"(tid_));
  const int tid = tid_, wid = __builtin_amdgcn_readfirstlane(tid >> 6), lane = tid & 63, wr = wid >> 2, wc = wid & 3, fr = lane & 15, fq = lane >> 4;
  unsigned voffA[2], voffB1[2], voffB3[2];
#pragma unroll
  for (int i = 0; i < 2; ++i) { int Rr, Cc; stage_rc(tid * 16 + i * 8192, Rr, Cc); voffA[i] = (unsigned)(Rr * 1024 + Cc) * 2u; voffB1[i] = voffA[i]; voffB3[i] = (unsigned)(Rr * 3072 + Cc) * 2u; }
  const size_t hstepA = (size_t)HALF * 1024 * 2;
  const unsigned ldsw = (unsigned)wid * 1024u;
  const int aoff = lds_byte(wr * 64 + fr, fq * 8), boff = lds_byte(wc * 32 + fr, fq * 8);
#define G_SA(b, h) (((b) * 2 + (h)) * HTB)
#define G_SB(b, h) ((4 + (b) * 2 + (h)) * HTB)
#define G_STAGE(bufoff, gbase, v0, v1) do { \
    __builtin_amdgcn_global_load_lds((const unsigned*)((const char*)(gbase) + (v0)), (LAS unsigned*)(lds + (bufoff) + ldsw), 16, 0, 0); \
    __builtin_amdgcn_global_load_lds((const unsigned*)((const char*)(gbase) + (v1)), (LAS unsigned*)(lds + (bufoff) + ldsw + 8192), 16, 0, 0); } while (0)
#define G_STAGE_A(bufoff, gbase) G_STAGE(bufoff, gbase, voffA[0], voffA[1])
#define G_LDA(dst, b, h) do { _Pragma("unroll") for (int m = 0; m < 4; ++m) _Pragma("unroll") for (int k = 0; k < 2; ++k) dst[m][k] = *(const LAS bf16x8*)(lds + G_SA(b, h) + aoff + m * 2048 + k * 1024); } while (0)
#define G_LDB(dst, b, h) do { _Pragma("unroll") for (int n = 0; n < 2; ++n) _Pragma("unroll") for (int k = 0; k < 2; ++k) dst[n][k] = *(const LAS bf16x8*)(lds + G_SB(b, h) + boff + n * 2048 + k * 1024); } while (0)
#define G_MMA(ai, bj, At, Bt) do { __builtin_amdgcn_s_setprio(1); _Pragma("unroll") for (int m = 0; m < 4; ++m) _Pragma("unroll") for (int n = 0; n < 2; ++n) _Pragma("unroll") for (int k = 0; k < 2; ++k) \
    acc[ai][bj][m][n] = __builtin_amdgcn_mfma_f32_16x16x32_bf16(Bt[n][k], At[m][k], acc[ai][bj][m][n], 0, 0, 0); __builtin_amdgcn_s_setprio(0); } while (0)
#define G_WAIT_V(n) asm volatile("s_waitcnt vmcnt(" #n ")" ::: "memory")
#define G_WAIT_L(n) asm volatile("s_waitcnt lgkmcnt(" #n ")" ::: "memory")
#define G_BAR __builtin_amdgcn_s_barrier()
#define G_SCHED __builtin_amdgcn_sched_barrier(0)
  GUnit cur, nxt; int ui = 0;
  if (!unit_next(0, nM, nN, cur)) return;
  f32x4 acc[2][2][4][2];
#pragma unroll
  for (int a = 0; a < 2; ++a)
#pragma unroll
    for (int b = 0; b < 2; ++b)
#pragma unroll
      for (int m = 0; m < 4; ++m)
#pragma unroll
        for (int n = 0; n < 2; ++n) acc[a][b][m][n] = (f32x4){0.f, 0.f, 0.f, 0.f};
  bf16x8 At[4][2], B0[2][2], B1[2][2];
  {
    const bool w3 = S.ldb(cur) == 3072; const unsigned vb0 = w3 ? voffB3[0] : voffB1[0], vb1 = w3 ? voffB3[1] : voffB1[1]; const size_t hsB = (size_t)HALF * S.ldb(cur) * 2;
    const char* cA0 = S.a(cur, 0); const char* cB0 = S.b(cur, 0); const char* cA1 = S.a(cur, 1); const char* cB1 = S.b(cur, 1);
    G_STAGE(G_SB(0, 0), cB0, vb0, vb1); G_STAGE_A(G_SA(0, 0), cA0); G_STAGE(G_SB(0, 1), cB0 + hsB, vb0, vb1); G_STAGE_A(G_SA(0, 1), cA0 + hstepA);
    if (wr == 1) G_BAR;
    G_WAIT_V(4); G_BAR;
    G_STAGE(G_SB(1, 0), cB1, vb0, vb1); G_STAGE_A(G_SA(1, 0), cA1); G_STAGE(G_SB(1, 1), cB1 + hsB, vb0, vb1);
    G_WAIT_V(6); G_BAR;
  }
  for (;;) {
    const bool has_next = unit_next(ui + 1, nM, nN, nxt);
    const GUnit nu = has_next ? nxt : cur;
    const int nt = S.nt(cur);
    const bool cw3 = S.ldb(cur) == 3072, nw3 = S.ldb(nu) == 3072;
    for (int t = 0; t < nt; t += 2) {
      const bool last = (t == nt - 2);
      const char* a1 = S.a(cur, t + 1);
      const char* a2 = last ? S.a(nu, 0) : S.a(cur, t + 2); const char* b2 = last ? S.b(nu, 0) : S.b(cur, t + 2);
      const char* a3 = last ? S.a(nu, 1) : S.a(cur, t + 3); const char* b3 = last ? S.b(nu, 1) : S.b(cur, t + 3);
      const bool w3 = last ? nw3 : cw3;
      const unsigned vb0 = w3 ? voffB3[0] : voffB1[0], vb1 = w3 ? voffB3[1] : voffB1[1]; const size_t hsB = w3 ? (size_t)HALF * 3072 * 2 : (size_t)HALF * 1024 * 2;
      G_LDB(B0, 0, 0); G_SCHED; G_LDA(At, 0, 0); G_STAGE_A(G_SA(1, 1), a1 + hstepA);
      G_WAIT_L(8); G_BAR; G_WAIT_L(0); G_MMA(0, 0, At, B0); G_BAR; G_SCHED;
      G_LDB(B1, 0, 1); G_STAGE(G_SB(0, 0), b2, vb0, vb1);
      G_BAR; G_WAIT_L(0); G_MMA(0, 1, At, B1); G_BAR;
      G_LDA(At, 0, 1); G_STAGE_A(G_SA(0, 0), a2);
      G_BAR; G_WAIT_L(0); G_MMA(1, 0, At, B0); G_BAR; G_SCHED;
      G_STAGE(G_SB(0, 1), b2 + hsB, vb0, vb1);
      G_WAIT_V(6); G_BAR; G_MMA(1, 1, At, B1); G_BAR;
      G_LDB(B0, 1, 0); G_SCHED; G_LDA(At, 1, 0); G_STAGE_A(G_SA(0, 1), a2 + hstepA);
      G_WAIT_L(8); G_BAR; G_WAIT_L(0); G_MMA(0, 0, At, B0); G_BAR; G_SCHED;
      G_LDB(B1, 1, 1); G_STAGE(G_SB(1, 0), b3, vb0, vb1);
      G_BAR; G_WAIT_L(0); G_MMA(0, 1, At, B1); G_BAR;
      G_LDA(At, 1, 1); G_STAGE_A(G_SA(1, 0), a3);
      G_BAR; G_WAIT_L(0); G_MMA(1, 0, At, B0); G_BAR; G_SCHED;
      G_STAGE(G_SB(1, 1), b3 + hsB, vb0, vb1);
      G_WAIT_V(6); G_BAR; G_MMA(1, 1, At, B1); G_BAR;
    }
    E(acc, cur, wr, wc, fr, fq, lds);
    if (!has_next) break;
#pragma unroll
    for (int a = 0; a < 2; ++a)
#pragma unroll
      for (int b = 0; b < 2; ++b)
#pragma unroll
        for (int m = 0; m < 4; ++m)
#pragma unroll
          for (int n = 0; n < 2; ++n) acc[a][b][m][n] = (f32x4){0.f, 0.f, 0.f, 0.f};
    cur = nxt; ++ui;
  }
  G_WAIT_V(0);
  if (wr == 0) G_BAR;
  G_BAR;
#undef G_SA
#undef G_SB
#undef G_STAGE
#undef G_STAGE_A
#undef G_LDA
#undef G_LDB
#undef G_MMA
#undef G_WAIT_V
#undef G_WAIT_L
#undef G_BAR
#undef G_SCHED
}

__device__ __forceinline__ void phase_prep(const Params& p, LAS unsigned char* lds) {
  int tid_ = threadIdx.x; asm volatile("" : "+v"(tid_));
  const int tid = tid_, nb = gridDim.x, bid = blockIdx.x;
  LAS float* tile = (LAS float*)lds;
  const int NJ = DEPTH * (48 + 8 + 16) * 16;
  for (int job = bid; job < NJ; job += nb) {
    const int l = job / ((48 + 8 + 16) * 16); int rem = job % ((48 + 8 + 16) * 16); const int ntile = rem / 16, kt = rem % 16;
    const int kind = ntile < 48 ? 0 : ntile < 56 ? 1 : 2; const int n0 = kind == 0 ? ntile * 64 : kind == 1 ? (ntile - 48) * 64 : (ntile - 56) * 64;
    const float* src = kind == 2 ? p.w_out + (size_t)l * D * D : p.w_in + (size_t)l * D * NIN; const int lds_ = kind == 2 ? D : NIN;
    for (int i = tid; i < 64 * 64; i += NTHREADS) {
      const int kk = i >> 6, nn = i & 63; const int n = n0 + nn; int col;
      if (kind == 0) { const int grp = n >> 9, cc = n & 511; col = (grp == 0 ? O_QA : grp == 1 ? O_GA : grp == 2 ? O_QH : grp == 3 ? O_FH : grp == 4 ? O_IH : O_GH) + cc; }
      else if (kind == 1) { col = n < 256 ? O_QI + n : n < 384 ? O_CKV + (n - 256) : n < 448 ? O_KI + (n - 384) : n < 452 ? O_WI + (n - 448) : -1; }
      else col = n;
      tile[kk * 65 + nn] = col >= 0 ? src[(size_t)(kt * 64 + kk) * lds_ + col] : 0.f;
    }
    __syncthreads();
    for (int i = tid; i < 64 * 64; i += NTHREADS) {
      const int nn = i >> 6, kk = i & 63; const float v = tile[kk * 65 + nn]; const int n = n0 + nn, k = kt * 64 + kk;
      if (kind == 0) p.WmT[((size_t)l * 3072 + n) * 1024 + k] = f2bf(v);
      else if (kind == 2) p.WoT[((size_t)l * 1024 + n) * 1024 + k] = f2bf(v);
      else { const bf16_t h = f2bf(v), lo = f2bf(v - bf2f(h)); bf16_t* d = p.WsT + ((size_t)l * 512 + n) * 3072; d[k] = h; d[1024 + k] = h; d[2048 + k] = lo; }
    }
    __syncthreads();
  }
  for (int i = bid * NTHREADS + tid; i < 512; i += nb * NTHREADS) {
    const float r0 = p.lbraw[i], r1 = p.lbraw[512 + i]; const float m = fmaxf(r0, r1); const float e0 = expf(r0 - m), e1 = expf(r1 - m);
    p.lbv[i] = 0.f; p.lbv[512 + i] = e1 / (e0 + e1);
  }
  for (int i = bid * NTHREADS + tid; i < DEPTH * 8 * 128 * 64; i += nb * NTHREADS) {
    const int d = i & 63, c = (i >> 6) & 127, lh = i >> 13;
    p.wukT[i] = f2bf(p.w_uk[((size_t)lh * 64 + d) * 128 + c]);
    const int c2 = i & 127, d2 = (i >> 7) & 63;
    p.wuvT[i] = f2bf(p.w_uv[((size_t)lh * 128 + c2) * 64 + d2]);
  }
  const size_t n4 = (size_t)(R + NM) * D / 4;
  for (size_t i = (size_t)bid * NTHREADS + tid; i < n4; i += (size_t)nb * NTHREADS) {
    const size_t row = i / (D / 4); const int c4 = (int)(i % (D / 4));
    const bool im = row >= (size_t)R; const size_t rr = im ? row - R : row;
    const f32x4 v = *(const f32x4*)((im ? p.meta : p.x) + rr * D + c4 * 4);
    bf16_t h[4], l[4];
#pragma unroll
    for (int j = 0; j < 4; ++j) { h[j] = f2bf(v[j]); l[j] = f2bf(v[j] - bf2f(h[j])); }
    u32x2 wh, wl; wh.x = (unsigned)h[0] | ((unsigned)h[1] << 16); wh.y = (unsigned)h[2] | ((unsigned)h[3] << 16);
    wl.x = (unsigned)l[0] | ((unsigned)l[1] << 16); wl.y = (unsigned)l[2] | ((unsigned)l[3] << 16);
    *(u32x2*)((im ? p.hHim : p.hHi) + rr * D + c4 * 4) = wh; *(u32x2*)((im ? p.hLom : p.hLo) + rr * D + c4 * 4) = wl;
  }
}

__device__ __forceinline__ void phase_ln(const Params& p, int layer, float* dst, bool write_split) {
  int tid_ = threadIdx.x; asm volatile("" : "+v"(tid_));
  const int tid = tid_, wid = tid >> 6, lane = tid & 63;
  const float* g = p.ln_g + layer * D; const float* bb = p.ln_b + layer * D;
  for (int row = blockIdx.x * 8 + wid; row < R; row += gridDim.x * 8) {
    float s = 0.f, q = 0.f;
    if (lane < 16) { const float2 st = *(const float2*)(p.stats + ((size_t)row * 16 + lane) * 2); s = st.x; q = st.y; }
#pragma unroll
    for (int o = 8; o > 0; o >>= 1) { s += __shfl_xor(s, o); q += __shfl_xor(q, o); }
    s = __shfl(s, 0); q = __shfl(q, 0);
    const float mean = s * (1.0f / D); const float var = fmaxf(q * (1.0f / D) - mean * mean, 0.f); const float rstd = rsqrtf(var + EPS);
#pragma unroll
    for (int i = 0; i < 4; ++i) {
      const int c = (i * 64 + lane) * 4;
      const f32x4 v = *(const f32x4*)(p.hF + (size_t)row * D + c); const f32x4 gg = *(const f32x4*)(g + c); const f32x4 bv = *(const f32x4*)(bb + c);
      const f32x4 o = (v - mean) * rstd * gg + bv;
      *(f32x4*)(dst + (size_t)row * D + c) = o;
      if (write_split) {
        bf16_t h[4], l[4];
#pragma unroll
        for (int j = 0; j < 4; ++j) { h[j] = f2bf(o[j]); l[j] = f2bf(o[j] - bf2f(h[j])); }
        u32x2 wh, wl; wh.x = (unsigned)h[0] | ((unsigned)h[1] << 16); wh.y = (unsigned)h[2] | ((unsigned)h[3] << 16);
        wl.x = (unsigned)l[0] | ((unsigned)l[1] << 16); wl.y = (unsigned)l[2] | ((unsigned)l[3] << 16);
        *(u32x2*)(p.hHi + (size_t)row * D + c) = wh; *(u32x2*)(p.hLo + (size_t)row * D + c) = wl;
      }
    }
  }
}

constexpr int K16_STRIDE = 8208;
constexpr int A_BIG = 0;
constexpr int A_SEL = 131328;
constexpr int A_CM = A_SEL + 8192;
constexpr int A_MISC = A_CM + 4096;
constexpr int A_HIST = A_MISC;
constexpr int A_CAND = A_MISC + 8192;
constexpr int A_RB = A_MISC + 8192 + 1024;
constexpr int A_BKT = A_RB + 1024;
constexpr int A_NSEL = A_BKT + 128;
static_assert(A_NSEL + 64 <= LDS_BYTES, "attention LDS map");

__device__ __forceinline__ unsigned off_b(unsigned row, unsigned ch) { return 256u * row + 16u * (ch ^ (((row & 3) << 2) | ((row >> 2) & 3))); }
__device__ __forceinline__ void wave_lds_sync() { asm volatile("s_waitcnt lgkmcnt(0)" ::: "memory"); }
typedef unsigned short u16x4 __attribute__((ext_vector_type(4)));
typedef unsigned short u16x8 __attribute__((ext_vector_type(8)));
__device__ __forceinline__ f32x4 mfma16(bf16x8 a, bf16x8 b, f32x4 c) { return __builtin_amdgcn_mfma_f32_16x16x32_bf16(a, b, c, 0, 0, 0); }

__device__ __forceinline__ void wave_find_bin(const unsigned (&c)[4], unsigned need, int lane, unsigned& bin, unsigned& above) {
  const unsigned tot = c[0] + c[1] + c[2] + c[3];
  unsigned inc = tot;
#pragma unroll
  for (int o = 1; o < 64; o <<= 1) { const unsigned v = __shfl_down(inc, o); if (lane + o < 64) inc += v; }
  unsigned cum = inc - tot;
  unsigned fb = 0xffffffffu, fa = 0;
#pragma unroll
  for (int i = 3; i >= 0; --i) { if (fb == 0xffffffffu && cum < need && cum + c[i] >= need) { fb = 4u * lane + i; fa = cum; } cum += c[i]; }
  const unsigned long long m = __ballot(fb != 0xffffffffu);
  const int src = m ? (63 - __builtin_clzll(m)) : 0;
  bin = __shfl(fb, src); above = __shfl(fa, src);
  if (!m) { bin = 0; above = 0; }
}

__device__ __forceinline__ void attn_tile(const Params& p, const int layer, LAS unsigned char* lds, const bool is_meta, const int b, const int j,
                                          const bf16_t* wukT, const bf16_t* wuvT) {
  int tid_ = threadIdx.x; asm volatile("" : "+v"(tid_));
  const int tid = tid_, wid = __builtin_amdgcn_readfirstlane(tid >> 6), lane = tid & 63, fr = lane & 15, g = lane >> 4;
  const int t0 = 16 * j; const size_t r0 = is_meta ? 0 : (size_t)b * S + t0;
  const bf16_t* cNb = p.cN + (size_t)b * S * 128;
  LAS int* nselp = (LAS int*)(lds + A_NSEL);
  if (!is_meta && j >= 16) {
    {
      bf16x8 qH[4][2], qL[4][2];
      const bf16_t* qh = p.qiH + (r0 + fr) * 256 + g * 8; const bf16_t* ql = p.qiL + (r0 + fr) * 256 + g * 8;
#pragma unroll
      for (int h = 0; h < 4; ++h)
#pragma unroll
        for (int ks = 0; ks < 2; ++ks) { qH[h][ks] = *(const bf16x8*)(qh + h * 64 + ks * 32); qL[h][ks] = *(const bf16x8*)(ql + h * 64 + ks * 32); }
      const f32x4 w = *(const f32x4*)(p.wi + (r0 + fr) * 4);
      const int tq = t0 + fr;
      for (int kt = wid; kt <= j; kt += 8) {
        const bf16_t* kh = p.kiH + ((size_t)b * S + kt * 16 + fr) * 64 + g * 8; const bf16_t* kl = p.kiL + ((size_t)b * S + kt * 16 + fr) * 64 + g * 8;
        bf16x8 kH[2], kL[2];
#pragma unroll
        for (int ks = 0; ks < 2; ++ks) { kH[ks] = *(const bf16x8*)(kh + ks * 32); kL[ks] = *(const bf16x8*)(kl + ks * 32); }
        f32x4 sc = (f32x4){0.f, 0.f, 0.f, 0.f};
#pragma unroll
        for (int h = 0; h < 4; ++h) {
          f32x4 a = (f32x4){0.f, 0.f, 0.f, 0.f};
#pragma unroll
          for (int ks = 0; ks < 2; ++ks) { a = mfma16(kH[ks], qH[h][ks], a); a = mfma16(kL[ks], qH[h][ks], a); a = mfma16(kH[ks], qL[h][ks], a); }
#pragma unroll
          for (int i = 0; i < 4; ++i) sc[i] = fmaf(w[h], fmaxf(a[i], 0.f), sc[i]);
        }
        u16x4 kk;
#pragma unroll
        for (int i = 0; i < 4; ++i) { const int s = kt * 16 + 4 * g + i; kk[i] = s <= tq ? (unsigned short)(f2key(sc[i]) >> 16) : (unsigned short)0; }
        *(LAS u16x4*)(lds + A_BIG + fr * K16_STRIDE + (kt * 16 + 4 * g) * 2) = kk;
      }
    }
    __syncthreads();
    const int nkeys = 16 * (j + 1);
    LAS unsigned* hist = (LAS unsigned*)(lds + A_HIST + wid * 1024);
    LAS unsigned short* cand = (LAS unsigned short*)(lds + A_CAND + wid * 128);
    for (int qq = 0; qq < 2; ++qq) {
      const int qi = wid + 8 * qq;
      const LAS unsigned char* Kq = lds + A_BIG + qi * K16_STRIDE;
      LAS unsigned short* sel = (LAS unsigned short*)(lds + A_SEL + qi * 512);
      const int nit = (nkeys + 511) >> 9;
#pragma unroll
      for (int i = 0; i < 4; ++i) hist[lane * 4 + i] = 0u;
      wave_lds_sync();
      for (int it = 0; it < nit; ++it) {
        const int base = (it * 64 + lane) * 8;
        if (base < nkeys) { const u16x8 k = *(const LAS u16x8*)(Kq + base * 2);
#pragma unroll
          for (int e = 0; e < 8; ++e) __hip_atomic_fetch_add(hist + (k[e] >> 8), 1u, __ATOMIC_RELAXED, __HIP_MEMORY_SCOPE_WORKGROUP); }
      }
      wave_lds_sync();
      unsigned c4[4];
#pragma unroll
      for (int i = 0; i < 4; ++i) c4[i] = hist[lane * 4 + i];
      unsigned B1, above1; wave_find_bin(c4, (unsigned)TOPK, lane, B1, above1);
      wave_lds_sync();
#pragma unroll
      for (int i = 0; i < 4; ++i) hist[lane * 4 + i] = 0u;
      wave_lds_sync();
      for (int it = 0; it < nit; ++it) {
        const int base = (it * 64 + lane) * 8;
        if (base < nkeys) { const u16x8 k = *(const LAS u16x8*)(Kq + base * 2);
#pragma unroll
          for (int e = 0; e < 8; ++e) if ((unsigned)(k[e] >> 8) == B1) __hip_atomic_fetch_add(hist + (k[e] & 255), 1u, __ATOMIC_RELAXED, __HIP_MEMORY_SCOPE_WORKGROUP); }
      }
      wave_lds_sync();
#pragma unroll
      for (int i = 0; i < 4; ++i) c4[i] = hist[lane * 4 + i];
      unsigned B2, above2; wave_find_bin(c4, (unsigned)TOPK - above1, lane, B2, above2);
      const unsigned T16 = (B1 << 8) | B2; const unsigned ngt = above1 + above2; const unsigned need = (unsigned)TOPK - ngt;
      unsigned pos_gt = 0, pos_eq = 0;
      for (int it = 0; it < nit; ++it) {
        const int base = (it * 64 + lane) * 8; const bool ok = base < nkeys;
        u16x8 k = (u16x8){0, 0, 0, 0, 0, 0, 0, 0}; if (ok) k = *(const LAS u16x8*)(Kq + base * 2);
#pragma unroll
        for (int e = 0; e < 8; ++e) {
          const bool gt = ok && (unsigned)k[e] > T16, eq = ok && (unsigned)k[e] == T16;
          const unsigned long long mg = __ballot(gt), me = __ballot(eq);
          if (gt) sel[pos_gt + __builtin_amdgcn_mbcnt_hi((unsigned)(mg >> 32), __builtin_amdgcn_mbcnt_lo((unsigned)mg, 0u))] = (unsigned short)(base + e);
          if (eq) { const unsigned o = pos_eq + __builtin_amdgcn_mbcnt_hi((unsigned)(me >> 32), __builtin_amdgcn_mbcnt_lo((unsigned)me, 0u)); if (o < 64u) cand[o] = (unsigned short)(base + e); }
          pos_gt += (unsigned)__popcll(mg); pos_eq += (unsigned)__popcll(me);
        }
      }
      wave_lds_sync();
      if (T16 == 0x8000u || pos_eq > 64u) {
        unsigned taken = 0;
        for (int s0 = 0; s0 < nkeys && taken < need; s0 += 64) {
          const int s = s0 + lane; const bool eq = s < nkeys && (unsigned)(*(const LAS unsigned short*)(Kq + s * 2)) == T16;
          const unsigned long long me = __ballot(eq);
          const unsigned o = taken + __builtin_amdgcn_mbcnt_hi((unsigned)(me >> 32), __builtin_amdgcn_mbcnt_lo((unsigned)me, 0u));
          if (eq && o < need) sel[ngt + o] = (unsigned short)s;
          taken += (unsigned)__popcll(me);
        }
      } else {
        const int c = (int)pos_eq;
        const int myidx = lane < c ? (int)cand[lane] : 0;
        const size_t qrow = r0 + qi;
        float qv[4];
        { const u32x2 hq = *(const u32x2*)(p.qiH + qrow * 256 + lane * 4); const u32x2 lq = *(const u32x2*)(p.qiL + qrow * 256 + lane * 4);
          qv[0] = __uint_as_float(hq.x << 16) + __uint_as_float(lq.x << 16); qv[1] = __uint_as_float(hq.x & 0xffff0000u) + __uint_as_float(lq.x & 0xffff0000u);
          qv[2] = __uint_as_float(hq.y << 16) + __uint_as_float(lq.y << 16); qv[3] = __uint_as_float(hq.y & 0xffff0000u) + __uint_as_float(lq.y & 0xffff0000u); }
        const f32x4 w = *(const f32x4*)(p.wi + qrow * 4);
        const bf16_t* kh = p.kiH + ((size_t)b * S + myidx) * 64; const bf16_t* kl = p.kiL + ((size_t)b * S + myidx) * 64;
        float d4[4] = {0.f, 0.f, 0.f, 0.f};
#pragma unroll 1
        for (int dc = 0; dc < 8; ++dc) {
          const u32x4 hk = *(const u32x4*)(kh + dc * 8); const u32x4 lk = *(const u32x4*)(kl + dc * 8);
          float kv[8];
          kv[0] = __uint_as_float(hk.x << 16) + __uint_as_float(lk.x << 16); kv[1] = __uint_as_float(hk.x & 0xffff0000u) + __uint_as_float(lk.x & 0xffff0000u);
          kv[2] = __uint_as_float(hk.y << 16) + __uint_as_float(lk.y << 16); kv[3] = __uint_as_float(hk.y & 0xffff0000u) + __uint_as_float(lk.y & 0xffff0000u);
          kv[4] = __uint_as_float(hk.z << 16) + __uint_as_float(lk.z << 16); kv[5] = __uint_as_float(hk.z & 0xffff0000u) + __uint_as_float(lk.z & 0xffff0000u);
          kv[6] = __uint_as_float(hk.w << 16) + __uint_as_float(lk.w << 16); kv[7] = __uint_as_float(hk.w & 0xffff0000u) + __uint_as_float(lk.w & 0xffff0000u);
#pragma unroll
          for (int h = 0; h < 4; ++h)
#pragma unroll
            for (int dd = 0; dd < 8; ++dd) {
              const int srcl = h * 16 + dc * 2 + (dd >> 2);
              const float qs = __uint_as_float(__builtin_amdgcn_readlane(__float_as_uint(qv[dd & 3]), srcl));
              d4[h] = fmaf(qs, kv[dd], d4[h]);
            }
        }
        float sc = 0.f;
#pragma unroll
        for (int h = 0; h < 4; ++h) sc = fmaf(w[h], fmaxf(d4[h], 0.f), sc);
        int rank = 0;
        for (int jj = 0; jj < c; ++jj) {
          const float sj = __uint_as_float(__builtin_amdgcn_readlane(__float_as_uint(sc), jj)); const int ij = __builtin_amdgcn_readlane(myidx, jj);
          rank += (sj > sc || (sj == sc && ij < myidx)) ? 1 : 0;
        }
        if (lane < c && (unsigned)rank < need) sel[ngt + rank] = (unsigned short)myidx;
      }
      if (lane == 0) nselp[qi] = TOPK;
      wave_lds_sync();
    }
  } else if (!is_meta) {
    for (int i = tid; i < 16 * 256; i += NTHREADS) { const int qi = i >> 8, s = i & 255; ((LAS unsigned short*)(lds + A_SEL))[i] = (unsigned short)(s <= t0 + qi ? s : 0); }
    if (tid < 16) nselp[tid] = t0 + tid + 1;
  } else {
    if (tid < 16) nselp[tid] = 0;
  }
  __syncthreads();
  {
    const bf16_t* qa = (is_meta ? p.qam : p.qa) + (r0 + fr) * 512 + wid * 64 + g * 8;
    bf16x8 bq[2];
#pragma unroll
    for (int ks = 0; ks < 2; ++ks) bq[ks] = *(const bf16x8*)(qa + ks * 32);
    const bf16_t* wk = wukT + ((size_t)wid * 128 + fr) * 64 + g * 8;
#pragma unroll
    for (int mt = 0; mt < 8; ++mt) {
      f32x4 a = (f32x4){0.f, 0.f, 0.f, 0.f};
#pragma unroll
      for (int ks = 0; ks < 2; ++ks) a = mfma16(*(const bf16x8*)(wk + (size_t)mt * 16 * 64 + ks * 32), bq[ks], a);
      u32x2 w2; w2.x = pack_bf16(a[0], a[1]); w2.y = pack_bf16(a[2], a[3]);
      *(LAS u32x2*)(lds + A_BIG + ((fr * 8 + wid) * 128 + mt * 16 + 4 * g) * 2) = w2;
    }
  }
  __syncthreads();
  bf16x8 qf_[2][4];
#pragma unroll
  for (int qq = 0; qq < 2; ++qq)
#pragma unroll
    for (int ks = 0; ks < 4; ++ks) {
      const bf16x8 v = *(const LAS bf16x8*)(lds + A_BIG + (((wid + 8 * qq) * 8 + (fr & 7)) * 128 + ks * 32 + g * 8) * 2);
      qf_[qq][ks] = fr < 8 ? v : (bf16x8){0, 0, 0, 0, 0, 0, 0, 0};
    }
  __syncthreads();
  const LAS float* rb = (const LAS float*)(lds + A_RB);
  const LAS unsigned char* bkt = lds + A_BKT;
  f32x4 O[2][8];
  float linv[2];
  LAS unsigned char* gbuf = lds + A_BIG + wid * 16384;
  const unsigned gq = (lane & 15) >> 2, gp = lane & 3;
#pragma unroll
  for (int qq = 0; qq < 2; ++qq) {
    const int qi = wid + 8 * qq; const int nsel = nselp[qi];
    const int epos = is_meta ? qi : NM + t0 + qi;
    const LAS unsigned short* sel = (const LAS unsigned short*)(lds + A_SEL + qi * 512);
#pragma unroll
    for (int ct = 0; ct < 8; ++ct) O[qq][ct] = (f32x4){0.f, 0.f, 0.f, 0.f};
    float mrun = -INFINITY, lrun = 0.f;
    const int nch = (nsel + 31) >> 5;
#define ISSUE_GATHER(ch_) do { LAS unsigned char* dst_ = gbuf + ((ch_) & 1) * 8192; \
      _Pragma("unroll") for (int i_ = 0; i_ < 8; ++i_) { \
        const int row_ = 4 * i_ + g; const int si_ = (ch_) * 32 + row_; const int idx_ = si_ < nsel ? (int)sel[si_] : 0; \
        const unsigned f_ = (((unsigned)row_ & 3u) << 2) | (((unsigned)row_ >> 2) & 3u); \
        const bf16_t* src_ = cNb + (size_t)idx_ * 128 + (((unsigned)fr ^ f_) * 8); \
        __builtin_amdgcn_global_load_lds((const unsigned*)src_, (LAS unsigned*)(dst_ + i_ * 1024), 16, 0, 0); } } while (0)
    if (nch > 0) ISSUE_GATHER(0);
    {
      f32x4 s0 = (f32x4){0.f, 0.f, 0.f, 0.f};
#pragma unroll
      for (int ks = 0; ks < 4; ++ks) s0 = mfma16(*(const LAS bf16x8*)(lds + A_CM + off_b(fr, 4 * ks + g)), qf_[qq][ks], s0);
      float lg[4]; float mx = -INFINITY;
#pragma unroll
      for (int i = 0; i < 4; ++i) { const int m = 4 * g + i; const int dist = epos - m; const bool valid = !is_meta || m <= qi;
        const int bk = dist >= 128 ? 31 : (int)bkt[dist < 0 ? 0 : dist];
        lg[i] = valid ? s0[i] * 0.125f + rb[bk * 8 + (fr & 7)] : -INFINITY; mx = fmaxf(mx, lg[i]); }
      mx = fmaxf(mx, __shfl_xor(mx, 16)); mx = fmaxf(mx, __shfl_xor(mx, 32));
      mrun = mx; float ps = 0.f; float pv[4];
#pragma unroll
      for (int i = 0; i < 4; ++i) { pv[i] = __expf(lg[i] - mrun); ps += pv[i]; }
      ps += __shfl_xor(ps, 16); ps += __shfl_xor(ps, 32); lrun = ps;
      bf16x8 pf; { const unsigned a0 = pack_bf16(pv[0], pv[1]), a1 = pack_bf16(pv[2], pv[3]); u32x4 t; t.x = a0; t.y = a1; t.z = 0u; t.w = 0u; pf = __builtin_bit_cast(bf16x8, t); }
#pragma unroll
      for (int ct = 0; ct < 8; ++ct) {
        u16x4 t0v;
        asm volatile("ds_read_b64_tr_b16 %0, %1\n\ts_waitcnt lgkmcnt(0)" : "=&v"(t0v) : "v"((unsigned)(size_t)(lds + A_CM) + off_b(4 * g + gq, 2 * ct + (gp >> 1)) + 8 * (gp & 1)) : "memory");
        u16x8 af; af[0] = t0v[0]; af[1] = t0v[1]; af[2] = t0v[2]; af[3] = t0v[3]; af[4] = 0; af[5] = 0; af[6] = 0; af[7] = 0;
        O[qq][ct] = mfma16(__builtin_bit_cast(bf16x8, af), pf, O[qq][ct]);
      }
    }
    for (int ch = 0; ch < nch; ++ch) {
      asm volatile("s_waitcnt vmcnt(0)" ::: "memory");
      if (ch + 1 < nch) ISSUE_GATHER(ch + 1);
      const LAS unsigned char* buf = gbuf + (ch & 1) * 8192;
      f32x4 sA = (f32x4){0.f, 0.f, 0.f, 0.f}, sB = (f32x4){0.f, 0.f, 0.f, 0.f};
#pragma unroll
      for (int ks = 0; ks < 4; ++ks) {
        sA = mfma16(*(const LAS bf16x8*)(buf + off_b(fr, 4 * ks + g)), qf_[qq][ks], sA);
        sB = mfma16(*(const LAS bf16x8*)(buf + off_b(fr + 16, 4 * ks + g)), qf_[qq][ks], sB);
      }
      const u16x4 iA = *(const LAS u16x4*)(sel + ch * 32 + 4 * g); const u16x4 iB = *(const LAS u16x4*)(sel + ch * 32 + 16 + 4 * g);
      float lg[8]; float mx = -INFINITY;
#pragma unroll
      for (int i = 0; i < 8; ++i) {
        const int slot = ch * 32 + (i < 4 ? 4 * g + i : 16 + 4 * g + (i - 4)); const int kidx = i < 4 ? (int)iA[i] : (int)iB[i - 4];
        const int dist = t0 + qi - kidx; const int bk = dist >= 128 ? 31 : (int)bkt[dist < 0 ? 0 : dist];
        const float sv = i < 4 ? sA[i] : sB[i - 4];
        lg[i] = slot < nsel ? sv * 0.125f + rb[bk * 8 + (fr & 7)] : -INFINITY; mx = fmaxf(mx, lg[i]);
      }
      mx = fmaxf(mx, __shfl_xor(mx, 16)); mx = fmaxf(mx, __shfl_xor(mx, 32));
      const float mnew = fmaxf(mrun, mx); const float alpha = __expf(mrun - mnew); mrun = mnew;
      float pv[8]; float ps = 0.f;
#pragma unroll
      for (int i = 0; i < 8; ++i) { pv[i] = __expf(lg[i] - mnew); ps += pv[i]; }
      ps += __shfl_xor(ps, 16); ps += __shfl_xor(ps, 32); lrun = lrun * alpha + ps;
#pragma unroll
      for (int ct = 0; ct < 8; ++ct) O[qq][ct] *= alpha;
      bf16x8 pf; { u32x4 t; t.x = pack_bf16(pv[0], pv[1]); t.y = pack_bf16(pv[2], pv[3]); t.z = pack_bf16(pv[4], pv[5]); t.w = pack_bf16(pv[6], pv[7]); pf = __builtin_bit_cast(bf16x8, t); }
      const unsigned bb = (unsigned)(size_t)buf;
#pragma unroll
      for (int ct = 0; ct < 8; ++ct) {
        u16x4 ta, tb;
        asm volatile("ds_read_b64_tr_b16 %0, %2\n\tds_read_b64_tr_b16 %1, %3\n\ts_waitcnt lgkmcnt(0)" : "=&v"(ta), "=&v"(tb)
                     : "v"(bb + off_b(4 * g + gq, 2 * ct + (gp >> 1)) + 8 * (gp & 1)), "v"(bb + off_b(16 + 4 * g + gq, 2 * ct + (gp >> 1)) + 8 * (gp & 1)) : "memory");
        u16x8 af; af[0] = ta[0]; af[1] = ta[1]; af[2] = ta[2]; af[3] = ta[3]; af[4] = tb[0]; af[5] = tb[1]; af[6] = tb[2]; af[7] = tb[3];
        O[qq][ct] = mfma16(__builtin_bit_cast(bf16x8, af), pf, O[qq][ct]);
      }
    }
    linv[qq] = 1.0f / lrun;
  }
  asm volatile("s_waitcnt vmcnt(0) lgkmcnt(0)" ::: "memory");
#pragma unroll
  for (int qq = 0; qq < 2; ++qq)
    if (fr < 8) {
#pragma unroll
      for (int ct = 0; ct < 8; ++ct) { const f32x4 o = O[qq][ct] * linv[qq]; u32x2 w2; w2.x = pack_bf16(o[0], o[1]); w2.y = pack_bf16(o[2], o[3]);
        *(LAS u32x2*)(gbuf + qq * 2048 + (fr * 128 + ct * 16 + 4 * g) * 2) = w2; }
    }
  __syncthreads();
  {
    bf16x8 bo[4];
#pragma unroll
    for (int ks = 0; ks < 4; ++ks) bo[ks] = *(const LAS bf16x8*)(lds + A_BIG + (fr & 7) * 16384 + (fr >> 3) * 2048 + (wid * 128 + ks * 32 + g * 8) * 2);
    const bf16_t* wv = wuvT + ((size_t)wid * 64 + fr) * 128 + g * 8;
    bf16_t* grow = (is_meta ? p.gatesm : p.gates) + (r0 + fr) * 1024 + wid * 64 + 4 * g;
#pragma unroll
    for (int nt = 0; nt < 4; ++nt) {
      f32x4 a = (f32x4){0.f, 0.f, 0.f, 0.f};
#pragma unroll
      for (int ks = 0; ks < 4; ++ks) a = mfma16(*(const bf16x8*)(wv + (size_t)nt * 16 * 128 + ks * 32), bo[ks], a);
      const u32x2 gt = *(const u32x2*)(grow + nt * 16);
      const float g0 = __uint_as_float(gt.x << 16), g1 = __uint_as_float(gt.x & 0xffff0000u), g2 = __uint_as_float(gt.y << 16), g3 = __uint_as_float(gt.y & 0xffff0000u);
      u32x2 w2; w2.x = pack_bf16(a[0] * g0, a[1] * g1); w2.y = pack_bf16(a[2] * g2, a[3] * g3);
      *(u32x2*)(grow + nt * 16) = w2;
    }
  }
  __syncthreads();
}

__device__ __forceinline__ void phase_attn(const Params& p, int layer, LAS unsigned char* lds, int ablk, int nablk, bool do_meta) {
  int tid_ = threadIdx.x; asm volatile("" : "+v"(tid_));
  const int tid = tid_;
  if (tid < 256) { const int row = tid >> 4, ch = tid & 15; *(LAS u32x4*)(lds + A_CM + off_b(row, ch)) = *(const u32x4*)(p.cNm + row * 128 + ch * 8); }
  if (tid < 256) ((LAS float*)(lds + A_RB))[tid] = p.rel_bias[tid];
  if (tid < 128) (lds + A_BKT)[tid] = c_bucket[tid];
  __syncthreads();
  const bf16_t* wukT = p.wukT + (size_t)layer * 8 * 128 * 64; const bf16_t* wuvT = p.wuvT + (size_t)layer * 8 * 64 * 128;
  for (int item = ablk; item < NB * 256; item += nablk) {
    const int j = 255 - item / NB, b = item % NB;
    attn_tile(p, layer, lds, false, b, j, wukT, wuvT);
  }
  if (do_meta && ablk == nablk - 1) attn_tile(p, layer, lds, true, 0, 0, wukT, wuvT);
}

constexpr int H_QT = 0, H_KH = 4096, H_KT = 8192, H_VV = 12288, H_DEC = 16384, H_PART = 16384 + 512;
__device__ __forceinline__ u16x4 lds_tr4(unsigned addr) { u16x4 r; asm volatile("ds_read_b64_tr_b16 %0, %1\n\ts_waitcnt lgkmcnt(0)" : "=&v"(r) : "v"(addr) : "memory"); return r; }

__device__ __forceinline__ void phase_hgrn(const Params& p, const int layer, LAS unsigned char* lds, const int hblk) {
  int tid_ = threadIdx.x; asm volatile("" : "+v"(tid_));
  const int tid = tid_, wid = __builtin_amdgcn_readfirstlane(tid >> 6), lane = tid & 63, fr = lane & 15, g = lane >> 4;
  const int b = hblk >> 2, h = hblk & 3;
  const unsigned gq = (lane & 15) >> 2, gp = lane & 3;
  const unsigned ldsb = (unsigned)(size_t)lds;
  f32x4 Sacc[8];
#pragma unroll
  for (int kt = 0; kt < 8; ++kt) Sacc[kt] = (f32x4){0.f, 0.f, 0.f, 0.f};
  const float gn = p.hng[layer * 128 + wid * 16 + fr];
  const int st = lane >> 2, skq = lane & 3, sk4 = wid * 16 + skq * 4;
  for (int step = 0; step <= S / 16; ++step) {
    const bool im = step == 0;
    const size_t rbase = im ? 0 : (size_t)b * S + (size_t)(step - 1) * 16;
    const float* gl = (im ? p.glm : p.gl) + rbase * 512 + h * 128;
    const bf16_t* qf = (im ? p.qfm : p.qf) + rbase * 512 + h * 128;
    const bf16_t* vv = (im ? p.vvm : p.vv) + rbase * 512 + h * 128;
    bf16_t* gt = (im ? p.gatesm : p.gates) + rbase * 1024 + 512 + h * 128;
    {
      const f32x4 gv = *(const f32x4*)(gl + (size_t)st * 512 + sk4);
      const u32x2 qraw = *(const u32x2*)(qf + (size_t)st * 512 + sk4);
      f32x4 bc = gv;
#pragma unroll
      for (int o = 4; o < 64; o <<= 1) { f32x4 u;
#pragma unroll
        for (int j = 0; j < 4; ++j) u[j] = __shfl_up(bc[j], o); if (lane >= o) bc += u; }
      f32x4 bl;
#pragma unroll
      for (int j = 0; j < 4; ++j) bl[j] = __shfl(bc[j], 60 + skq);
      const float q0 = __uint_as_float(qraw.x << 16), q1 = __uint_as_float(qraw.x & 0xffff0000u), q2 = __uint_as_float(qraw.y << 16), q3 = __uint_as_float(qraw.y & 0xffff0000u);
      const float qv[4] = {q0, q1, q2, q3};
      float qt[4], khv[4], ktv[4];
#pragma unroll
      for (int j = 0; j < 4; ++j) {
        const float kc = 1.0f - __expf(gv[j]);
        const float eb = __expf(bc[j]);
        qt[j] = qv[j] * eb; khv[j] = kc * __expf(fminf(-bc[j], 80.f)); ktv[j] = kc * __expf(bl[j] - bc[j]);
      }
      const unsigned o1 = off_b(st, sk4 >> 3) + (sk4 & 7) * 2;
      u32x2 w2; w2.x = pack_bf16(qt[0], qt[1]); w2.y = pack_bf16(qt[2], qt[3]); *(LAS u32x2*)(lds + H_QT + o1) = w2;
      w2.x = pack_bf16(khv[0], khv[1]); w2.y = pack_bf16(khv[2], khv[3]); *(LAS u32x2*)(lds + H_KH + o1) = w2;
      w2.x = pack_bf16(ktv[0], ktv[1]); w2.y = pack_bf16(ktv[2], ktv[3]); *(LAS u32x2*)(lds + H_KT + o1) = w2;
      if (st == 15) { f32x4 dv;
#pragma unroll
        for (int j = 0; j < 4; ++j) dv[j] = __expf(bc[j]); *(LAS f32x4*)(lds + H_DEC + sk4 * 4) = dv; }
      if (tid < 256) { const int row = tid >> 4, ch = tid & 15; *(LAS u32x4*)(lds + H_VV + off_b(row, ch)) = *(const u32x4*)(vv + (size_t)row * 512 + ch * 8); }
    }
    float gate[4];
#pragma unroll
    for (int i = 0; i < 4; ++i) gate[i] = bf2f(gt[(size_t)(4 * g + i) * 1024 + wid * 16 + fr]);
    __syncthreads();
    f32x4 o = (f32x4){0.f, 0.f, 0.f, 0.f};
    {
      f32x4 sc = (f32x4){0.f, 0.f, 0.f, 0.f};
#pragma unroll
      for (int ks = 0; ks < 4; ++ks) sc = mfma16(*(const LAS bf16x8*)(lds + H_KH + off_b(fr, 4 * ks + g)), *(const LAS bf16x8*)(lds + H_QT + off_b(fr, 4 * ks + g)), sc);
#pragma unroll
      for (int ks = 0; ks < 4; ++ks) {
        const u32x2 a0 = *(const LAS u32x2*)(lds + H_QT + off_b(fr, 4 * ks + (g >> 1)) + (g & 1) * 8);
        const u32x2 a1 = *(const LAS u32x2*)(lds + H_QT + off_b(fr, 4 * ks + 2 + (g >> 1)) + (g & 1) * 8);
        u32x4 av; av.x = a0.x; av.y = a0.y; av.z = a1.x; av.w = a1.y;
        u32x4 bv; bv.x = pack_bf16(Sacc[2 * ks][0], Sacc[2 * ks][1]); bv.y = pack_bf16(Sacc[2 * ks][2], Sacc[2 * ks][3]);
        bv.z = pack_bf16(Sacc[2 * ks + 1][0], Sacc[2 * ks + 1][1]); bv.w = pack_bf16(Sacc[2 * ks + 1][2], Sacc[2 * ks + 1][3]);
        o = mfma16(__builtin_bit_cast(bf16x8, av), __builtin_bit_cast(bf16x8, bv), o);
      }
      const u16x4 vt = lds_tr4(ldsb + H_VV + off_b(4 * g + gq, 2 * wid + (gp >> 1)) + 8 * (gp & 1));
      u32x4 bvv; bvv.x = (unsigned)vt[0] | ((unsigned)vt[1] << 16); bvv.y = (unsigned)vt[2] | ((unsigned)vt[3] << 16); bvv.z = 0u; bvv.w = 0u;
      const bf16x8 bfv = __builtin_bit_cast(bf16x8, bvv);
      float ms[4];
#pragma unroll
      for (int i = 0; i < 4; ++i) ms[i] = (4 * g + i) <= fr ? sc[i] : 0.f;
      u32x4 am; am.x = pack_bf16(ms[0], ms[1]); am.y = pack_bf16(ms[2], ms[3]); am.z = 0u; am.w = 0u;
      o = mfma16(__builtin_bit_cast(bf16x8, am), bfv, o);
#pragma unroll
      for (int kt = 0; kt < 8; ++kt) {
        const f32x4 dv = *(const LAS f32x4*)(lds + H_DEC + (16 * kt + 4 * g) * 4);
        const u16x4 kt4 = lds_tr4(ldsb + H_KT + off_b(4 * g + gq, 2 * kt + (gp >> 1)) + 8 * (gp & 1));
        u32x4 ak; ak.x = (unsigned)kt4[0] | ((unsigned)kt4[1] << 16); ak.y = (unsigned)kt4[2] | ((unsigned)kt4[3] << 16); ak.z = 0u; ak.w = 0u;
        Sacc[kt] = mfma16(__builtin_bit_cast(bf16x8, ak), bfv, Sacc[kt] * dv);
      }
    }
    {
      f32x4 sq = o * o;
#pragma unroll
      for (int m = 1; m < 16; m <<= 1) {
#pragma unroll
        for (int i = 0; i < 4; ++i) sq[i] += __shfl_xor(sq[i], m); }
      if (fr == 0) *(LAS f32x4*)(lds + H_PART + (wid * 16 + 4 * g) * 4) = sq;
    }
    __syncthreads();
    if (!im || (b == 0 && layer == 0)) {
      f32x4 tot = (f32x4){0.f, 0.f, 0.f, 0.f};
#pragma unroll
      for (int w = 0; w < 8; ++w) tot += *(const LAS f32x4*)(lds + H_PART + (w * 16 + 4 * g) * 4);
#pragma unroll
      for (int i = 0; i < 4; ++i) {
        const float rstd = rsqrtf(tot[i] * (1.0f / 128.0f) + EPS);
        gt[(size_t)(4 * g + i) * 1024 + wid * 16 + fr] = f2bf(o[i] * rstd * gn * gate[i]);
      }
    }
  }
}

enum { PH_PREP = 0, PH_P1 = 1, PH_ATTN = 2, PH_P3 = 3, PH_LN = 4, PH_HGRN = 5 };
__global__ void __launch_bounds__(NTHREADS, 2) k_fast(Params p, int phase, int layer) {
  extern __shared__ __attribute__((aligned(16))) unsigned char smem[];
  LAS unsigned char* lds = (LAS unsigned char*)smem;
  if (phase == PH_PREP) phase_prep(p, lds);
  else if (phase == PH_P1) {
    SrcP1 S{(const char*)p.hHi, (const char*)p.hLo, (const char*)(p.WmT + (size_t)layer * 3072 * 1024), (const char*)(p.WsT + (size_t)layer * 512 * 3072)};
    EpiP1 E{p, layer};
    gemm_phase<SrcP1, EpiP1>(lds, S, R / BM, 14, E);
  } else if (phase == PH_P3) {
    SrcP3 S{(const char*)p.gates, (const char*)(p.WoT + (size_t)layer * 1024 * 1024)};
    EpiP3 E{p, layer == 0 ? p.x : p.hF};
    gemm_phase<SrcP3, EpiP3>(lds, S, R / BM, 4, E);
  } else if (phase == PH_ATTN) {
    phase_attn(p, layer, lds, blockIdx.x, gridDim.x, layer == 0);
  } else if (phase == PH_HGRN) {
    if (blockIdx.x < NB * 4) phase_hgrn(p, layer, lds, blockIdx.x);
  } else if (phase == PH_LN) {
    phase_ln(p, layer, layer == 0 ? p.hF : p.out, layer == 0);
  }
}

constexpr int M_A32T = 0;
constexpr int M_PART = 65536;
template <bool A_BF16>
__device__ __forceinline__ void meta_group_gemm(LAS unsigned char* lds, const void* A, const float* W, const int ldw, const int col0) {
  int tid_ = threadIdx.x; asm volatile("" : "+v"(tid_));
  const int tid = tid_, wid = __builtin_amdgcn_readfirstlane(tid >> 6), lane = tid & 63;
  LAS float* a32 = (LAS float*)(lds + M_A32T); LAS float* part = (LAS float*)(lds + M_PART);
  for (int i = tid; i < 16 * 1024; i += NTHREADS) { const int r = i >> 10, k = i & 1023; a32[k * 16 + r] = A_BF16 ? bf2f(((const bf16_t*)A)[i]) : ((const float*)A)[i]; }
  __syncthreads();
  float acc0[16], acc1[16];
#pragma unroll
  for (int r = 0; r < 16; ++r) { acc0[r] = 0.f; acc1[r] = 0.f; }
  const float* w0p = W + (size_t)(wid * 128) * ldw + col0 + lane;
#pragma unroll 4
  for (int kk = 0; kk < 128; ++kk) {
    const float w0 = w0p[(size_t)kk * ldw], w1 = w0p[(size_t)kk * ldw + 64];
    const LAS f32x4* ar = (const LAS f32x4*)(a32 + (wid * 128 + kk) * 16);
#pragma unroll
    for (int q = 0; q < 4; ++q) { const f32x4 a = ar[q];
#pragma unroll
      for (int j = 0; j < 4; ++j) { acc0[q * 4 + j] = fmaf(a[j], w0, acc0[q * 4 + j]); acc1[q * 4 + j] = fmaf(a[j], w1, acc1[q * 4 + j]); } }
  }
#pragma unroll
  for (int r = 0; r < 16; ++r) { part[(wid * 16 + r) * 128 + lane] = acc0[r]; part[(wid * 16 + r) * 128 + 64 + lane] = acc1[r]; }
  __syncthreads();
  for (int i = tid; i < 2048; i += NTHREADS) { float s = 0.f;
#pragma unroll
    for (int w = 0; w < 8; ++w) s += part[w * 2048 + i]; part[i] = s; }
  __syncthreads();
}

__device__ __forceinline__ void meta_inproj_group(const Params& p, const int layer, LAS unsigned char* lds, const int grp) {
  int tid_ = threadIdx.x; asm volatile("" : "+v"(tid_)); const int tid = tid_;
  const float* A = layer == 0 ? p.meta : p.hFm;
  int kind, sub;
  if (grp < 4) { kind = 0; sub = grp; } else if (grp == 4) { kind = 6; sub = 0; } else { kind = 1 + (grp - 5) / 4; sub = (grp - 5) % 4; }
  const int colbase = (kind == 0 ? O_QA : kind == 6 ? O_CKV : kind == 1 ? O_GA : kind == 2 ? O_QH : kind == 3 ? O_FH : kind == 4 ? O_IH : O_GH) + sub * 128;
  meta_group_gemm<false>(lds, A, p.w_in + (size_t)layer * D * NIN, NIN, colbase);
  LAS float* out = (LAS float*)(lds + M_PART);
  LAS float* rs = (LAS float*)(lds + M_PART + 2048 * 4);
  if (kind == 6) {
    if (tid < 16) { float s = 0.f; for (int c = 0; c < 128; ++c) { const float v = out[tid * 128 + c]; s = fmaf(v, v, s); } rs[tid] = rsqrtf(s * (1.0f / 128.0f) + EPS); }
    __syncthreads();
  }
  for (int i = tid; i < 2048; i += NTHREADS) {
    const int r = i >> 7, c = i & 127, cc = sub * 128 + c; const float v = out[i];
    if (kind == 0) p.qam[r * 512 + cc] = f2bf(v);
    else if (kind == 6) p.cNm[r * 128 + c] = f2bf(v * rs[r] * p.kvg[layer * 128 + c]);
    else if (kind == 1) p.gatesm[r * 1024 + cc] = f2bf(fast_silu(v));
    else if (kind == 2) p.qfm[r * 512 + cc] = f2bf(fast_silu(v) * 0.08838834764831845f);
    else if (kind == 3) { const float lb = p.lbv[layer * 512 + cc]; p.glm[r * 512 + cc] = __logf(lb + (1.0f - lb) * fast_sigmoid(v)); }
    else if (kind == 4) p.vvm[r * 512 + cc] = f2bf(v);
    else p.gatesm[r * 1024 + 512 + cc] = f2bf(fast_silu(v));
  }
  __syncthreads();
}
__device__ __forceinline__ void meta_outproj_group(const Params& p, LAS unsigned char* lds, const int grp) {
  int tid_ = threadIdx.x; asm volatile("" : "+v"(tid_)); const int tid = tid_;
  meta_group_gemm<true>(lds, p.gatesm, p.w_out, D, grp * 128);
  const LAS float* out = (const LAS float*)(lds + M_PART);
  for (int i = tid; i < 2048; i += NTHREADS) { const int r = i >> 7, c = grp * 128 + (i & 127); p.vm[r * D + c] = DN_ALPHA * p.meta[r * D + c] + out[i]; }
  __syncthreads();
}
__device__ __forceinline__ void meta_ln(const Params& p) {
  int tid_ = threadIdx.x; asm volatile("" : "+v"(tid_)); const int tid = tid_, wid = tid >> 6, lane = tid & 63;
  for (int row = wid; row < NM; row += 8) {
    f32x4 v[4]; float s = 0.f;
#pragma unroll
    for (int i = 0; i < 4; ++i) { v[i] = *(const f32x4*)(p.vm + row * D + (i * 64 + lane) * 4); s += (v[i][0] + v[i][1]) + (v[i][2] + v[i][3]); }
#pragma unroll
    for (int o = 32; o > 0; o >>= 1) s += __shfl_xor(s, o);
    const float mean = s * (1.0f / D); float q = 0.f;
#pragma unroll
    for (int i = 0; i < 4; ++i) { const f32x4 d = v[i] - mean; q += (d[0] * d[0] + d[1] * d[1]) + (d[2] * d[2] + d[3] * d[3]); }
#pragma unroll
    for (int o = 32; o > 0; o >>= 1) q += __shfl_xor(q, o);
    const float rstd = rsqrtf(q * (1.0f / D) + EPS);
#pragma unroll
    for (int i = 0; i < 4; ++i) { const int c = (i * 64 + lane) * 4; *(f32x4*)(p.hFm + row * D + c) = (v[i] - mean) * rstd * *(const f32x4*)(p.ln_g + c) + *(const f32x4*)(p.ln_b + c); }
  }
}

constexpr int N_HGRN_BLOCKS = NB * 4;
__global__ void __launch_bounds__(NTHREADS, 2) k_mega(Params p) {
  extern __shared__ __attribute__((aligned(16))) unsigned char smem[];
  LAS unsigned char* lds = (LAS unsigned char*)smem;
  cooperative_groups::grid_group grid = cooperative_groups::this_grid();
  const int bid = blockIdx.x, G = gridDim.x;
  phase_prep(p, lds);
  __syncthreads();
  if (bid >= G - 25) {
    { int t_ = threadIdx.x; asm volatile("" : "+v"(t_)); for (int i = t_; i < 512; i += NTHREADS) p.lbv[i] = 0.f; }
    __syncthreads();
    meta_inproj_group(p, 0, lds, bid - (G - 25));
  }
  grid.sync();
#pragma unroll
  for (int layer = 0; layer < DEPTH; ++layer) {
    if (layer == 1 && bid < 25) meta_inproj_group(p, 1, lds, bid);
    {
      SrcP1 Sp{(const char*)p.hHi, (const char*)p.hLo, (const char*)(p.WmT + (size_t)layer * 3072 * 1024), (const char*)(p.WsT + (size_t)layer * 512 * 3072)};
      EpiP1 E{p, layer};
      gemm_phase<SrcP1, EpiP1>(lds, Sp, R / BM, 14, E);
    }
    grid.sync();
    if (bid < N_HGRN_BLOCKS) phase_hgrn(p, layer, lds, bid);
    else phase_attn(p, layer, lds, bid - N_HGRN_BLOCKS, G - N_HGRN_BLOCKS, layer == 0);
    grid.sync();
    if (layer == 0 && bid < 8) meta_outproj_group(p, lds, bid);
    {
      SrcP3 Sp{(const char*)p.gates, (const char*)(p.WoT + (size_t)layer * 1024 * 1024)};
      EpiP3 E{p, layer == 0 ? p.x : p.hF};
      gemm_phase<SrcP3, EpiP3>(lds, Sp, R / BM, 4, E);
    }
    grid.sync();
    if (layer == 0) { phase_ln(p, 0, p.hF, true); if (bid == G - 1) meta_ln(p); grid.sync(); }
    else phase_ln(p, 1, p.out, false);
  }
}

}

extern "C" void kernel_launch(void* const* d_in, const int* in_sizes, int n_in, void* d_out, int out_size, void* d_ws, size_t ws_size,
                              hipStream_t stream) {
  Params p{};
  p.x = (const float*)d_in[0]; p.meta = (const float*)d_in[1]; p.rel_bias = (const float*)d_in[2]; p.lbraw = (const float*)d_in[3];
  p.w_in = (const float*)d_in[4]; p.kvg = (const float*)d_in[5]; p.w_uk = (const float*)d_in[6]; p.w_uv = (const float*)d_in[7];
  p.hng = (const float*)d_in[8]; p.w_out = (const float*)d_in[9]; p.ln_g = (const float*)d_in[10]; p.ln_b = (const float*)d_in[11];
  p.out = (float*)d_out;
  char* w = (char*)d_ws; size_t off = 0;
  auto take = [&](size_t bytes) { char* q = w + off; off += (bytes + 255) & ~(size_t)255; return q; };
  p.hF = (float*)take((size_t)R * D * 4); p.hFm = (float*)take((size_t)NM * D * 4);
  p.hHi = (bf16_t*)take((size_t)R * D * 2); p.hHim = (bf16_t*)take((size_t)NM * D * 2);
  p.hLo = (bf16_t*)take((size_t)R * D * 2); p.hLom = (bf16_t*)take((size_t)NM * D * 2);
  p.qa = (bf16_t*)take((size_t)R * 512 * 2); p.qam = (bf16_t*)take((size_t)NM * 512 * 2);
  p.cN = (bf16_t*)take((size_t)R * 128 * 2); p.cNm = (bf16_t*)take((size_t)NM * 128 * 2);
  p.gates = (bf16_t*)take((size_t)R * 1024 * 2); p.gatesm = (bf16_t*)take((size_t)NM * 1024 * 2);
  p.qfm = (bf16_t*)take((size_t)NM * 512 * 2); p.glm = (float*)take((size_t)NM * 512 * 4); p.vvm = (bf16_t*)take((size_t)NM * 512 * 2);
  p.qiH = (bf16_t*)take((size_t)R * 256 * 2); p.qiL = (bf16_t*)take((size_t)R * 256 * 2);
  p.kiH = (bf16_t*)take((size_t)R * 64 * 2); p.kiL = (bf16_t*)take((size_t)R * 64 * 2);
  p.wi = (float*)take((size_t)R * 4 * 4);
  p.sel = (int*)take((size_t)R * TOPK * 4); p.nsel = (int*)take((size_t)R * 4);
  p.proj = (float*)take((size_t)NM * NIN * 4);
  p.ych = (float*)take((size_t)NM * D * 4);
  p.WmT = (bf16_t*)take((size_t)DEPTH * 3072 * 1024 * 2); p.WsT = (bf16_t*)take((size_t)DEPTH * 512 * 3072 * 2); p.WoT = (bf16_t*)take((size_t)DEPTH * 1024 * 1024 * 2);
  p.lbv = (float*)take((size_t)DEPTH * 512 * 4);
  p.stats = (float*)take((size_t)R * 16 * 2 * 4); p.statsm = (float*)take(256);
  p.vm = (float*)take((size_t)NM * D * 4);
  p.wukT = (bf16_t*)take((size_t)DEPTH * 8 * 128 * 64 * 2); p.wuvT = (bf16_t*)take((size_t)DEPTH * 8 * 64 * 128 * 2);
  if (off > ws_size) return;
  p.gl = (float*)d_out; p.qf = (bf16_t*)((char*)d_out + (size_t)R * 512 * 4); p.vv = (bf16_t*)((char*)d_out + (size_t)R * 512 * 4 + (size_t)R * 512 * 2);

  static int grid_blocks = 0;
  if (!grid_blocks) {
    (void)hipFuncSetAttribute((const void*)k_mega, hipFuncAttributeMaxDynamicSharedMemorySize, LDS_BYTES);
    int dev = 0, cus = 0, per_cu = 0;
    (void)hipGetDevice(&dev);
    (void)hipDeviceGetAttribute(&cus, hipDeviceAttributeMultiprocessorCount, dev);
    (void)hipOccupancyMaxActiveBlocksPerMultiprocessor(&per_cu, (const void*)k_mega, NTHREADS, LDS_BYTES);
    grid_blocks = per_cu >= 1 ? cus : 0;
    if (grid_blocks > 256) grid_blocks = 256;
  }
  if (grid_blocks < 64) return;
  void* args[] = {(void*)&p};
  (void)hipLaunchCooperativeKernel((const void*)k_mega, dim3(grid_blocks), dim3(NTHREADS), args, LDS_BYTES, stream);
}
```

```cpp
#include <hip/hip_runtime.h>
#include <hip/hip_cooperative_groups.h>
#include <stdint.h>

namespace {
typedef unsigned short bf16_t;
constexpr int D = 1024, NB = 8, S = 4096, NM = 16, NIN = 3524, DEPTH = 2;
constexpr int R = NB * S;
constexpr int O_QA = 0, O_CKV = 512, O_QI = 640, O_KI = 896, O_WI = 960, O_GA = 964, O_QH = 1476, O_FH = 1988, O_IH = 2500, O_GH = 3012;
constexpr int TOPK = 256;
constexpr float EPS = 1e-6f;
constexpr float DN_ALPHA = 1.4142135623730951f;

__constant__ unsigned char c_bucket[128] = {
  0, 1, 2, 3, 4, 5, 6, 7, 8, 9, 10, 11, 12, 13, 14, 15, 16, 16, 16, 17, 17, 18, 18, 18, 19, 19, 19, 20, 20, 20, 20, 21,
  21, 21, 21, 22, 22, 22, 22, 22, 23, 23, 23, 23, 23, 23, 24, 24, 24, 24, 24, 24, 25, 25, 25, 25, 25, 25, 25, 26, 26, 26, 26, 26,
  26, 26, 26, 27, 27, 27, 27, 27, 27, 27, 27, 27, 27, 28, 28, 28, 28, 28, 28, 28, 28, 28, 28, 29, 29, 29, 29, 29, 29, 29, 29, 29,
  29, 29, 29, 30, 30, 30, 30, 30, 30, 30, 30, 30, 30, 30, 30, 30, 30, 31, 31, 31, 31, 31, 31, 31, 31, 31, 31, 31, 31, 31, 31, 31};

__device__ __forceinline__ int t5_bucket(int dist) { int n = dist < 0 ? 0 : dist; return n >= 128 ? 31 : (int)c_bucket[n]; }
__device__ __forceinline__ float sigmoidf_(float x) { return 1.0f / (1.0f + expf(-x)); }
__device__ __forceinline__ float siluf_(float x) { return x / (1.0f + expf(-x)); }
__device__ __forceinline__ bf16_t f2bf(float f) { unsigned u = __float_as_uint(f); u += 0x7fffu + ((u >> 16) & 1u); return (bf16_t)(u >> 16); }
__device__ __forceinline__ float bf2f(bf16_t h) { return __uint_as_float(((unsigned)h) << 16); }

struct Params {
  const float *x, *meta, *rel_bias, *lbraw, *w_in, *kvg, *w_uk, *w_uv, *hng, *w_out, *ln_g, *ln_b;
  float* out;
  float *hF, *hFm;
  bf16_t *hHi, *hHim, *hLo, *hLom;
  bf16_t *qa, *qam;
  bf16_t *cN, *cNm;
  bf16_t *gates, *gatesm;
  bf16_t *qf, *qfm;
  float *gl, *glm;
  bf16_t *vv, *vvm;
  bf16_t *qiH, *qiL;
  bf16_t *kiH, *kiL;
  float* wi;
  int* sel; int* nsel;
  float* proj;
  float* ych;
  bf16_t* WmT;
  bf16_t* WsT;
  bf16_t* WoT;
  float* lbv;
  float* stats;
  float* statsm;
  float* vm;
  bf16_t* dummy;
  unsigned* bar;
  unsigned long long* ts;
  bf16_t* wukT;
  bf16_t* wuvT;
};

template <typename TA>
__global__ __launch_bounds__(256) void k_sgemm(const TA* __restrict__ A, int lda, const float* __restrict__ Bm, int ldb,
                                               float* __restrict__ C, int ldc, int M, int N, int K) {
  __shared__ float As[16][64 + 4];
  __shared__ float Bs[16][64 + 4];
  const int tx = threadIdx.x & 15, ty = threadIdx.x >> 4;
  const int m0 = blockIdx.y * 64, n0 = blockIdx.x * 64;
  float acc[4][4] = {};
  for (int k0 = 0; k0 < K; k0 += 16) {
    for (int i = threadIdx.x; i < 64 * 16; i += 256) {
      int r = i >> 4, c = i & 15; int gm = m0 + r;
      float v = 0.f;
      if (gm < M) { if constexpr (sizeof(TA) == 2) v = bf2f(A[(size_t)gm * lda + k0 + c]); else v = A[(size_t)gm * lda + k0 + c]; }
      As[c][r] = v;
    }
    for (int i = threadIdx.x; i < 16 * 64; i += 256) {
      int r = i >> 6, c = i & 63; int gn = n0 + c;
      Bs[r][c] = gn < N ? Bm[(size_t)(k0 + r) * ldb + gn] : 0.f;
    }
    __syncthreads();
#pragma unroll
    for (int kk = 0; kk < 16; ++kk) {
      float a[4], b[4];
#pragma unroll
      for (int i = 0; i < 4; ++i) a[i] = As[kk][ty * 4 + i];
#pragma unroll
      for (int j = 0; j < 4; ++j) b[j] = Bs[kk][tx * 4 + j];
#pragma unroll
      for (int i = 0; i < 4; ++i)
#pragma unroll
        for (int j = 0; j < 4; ++j) acc[i][j] = fmaf(a[i], b[j], acc[i][j]);
    }
    __syncthreads();
  }
#pragma unroll
  for (int i = 0; i < 4; ++i) {
    int gm = m0 + ty * 4 + i; if (gm >= M) continue;
#pragma unroll
    for (int j = 0; j < 4; ++j) { int gn = n0 + tx * 4 + j; if (gn < N) C[(size_t)gm * ldc + gn] = acc[i][j]; }
  }
}

__global__ __launch_bounds__(256) void k_epi(Params p, int layer, int row0, int is_meta) {
  const int lr = blockIdx.x, tid = threadIdx.x;
  const float* pr = p.proj + (size_t)lr * NIN;
  const size_t r = (size_t)row0 + lr;
  bf16_t* qa = (is_meta ? p.qam : p.qa) + r * 512;
  bf16_t* cN = (is_meta ? p.cNm : p.cN) + r * 128;
  bf16_t* gates = (is_meta ? p.gatesm : p.gates) + r * 1024;
  bf16_t* qf = (is_meta ? p.qfm : p.qf) + r * 512;
  float* gl = (is_meta ? p.glm : p.gl) + r * 512;
  bf16_t* vv = (is_meta ? p.vvm : p.vv) + r * 512;
  __shared__ float red[256];
  for (int c = tid; c < 512; c += 256) {
    qa[c] = f2bf(pr[O_QA + c]);
    gates[c] = f2bf(siluf_(pr[O_GA + c]));
    gates[512 + c] = f2bf(siluf_(pr[O_GH + c]));
    qf[c] = f2bf(siluf_(pr[O_QH + c]) * 0.08838834764831845f);
    vv[c] = f2bf(pr[O_IH + c]);
    int hk = c;
    float lb = 0.f;
    if (layer == 1) { float r0 = p.lbraw[hk], r1 = p.lbraw[512 + hk]; float m = fmaxf(r0, r1); float e0 = expf(r0 - m), e1 = expf(r1 - m); lb = e1 / (e0 + e1); }
    float f = lb + (1.0f - lb) * sigmoidf_(pr[O_FH + c]);
    gl[c] = logf(f);
  }
  float v = tid < 128 ? pr[O_CKV + tid] : 0.f;
  red[tid] = v * v; __syncthreads();
  for (int s = 128; s > 0; s >>= 1) { if (tid < s) red[tid] += red[tid + s]; __syncthreads(); }
  float rstd = rsqrtf(red[0] / 128.f + EPS);
  if (tid < 128) cN[tid] = f2bf(v * rstd * p.kvg[layer * 128 + tid]);
  if (!is_meta) {
    { float q = pr[O_QI + tid] * 0.125f; bf16_t h = f2bf(q); p.qiH[r * 256 + tid] = h; p.qiL[r * 256 + tid] = f2bf(q - bf2f(h)); }
    if (tid < 64) { float k = pr[O_KI + tid]; bf16_t h = f2bf(k); p.kiH[r * 64 + tid] = h; p.kiL[r * 64 + tid] = f2bf(k - bf2f(h)); }
    if (tid < 4) p.wi[r * 4 + tid] = pr[O_WI + tid] * 0.5f;
  }
}

__device__ __forceinline__ unsigned f2key(float f) { unsigned u = __float_as_uint(f); return (u & 0x80000000u) ? ~u : (u | 0x80000000u); }

__global__ __launch_bounds__(256) void k_topk(Params p) {
  const int gq = blockIdx.x, b = gq / S, t = gq % S, tid = threadIdx.x;
  const int n = t + 1;
  int* sel = p.sel + (size_t)gq * TOPK;
  if (n <= TOPK) {
    for (int i = tid; i < TOPK; i += 256) sel[i] = i < n ? i : 0;
    if (tid == 0) p.nsel[gq] = n;
    return;
  }
  __shared__ float q[256];
  __shared__ float w[4];
  __shared__ unsigned keys[S];
  __shared__ unsigned hist[256];
  __shared__ unsigned s_prefix, s_need;
  __shared__ unsigned cg[256], ce[256];
  q[tid] = bf2f(p.qiH[(size_t)gq * 256 + tid]) + bf2f(p.qiL[(size_t)gq * 256 + tid]);
  if (tid < 4) w[tid] = p.wi[(size_t)gq * 4 + tid];
  __syncthreads();
  for (int s = tid; s < n; s += 256) {
    const bf16_t* kh = p.kiH + ((size_t)b * S + s) * 64;
    const bf16_t* kl = p.kiL + ((size_t)b * S + s) * 64;
    float sc = 0.f;
#pragma unroll 1
    for (int h = 0; h < 4; ++h) {
      float d = 0.f;
#pragma unroll 8
      for (int j = 0; j < 64; ++j) d = fmaf(q[h * 64 + j], bf2f(kh[j]) + bf2f(kl[j]), d);
      sc = fmaf(w[h], fmaxf(d, 0.f), sc);
    }
    keys[s] = f2key(sc);
  }
  if (tid == 0) { s_prefix = 0; s_need = TOPK; }
  __syncthreads();
  for (int d = 3; d >= 0; --d) {
    hist[tid] = 0; __syncthreads();
    unsigned prefix = s_prefix;
    for (int s = tid; s < n; s += 256) {
      unsigned k = keys[s];
      bool match = (d == 3) ? true : ((k >> (8 * (d + 1))) == prefix);
      if (match) atomicAdd(&hist[(k >> (8 * d)) & 255u], 1u);
    }
    __syncthreads();
    if (tid == 0) {
      unsigned need = s_need, cum = 0; int bin = 255;
      for (; bin > 0; --bin) { if (cum + hist[bin] >= need) break; cum += hist[bin]; }
      s_prefix = (prefix << 8) | (unsigned)bin; s_need = need - cum;
    }
    __syncthreads();
  }
  const unsigned T = s_prefix, need = s_need;
  const int per = (n + 255) / 256;
  const int s0 = tid * per, s1 = min(n, s0 + per);
  unsigned ng = 0, ne = 0;
  for (int s = s0; s < s1; ++s) { unsigned k = keys[s]; ng += k > T; ne += k == T; }
  cg[tid] = ng; ce[tid] = ne; __syncthreads();
  if (tid == 0) { unsigned a = 0, bb = 0; for (int i = 0; i < 256; ++i) { unsigned xx = cg[i], yy = ce[i]; cg[i] = a; ce[i] = bb; a += xx; bb += yy; } }
  __syncthreads();
  unsigned og = cg[tid], oe = ce[tid];
  const unsigned ngt = TOPK - need;
  for (int s = s0; s < s1; ++s) {
    unsigned k = keys[s];
    if (k > T) sel[og++] = s;
    else if (k == T) { if (oe < need) sel[ngt + oe] = s; oe++; }
  }
  if (tid == 0) p.nsel[gq] = TOPK;
}

__global__ __launch_bounds__(256) void k_attn(Params p, int layer) {
  const int tid = threadIdx.x;
  const bool is_meta = blockIdx.x >= R;
  const int gq = is_meta ? (int)blockIdx.x - R : (int)blockIdx.x;
  const int b = is_meta ? 0 : gq / S, t = is_meta ? gq : gq % S;
  const int e = is_meta ? gq : NM + t;
  __shared__ float qa[512];
  __shared__ float ql[8 * 128];
  __shared__ int kidx[NM + TOPK];
  __shared__ float lg[8][NM + TOPK];
  __shared__ float ol[8 * 128];
  __shared__ float red[8];
  const bf16_t* qrow = (is_meta ? p.qam : p.qa) + (size_t)gq * 512;
  qa[tid] = bf2f(qrow[tid]); qa[tid + 256] = bf2f(qrow[tid + 256]);
  int nk;
  if (is_meta) { nk = gq + 1; for (int i = tid; i < nk; i += 256) kidx[i] = -1 - i; }
  else {
    int ns = p.nsel[gq]; nk = NM + ns;
    for (int i = tid; i < nk; i += 256) kidx[i] = i < NM ? -1 - i : p.sel[(size_t)gq * TOPK + (i - NM)];
  }
  __syncthreads();
  const float* w_uk = p.w_uk + (size_t)layer * 8 * 64 * 128;
  const float* w_uv = p.w_uv + (size_t)layer * 8 * 128 * 64;
  for (int o = tid; o < 1024; o += 256) {
    int h = o >> 7, cc = o & 127; float a = 0.f;
    const float* wk = w_uk + (size_t)h * 64 * 128 + cc;
#pragma unroll 8
    for (int d = 0; d < 64; ++d) a = fmaf(qa[h * 64 + d], wk[(size_t)d * 128], a);
    ql[o] = a;
  }
  __syncthreads();
  for (int pp = tid; pp < 8 * nk; pp += 256) {
    int h = pp / nk, j = pp % nk; int kr = kidx[j];
    const bf16_t* cr = kr < 0 ? p.cNm + (size_t)(-1 - kr) * 128 : p.cN + ((size_t)b * S + kr) * 128;
    int kpos = kr < 0 ? (-1 - kr) : NM + kr;
    float a = 0.f;
#pragma unroll 8
    for (int cc = 0; cc < 128; ++cc) a = fmaf(ql[h * 128 + cc], bf2f(cr[cc]), a);
    lg[h][j] = a * 0.125f + p.rel_bias[t5_bucket(e - kpos) * 8 + h];
  }
  __syncthreads();
  {
    int h = tid >> 5, l = tid & 31;
    float m = -INFINITY;
    for (int j = l; j < nk; j += 32) m = fmaxf(m, lg[h][j]);
    for (int o = 16; o > 0; o >>= 1) m = fmaxf(m, __shfl_xor(m, o));
    float s = 0.f;
    for (int j = l; j < nk; j += 32) { float pr = expf(lg[h][j] - m); lg[h][j] = pr; s += pr; }
    for (int o = 16; o > 0; o >>= 1) s += __shfl_xor(s, o);
    if (l == 0) red[h] = 1.0f / s;
  }
  __syncthreads();
  for (int o = tid; o < 1024; o += 256) {
    int h = o >> 7, cc = o & 127; float a = 0.f;
#pragma unroll 4
    for (int j = 0; j < nk; ++j) { int kr = kidx[j]; const bf16_t* cr = kr < 0 ? p.cNm + (size_t)(-1 - kr) * 128 : p.cN + ((size_t)b * S + kr) * 128; a = fmaf(lg[h][j], bf2f(cr[cc]), a); }
    ol[o] = a * red[h];
  }
  __syncthreads();
  bf16_t* grow = (is_meta ? p.gatesm : p.gates) + (size_t)gq * 1024;
  for (int o = tid; o < 512; o += 256) {
    int h = o >> 6, d = o & 63; float a = 0.f;
    const float* wv = w_uv + (size_t)h * 128 * 64 + d;
#pragma unroll 8
    for (int cc = 0; cc < 128; ++cc) a = fmaf(ol[h * 128 + cc], wv[(size_t)cc * 64], a);
    grow[o] = f2bf(a * bf2f(grow[o]));
  }
}

__global__ __launch_bounds__(256) void k_hgrn(Params p, int layer) {
  const int b = blockIdx.x >> 2, h = blockIdx.x & 3, tid = threadIdx.x, v = tid & 127, kh = tid >> 7;
  __shared__ float sq[128], sf[128], sk[128], sv[128];
  __shared__ float so[2][128];
  __shared__ float sred[128];
  const float* gnorm = p.hng + layer * 128;
  float St[64];
#pragma unroll
  for (int i = 0; i < 64; ++i) St[i] = 0.f;
  for (int e = 0; e < NM + S; ++e) {
    const bool im = e < NM;
    const size_t r = im ? (size_t)e : (size_t)b * S + (e - NM);
    const bf16_t* qf = (im ? p.qfm : p.qf) + r * 512 + h * 128;
    const float* gl = (im ? p.glm : p.gl) + r * 512 + h * 128;
    const bf16_t* vv = (im ? p.vvm : p.vv) + r * 512 + h * 128;
    bf16_t* gt = (im ? p.gatesm : p.gates) + r * 1024 + 512 + h * 128;
    if (tid < 128) {
      float f = expf(gl[tid]);
      sq[tid] = bf2f(qf[tid]); sf[tid] = f; sk[tid] = 1.0f - f; sv[tid] = bf2f(vv[tid]);
    }
    __syncthreads();
    float vval = sv[v], o = 0.f;
#pragma unroll
    for (int i = 0; i < 64; ++i) { int k = kh * 64 + i; St[i] = fmaf(sf[k], St[i], sk[k] * vval); o = fmaf(sq[k], St[i], o); }
    so[kh][v] = o;
    __syncthreads();
    if (tid < 128) { float ot = so[0][tid] + so[1][tid]; so[0][tid] = ot; sred[tid] = ot * ot; }
    __syncthreads();
    for (int s = 64; s > 0; s >>= 1) { if (tid < s) sred[tid] += sred[tid + s]; __syncthreads(); }
    if (tid < 128 && (!im || b == 0)) {
      float rstd = rsqrtf(sred[0] / 128.f + EPS);
      gt[tid] = f2bf(so[0][tid] * rstd * gnorm[tid] * bf2f(gt[tid]));
    }
    __syncthreads();
  }
}

__global__ __launch_bounds__(256) void k_ln(const float* __restrict__ h, const float* __restrict__ y, const float* __restrict__ g,
                                            const float* __restrict__ bb, float* __restrict__ dst, bf16_t* __restrict__ hi, bf16_t* __restrict__ lo) {
  const int row = blockIdx.x, tid = threadIdx.x;
  __shared__ float red[256];
  float v[4]; float s = 0.f;
  for (int i = 0; i < 4; ++i) { int c = tid + 256 * i; v[i] = DN_ALPHA * h[(size_t)row * D + c] + y[(size_t)row * D + c]; s += v[i]; }
  red[tid] = s; __syncthreads();
  for (int o = 128; o > 0; o >>= 1) { if (tid < o) red[tid] += red[tid + o]; __syncthreads(); }
  float mu = red[0] / D; __syncthreads();
  float q = 0.f;
  for (int i = 0; i < 4; ++i) { float d = v[i] - mu; q += d * d; }
  red[tid] = q; __syncthreads();
  for (int o = 128; o > 0; o >>= 1) { if (tid < o) red[tid] += red[tid + o]; __syncthreads(); }
  float rstd = rsqrtf(red[0] / D + EPS);
  for (int i = 0; i < 4; ++i) {
    int c = tid + 256 * i; float o = (v[i] - mu) * rstd * g[c] + bb[c];
    dst[(size_t)row * D + c] = o;
    if (hi) { bf16_t hh = f2bf(o); hi[(size_t)row * D + c] = hh; lo[(size_t)row * D + c] = f2bf(o - bf2f(hh)); }
  }
}
#define LAS __attribute__((address_space(3)))
typedef short bf16x8 __attribute__((ext_vector_type(8)));
typedef float f32x4 __attribute__((ext_vector_type(4)));
typedef unsigned u32x2 __attribute__((ext_vector_type(2)));
typedef unsigned u32x4 __attribute__((ext_vector_type(4)));
constexpr int NTHREADS = 512;
constexpr int LDS_BYTES = 160 * 1024;
constexpr int BM = 256, BK = 64, HALF = 128, HTB = HALF * BK * 2, STAGE_BYTES = 8 * HTB;
constexpr int LDS_EXTRA = STAGE_BYTES;
#define TPROBE 0
#define TP_S 0
#define TP_E 1
#define TP_LO 0
#define TP_HI 256
#define TS_MARK(k) do { if (TPROBE && threadIdx.x == 0) p.ts[(size_t)blockIdx.x * 64 + (k)] = __builtin_amdgcn_s_memrealtime(); } while (0)
#define TS_ACC_BEGIN() unsigned long long tacc_ = TPROBE ? __builtin_amdgcn_s_memrealtime() : 0ull
#define TS_ACC(k) do { if (TPROBE) { const unsigned long long t2_ = __builtin_amdgcn_s_memrealtime(); if (threadIdx.x == 0) p.ts[(size_t)blockIdx.x * 64 + (k)] += t2_ - tacc_; tacc_ = t2_; } } while (0)
#define PROBE_REP_SCORE 0
#define ABL_SCORE 0
#define PROBE_REP_SELECT 0
#define PROBE_REP_ATT 0
#define PROBE_REP_QLAT 0

__device__ __forceinline__ unsigned pack_bf16(float lo, float hi) { return (unsigned)f2bf(lo) | ((unsigned)f2bf(hi) << 16); }
__device__ __forceinline__ float fast_sigmoid(float x) { return 1.0f / (1.0f + __expf(-x)); }
__device__ __forceinline__ float fast_silu(float x) { return x / (1.0f + __expf(-x)); }

__device__ __forceinline__ int lds_byte(int r, int c) { const int st = (r >> 4) * 2 + (c >> 5), rr = r & 15, cc = c & 31, ob = rr * 64 + cc * 2; return st * 1024 + (ob ^ (((ob >> 9) & 1) << 5)); }
__device__ __forceinline__ void stage_rc(int b, int& Rr, int& Cc) { const int st = b / 1024, sb = b % 1024, swz = sb ^ (((sb >> 9) & 1) << 5); Rr = (st >> 1) * 16 + swz / 64; Cc = (st & 1) * 32 + (swz % 64) / 2; }

struct GUnit { int pm, pn; };
__device__ __forceinline__ bool unit_next(int i, int nM, int nN, GUnit& u) {
  const int nwg = nM * nN; const long L = (long)i * gridDim.x + blockIdx.x; if (L >= nwg) return false;
  int wgid = (int)L; { const int q = nwg / 8, r = nwg % 8, xcd = wgid % 8, off = wgid / 8; wgid = (xcd < r ? xcd * (q + 1) : r * (q + 1) + (xcd - r) * q) + off; }
  const int nig = 8 * nN, gid = wgid / nig, fm = gid * 8, gsz = (nM - fm) < 8 ? (nM - fm) : 8;
  u.pm = fm + ((wgid % nig) % gsz); u.pn = (wgid % nig) / gsz; return true;
}

struct SrcP1 {
  const char* Ahi; const char* Alo; const char* Wm; const char* Ws;
  __device__ __forceinline__ int nt(const GUnit& u) const { return u.pn < 12 ? 16 : 48; }
  __device__ __forceinline__ int ldb(const GUnit& u) const { return u.pn < 12 ? 1024 : 3072; }
  __device__ __forceinline__ const char* a(const GUnit& u, int kt) const { const char* b = (kt >= 16 && kt < 32) ? Alo : Ahi; return b + (size_t)u.pm * (256 * 1024 * 2) + (size_t)(kt & 15) * 128; }
  __device__ __forceinline__ const char* b(const GUnit& u, int kt) const { return u.pn < 12 ? Wm + (size_t)u.pn * (256 * 1024 * 2) + (size_t)kt * 128 : Ws + (size_t)(u.pn - 12) * (256 * 3072 * 2) + (size_t)kt * 128; }
};
struct SrcP3 {
  const char* A; const char* W;
  __device__ __forceinline__ int nt(const GUnit&) const { return 16; }
  __device__ __forceinline__ int ldb(const GUnit&) const { return 1024; }
  __device__ __forceinline__ const char* a(const GUnit& u, int kt) const { return A + (size_t)u.pm * (256 * 1024 * 2) + (size_t)kt * 128; }
  __device__ __forceinline__ const char* b(const GUnit& u, int kt) const { return W + (size_t)u.pn * (256 * 1024 * 2) + (size_t)kt * 128; }
};


template <int CTRL, int ROWMASK = 0xf, bool BC = true>
__device__ __forceinline__ float dppf(float v) { return __int_as_float(__builtin_amdgcn_update_dpp(0, __float_as_int(v), CTRL, ROWMASK, 0xf, BC)); }
__device__ __forceinline__ float row_sum16(float v) { v += dppf<0x128>(v); v += dppf<0x124>(v); v += dppf<0x122>(v); v += dppf<0x121>(v); return v; }
__device__ __forceinline__ unsigned wave_incl_scan(unsigned v) {
  v += (unsigned)__builtin_amdgcn_update_dpp(0, (int)v, 0x111, 0xf, 0xf, true);
  v += (unsigned)__builtin_amdgcn_update_dpp(0, (int)v, 0x112, 0xf, 0xf, true);
  v += (unsigned)__builtin_amdgcn_update_dpp(0, (int)v, 0x114, 0xf, 0xf, true);
  v += (unsigned)__builtin_amdgcn_update_dpp(0, (int)v, 0x118, 0xf, 0xf, true);
  v += (unsigned)__builtin_amdgcn_update_dpp(0, (int)v, 0x142, 0xa, 0xf, false);
  v += (unsigned)__builtin_amdgcn_update_dpp(0, (int)v, 0x143, 0xc, 0xf, false);
  return v;
}
__device__ __forceinline__ float rows_max(float x) {
  auto r = __builtin_amdgcn_permlane16_swap(__float_as_uint(x), __float_as_uint(x), false, false); x = fmaxf(__uint_as_float(r[0]), __uint_as_float(r[1]));
  auto q = __builtin_amdgcn_permlane32_swap(__float_as_uint(x), __float_as_uint(x), false, false); return fmaxf(__uint_as_float(q[0]), __uint_as_float(q[1])); }
__device__ __forceinline__ float rows_sum(float x) {
  auto r = __builtin_amdgcn_permlane16_swap(__float_as_uint(x), __float_as_uint(x), false, false); x = __uint_as_float(r[0]) + __uint_as_float(r[1]);
  auto q = __builtin_amdgcn_permlane32_swap(__float_as_uint(x), __float_as_uint(x), false, false); return __uint_as_float(q[0]) + __uint_as_float(q[1]); }
__device__ __forceinline__ size_t kfrag(size_t row, int c) { return (((((row >> 4) * 2 + (size_t)(c >> 5)) * 4 + (size_t)((c >> 3) & 3)) * 16 + (row & 15)) * 8) + (size_t)(c & 7); }

struct EpiP1 {
  Params p; int layer;
  __device__ __forceinline__ void operator()(const f32x4 (&acc)[2][2][4][2], const GUnit& u, int wr, int wc, int fr, int fq, LAS unsigned char* lds) const {
    const int row0 = u.pm * BM + wr * 64 + fr;
    if (u.pn < 12) {
      const int kind = u.pn >> 1; const int c00 = (u.pn & 1) * 256 + wc * 32 + 4 * fq;
#pragma unroll
      for (int ai = 0; ai < 2; ++ai)
#pragma unroll
        for (int m = 0; m < 4; ++m) {
          const size_t row = (size_t)(row0 + ai * HALF + m * 16);
#pragma unroll
          for (int bj = 0; bj < 2; ++bj)
#pragma unroll
            for (int n = 0; n < 2; ++n) {
              const int c = c00 + bj * HALF + n * 16; f32x4 v = acc[ai][bj][m][n];
              if (kind == 3) {
                const f32x4 lb = *(const f32x4*)(p.lbv + layer * 512 + c); f32x4 o;
#pragma unroll
                for (int j = 0; j < 4; ++j) o[j] = __logf(lb[j] + (1.0f - lb[j]) * fast_sigmoid(v[j]));
                *(f32x4*)(p.gl + row * 512 + c) = o;
              } else {
                if (kind == 1 || kind == 5) {
#pragma unroll
                  for (int j = 0; j < 4; ++j) v[j] = fast_silu(v[j]);
                } else if (kind == 2) {
#pragma unroll
                  for (int j = 0; j < 4; ++j) v[j] = fast_silu(v[j]) * 0.08838834764831845f;
                }
                u32x2 w; w.x = pack_bf16(v[0], v[1]); w.y = pack_bf16(v[2], v[3]);
                bf16_t* dst = kind == 0 ? p.qa + row * 512 + c : kind == 1 ? p.gates + row * 1024 + c : kind == 2 ? p.qf + row * 512 + c
                            : kind == 4 ? p.vv + row * 512 + c : p.gates + row * 1024 + 512 + c;
                *(u32x2*)dst = w;
              }
            }
        }
    } else if (u.pn == 12) {
      const int c00 = wc * 32 + 4 * fq;
#pragma unroll
      for (int ai = 0; ai < 2; ++ai)
#pragma unroll
        for (int m = 0; m < 4; ++m) {
          const size_t row = (size_t)(row0 + ai * HALF + m * 16);
#pragma unroll
          for (int bj = 0; bj < 2; ++bj)
#pragma unroll
            for (int n = 0; n < 2; ++n) {
              const int c = c00 + bj * HALF + n * 16; const f32x4 v = acc[ai][bj][m][n] * 0.125f;
              bf16_t h[4], l[4];
#pragma unroll
              for (int j = 0; j < 4; ++j) { h[j] = f2bf(v[j]); l[j] = f2bf(v[j] - bf2f(h[j])); }
              u32x2 wh, wl; wh.x = (unsigned)h[0] | ((unsigned)h[1] << 16); wh.y = (unsigned)h[2] | ((unsigned)h[3] << 16);
              wl.x = (unsigned)l[0] | ((unsigned)l[1] << 16); wl.y = (unsigned)l[2] | ((unsigned)l[3] << 16);
              *(u32x2*)(p.qiH + row * 256 + c) = wh; *(u32x2*)(p.qiL + row * 256 + c) = wl;
            }
        }
    } else {
      LAS float* red = (LAS float*)(lds + LDS_EXTRA);
#pragma unroll
      for (int ai = 0; ai < 2; ++ai)
#pragma unroll
        for (int m = 0; m < 4; ++m) {
          float s = 0.f;
#pragma unroll
          for (int n = 0; n < 2; ++n) { const f32x4 v = acc[ai][0][m][n]; s += (v[0] * v[0] + v[1] * v[1]) + (v[2] * v[2] + v[3] * v[3]); }
          s = rows_sum(s);
          if (fq == 0) red[(ai * HALF + wr * 64 + m * 16 + fr) * 4 + wc] = s;
        }
      asm volatile("s_waitcnt lgkmcnt(0)" ::: "memory"); __builtin_amdgcn_s_barrier(); asm volatile("" ::: "memory");
#pragma unroll
      for (int ai = 0; ai < 2; ++ai)
#pragma unroll
        for (int m = 0; m < 4; ++m) {
          const int lr = ai * HALF + wr * 64 + m * 16 + fr; const size_t row = (size_t)(u.pm * BM + lr);
          const f32x4 pr = *(const LAS f32x4*)(red + lr * 4);
          const float rstd = rsqrtf(((pr[0] + pr[1]) + (pr[2] + pr[3])) * (1.0f / 128.0f) + EPS);
#pragma unroll
          for (int n = 0; n < 2; ++n) {
            const int c = wc * 32 + n * 16 + 4 * fq; const f32x4 g = *(const f32x4*)(p.kvg + layer * 128 + c); const f32x4 v = acc[ai][0][m][n] * rstd * g;
            u32x2 w; w.x = pack_bf16(v[0], v[1]); w.y = pack_bf16(v[2], v[3]); *(u32x2*)(p.cN + row * 128 + c) = w;
          }
          if (wc < 2) {
#pragma unroll
            for (int n = 0; n < 2; ++n) {
              const int c = wc * 32 + n * 16 + 4 * fq; const f32x4 v = acc[ai][1][m][n];
              bf16_t h[4], l[4];
#pragma unroll
              for (int j = 0; j < 4; ++j) { h[j] = f2bf(v[j]); l[j] = f2bf(v[j] - bf2f(h[j])); }
              u32x2 wh, wl; wh.x = (unsigned)h[0] | ((unsigned)h[1] << 16); wh.y = (unsigned)h[2] | ((unsigned)h[3] << 16);
              wl.x = (unsigned)l[0] | ((unsigned)l[1] << 16); wl.y = (unsigned)l[2] | ((unsigned)l[3] << 16);
              *(u32x2*)(p.kiH + kfrag(row, c)) = wh; *(u32x2*)(p.kiL + kfrag(row, c)) = wl;
            }
          } else if (wc == 2 && fq == 0) {
            *(f32x4*)(p.wi + row * 4) = acc[ai][1][m][0] * 0.5f;
          }
        }
    }
  }
};

struct EpiP3 {
  Params p; const float* hres;
  __device__ __forceinline__ void operator()(const f32x4 (&acc)[2][2][4][2], const GUnit& u, int wr, int wc, int fr, int fq, LAS unsigned char* lds) const {
    const int row0 = u.pm * BM + wr * 64 + fr; const int c00 = u.pn * BM + wc * 32 + 4 * fq;
#pragma unroll
    for (int ai = 0; ai < 2; ++ai)
#pragma unroll
      for (int m = 0; m < 4; ++m) {
        const size_t row = (size_t)(row0 + ai * HALF + m * 16); float s = 0.f, q = 0.f;
#pragma unroll
        for (int bj = 0; bj < 2; ++bj)
#pragma unroll
          for (int n = 0; n < 2; ++n) {
            const int c = c00 + bj * HALF + n * 16; const f32x4 h = *(const f32x4*)(hres + row * D + c);
            const f32x4 v = h * DN_ALPHA + acc[ai][bj][m][n];
            *(f32x4*)(p.hF + row * D + c) = v;
            s += (v[0] + v[1]) + (v[2] + v[3]); q += (v[0] * v[0] + v[1] * v[1]) + (v[2] * v[2] + v[3] * v[3]);
          }
        s = rows_sum(s); q = rows_sum(q);
        if (fq == 0) { float2 st; st.x = s; st.y = q; *(float2*)(p.stats + (row * 16 + u.pn * 4 + wc) * 2) = st; }
        asm volatile("" ::: "memory");
      }
  }
};

template <class Src, class Epi>
__device__ __forceinline__ void gemm_phase(LAS unsigned char* lds, const Src S, const int nM, const int nN, const Epi& E) {
  int tid_ = threadIdx.x; asm volatile("" : "+v"(tid_));
  const int tid = tid_, wid = __builtin_amdgcn_readfirstlane(tid >> 6), lane = tid & 63, wr = wid >> 2, wc = wid & 3, fr = lane & 15, fq = lane >> 4;
  unsigned voffA[2], voffB1[2], voffB3[2];
#pragma unroll
  for (int i = 0; i < 2; ++i) { int Rr, Cc; stage_rc(tid * 16 + i * 8192, Rr, Cc); voffA[i] = (unsigned)(Rr * 1024 + Cc) * 2u; voffB1[i] = voffA[i]; voffB3[i] = (unsigned)(Rr * 3072 + Cc) * 2u; }
  const size_t hstepA = (size_t)HALF * 1024 * 2;
  const unsigned ldsw = (unsigned)wid * 1024u;
  const int aoff = lds_byte(wr * 64 + fr, fq * 8), boff = lds_byte(wc * 32 + fr, fq * 8);
#define G_SA(b, h) (((b) * 2 + (h)) * HTB)
#define G_SB(b, h) ((4 + (b) * 2 + (h)) * HTB)
#define G_STAGE(bufoff, gbase, v0, v1) do { \
    __builtin_amdgcn_global_load_lds((const unsigned*)((const char*)(gbase) + (v0)), (LAS unsigned*)(lds + (bufoff) + ldsw), 16, 0, 0); \
    __builtin_amdgcn_global_load_lds((const unsigned*)((const char*)(gbase) + (v1)), (LAS unsigned*)(lds + (bufoff) + ldsw + 8192), 16, 0, 0); } while (0)
#define G_STAGE_A(bufoff, gbase) G_STAGE(bufoff, gbase, voffA[0], voffA[1])
#define G_LDA(dst, b, h) do { _Pragma("unroll") for (int m = 0; m < 4; ++m) _Pragma("unroll") for (int k = 0; k < 2; ++k) dst[m][k] = *(const LAS bf16x8*)(lds + G_SA(b, h) + aoff + m * 2048 + k * 1024); } while (0)
#define G_LDB(dst, b, h) do { _Pragma("unroll") for (int n = 0; n < 2; ++n) _Pragma("unroll") for (int k = 0; k < 2; ++k) dst[n][k] = *(const LAS bf16x8*)(lds + G_SB(b, h) + boff + n * 2048 + k * 1024); } while (0)
#define G_MMA(ai, bj, At, Bt) do { __builtin_amdgcn_s_setprio(1); _Pragma("unroll") for (int m = 0; m < 4; ++m) _Pragma("unroll") for (int n = 0; n < 2; ++n) _Pragma("unroll") for (int k = 0; k < 2; ++k) \
    acc[ai][bj][m][n] = __builtin_amdgcn_mfma_f32_16x16x32_bf16(Bt[n][k], At[m][k], acc[ai][bj][m][n], 0, 0, 0); __builtin_amdgcn_s_setprio(0); } while (0)
#define G_WAIT_V(n) asm volatile("s_waitcnt vmcnt(" #n ")" ::: "memory")
#define G_WAIT_L(n) asm volatile("s_waitcnt lgkmcnt(" #n ")" ::: "memory")
#define G_BAR __builtin_amdgcn_s_barrier()
#define G_SCHED __builtin_amdgcn_sched_barrier(0)
  GUnit cur, nxt; int ui = 0;
  if (!unit_next(0, nM, nN, cur)) return;
  f32x4 acc[2][2][4][2];
#pragma unroll
  for (int a = 0; a < 2; ++a)
#pragma unroll
    for (int b = 0; b < 2; ++b)
#pragma unroll
      for (int m = 0; m < 4; ++m)
#pragma unroll
        for (int n = 0; n < 2; ++n) acc[a][b][m][n] = (f32x4){0.f, 0.f, 0.f, 0.f};
  bf16x8 At[4][2], B0[2][2], B1[2][2];
  {
    const bool w3 = S.ldb(cur) == 3072; const unsigned vb0 = w3 ? voffB3[0] : voffB1[0], vb1 = w3 ? voffB3[1] : voffB1[1]; const size_t hsB = (size_t)HALF * S.ldb(cur) * 2;
    const char* cA0 = S.a(cur, 0); const char* cB0 = S.b(cur, 0); const char* cA1 = S.a(cur, 1); const char* cB1 = S.b(cur, 1);
    G_STAGE(G_SB(0, 0), cB0, vb0, vb1); G_STAGE_A(G_SA(0, 0), cA0); G_STAGE(G_SB(0, 1), cB0 + hsB, vb0, vb1); G_STAGE_A(G_SA(0, 1), cA0 + hstepA);
    if (wr == 1) G_BAR;
    G_WAIT_V(4); G_BAR;
    G_STAGE(G_SB(1, 0), cB1, vb0, vb1); G_STAGE_A(G_SA(1, 0), cA1); G_STAGE(G_SB(1, 1), cB1 + hsB, vb0, vb1);
    G_WAIT_V(6); G_BAR;
  }
  for (;;) {
    const bool has_next = unit_next(ui + 1, nM, nN, nxt);
    const GUnit nu = has_next ? nxt : cur;
    const int nt = S.nt(cur);
    const bool cw3 = S.ldb(cur) == 3072, nw3 = S.ldb(nu) == 3072;
    for (int t = 0; t < nt; t += 2) {
      const bool last = (t == nt - 2);
      const char* a1 = S.a(cur, t + 1);
      const char* a2 = last ? S.a(nu, 0) : S.a(cur, t + 2); const char* b2 = last ? S.b(nu, 0) : S.b(cur, t + 2);
      const char* a3 = last ? S.a(nu, 1) : S.a(cur, t + 3); const char* b3 = last ? S.b(nu, 1) : S.b(cur, t + 3);
      const bool w3 = last ? nw3 : cw3;
      const unsigned vb0 = w3 ? voffB3[0] : voffB1[0], vb1 = w3 ? voffB3[1] : voffB1[1]; const size_t hsB = w3 ? (size_t)HALF * 3072 * 2 : (size_t)HALF * 1024 * 2;
      G_LDB(B0, 0, 0); G_SCHED; G_LDA(At, 0, 0); G_STAGE_A(G_SA(1, 1), a1 + hstepA);
      G_WAIT_L(8); G_BAR; G_WAIT_L(0); G_MMA(0, 0, At, B0); G_BAR; G_SCHED;
      G_LDB(B1, 0, 1); G_STAGE(G_SB(0, 0), b2, vb0, vb1);
      G_BAR; G_WAIT_L(0); G_MMA(0, 1, At, B1); G_BAR;
      G_LDA(At, 0, 1); G_STAGE_A(G_SA(0, 0), a2);
      G_BAR; G_WAIT_L(0); G_MMA(1, 0, At, B0); G_BAR; G_SCHED;
      G_STAGE(G_SB(0, 1), b2 + hsB, vb0, vb1);
      G_WAIT_V(6); G_BAR; G_MMA(1, 1, At, B1); G_BAR;
      G_LDB(B0, 1, 0); G_SCHED; G_LDA(At, 1, 0); G_STAGE_A(G_SA(0, 1), a2 + hstepA);
      G_WAIT_L(8); G_BAR; G_WAIT_L(0); G_MMA(0, 0, At, B0); G_BAR; G_SCHED;
      G_LDB(B1, 1, 1); G_STAGE(G_SB(1, 0), b3, vb0, vb1);
      G_BAR; G_WAIT_L(0); G_MMA(0, 1, At, B1); G_BAR;
      G_LDA(At, 1, 1); G_STAGE_A(G_SA(1, 0), a3);
      G_BAR; G_WAIT_L(0); G_MMA(1, 0, At, B0); G_BAR; G_SCHED;
      G_STAGE(G_SB(1, 1), b3 + hsB, vb0, vb1);
      G_WAIT_V(6); G_BAR; G_MMA(1, 1, At, B1); G_BAR;
    }
    E(acc, cur, wr, wc, fr, fq, lds);
    if (!has_next) break;
#pragma unroll
    for (int a = 0; a < 2; ++a)
#pragma unroll
      for (int b = 0; b < 2; ++b)
#pragma unroll
        for (int m = 0; m < 4; ++m)
#pragma unroll
          for (int n = 0; n < 2; ++n) acc[a][b][m][n] = (f32x4){0.f, 0.f, 0.f, 0.f};
    cur = nxt; ++ui;
  }
  G_WAIT_V(0);
  if (wr == 0) G_BAR;
  G_BAR;
#undef G_SA
#undef G_SB
#undef G_STAGE
#undef G_STAGE_A
#undef G_LDA
#undef G_LDB
#undef G_MMA
#undef G_WAIT_V
#undef G_WAIT_L
#undef G_BAR
#undef G_SCHED
}

__device__ __forceinline__ void phase_prep(const Params& p, LAS unsigned char* lds) {
  int tid_ = threadIdx.x; asm volatile("" : "+v"(tid_));
  const int tid = tid_, nb = gridDim.x, bid = blockIdx.x;
  LAS float* tile = (LAS float*)lds;
  const int NJ = DEPTH * (48 + 8 + 16) * 16;
  for (int job = bid; job < NJ; job += nb) {
    const int l = job / ((48 + 8 + 16) * 16); int rem = job % ((48 + 8 + 16) * 16); const int ntile = rem / 16, kt = rem % 16;
    const int kind = ntile < 48 ? 0 : ntile < 56 ? 1 : 2; const int n0 = kind == 0 ? ntile * 64 : kind == 1 ? (ntile - 48) * 64 : (ntile - 56) * 64;
    const float* src = kind == 2 ? p.w_out + (size_t)l * D * D : p.w_in + (size_t)l * D * NIN; const int lds_ = kind == 2 ? D : NIN;
    for (int i = tid; i < 64 * 64; i += NTHREADS) {
      const int kk = i >> 6, nn = i & 63; const int n = n0 + nn; int col;
      if (kind == 0) { const int grp = n >> 9, cc = n & 511; col = (grp == 0 ? O_QA : grp == 1 ? O_GA : grp == 2 ? O_QH : grp == 3 ? O_FH : grp == 4 ? O_IH : O_GH) + cc; }
      else if (kind == 1) { col = n < 256 ? O_QI + n : n < 384 ? O_CKV + (n - 256) : n < 448 ? O_KI + (n - 384) : n < 452 ? O_WI + (n - 448) : -1; }
      else col = n;
      tile[kk * 65 + nn] = col >= 0 ? src[(size_t)(kt * 64 + kk) * lds_ + col] : 0.f;
    }
    __syncthreads();
    for (int i = tid; i < 64 * 64; i += NTHREADS) {
      const int nn = i >> 6, kk = i & 63; const float v = tile[kk * 65 + nn]; const int n = n0 + nn, k = kt * 64 + kk;
      if (kind == 0) p.WmT[((size_t)l * 3072 + n) * 1024 + k] = f2bf(v);
      else if (kind == 2) p.WoT[((size_t)l * 1024 + n) * 1024 + k] = f2bf(v);
      else { const bf16_t h = f2bf(v), lo = f2bf(v - bf2f(h)); bf16_t* d = p.WsT + ((size_t)l * 512 + n) * 3072; d[k] = h; d[1024 + k] = h; d[2048 + k] = lo; }
    }
    __syncthreads();
  }
  for (int i = bid * NTHREADS + tid; i < 512; i += nb * NTHREADS) {
    const float r0 = p.lbraw[i], r1 = p.lbraw[512 + i]; const float m = fmaxf(r0, r1); const float e0 = expf(r0 - m), e1 = expf(r1 - m);
    p.lbv[i] = 0.f; p.lbv[512 + i] = e1 / (e0 + e1);
  }
  for (int i = bid * NTHREADS + tid; i < DEPTH * 8 * 128 * 64; i += nb * NTHREADS) {
    const int d = i & 63, c = (i >> 6) & 127, lh = i >> 13;
    p.wukT[i] = f2bf(p.w_uk[((size_t)lh * 64 + d) * 128 + c]);
    const int c2 = i & 127, d2 = (i >> 7) & 63;
    p.wuvT[i] = f2bf(p.w_uv[((size_t)lh * 128 + c2) * 64 + d2]);
  }
  const size_t n4 = (size_t)(R + NM) * D / 4;
  for (size_t i = (size_t)bid * NTHREADS + tid; i < n4; i += (size_t)nb * NTHREADS) {
    const size_t row = i / (D / 4); const int c4 = (int)(i % (D / 4));
    const bool im = row >= (size_t)R; const size_t rr = im ? row - R : row;
    const f32x4 v = *(const f32x4*)((im ? p.meta : p.x) + rr * D + c4 * 4);
    bf16_t h[4], l[4];
#pragma unroll
    for (int j = 0; j < 4; ++j) { h[j] = f2bf(v[j]); l[j] = f2bf(v[j] - bf2f(h[j])); }
    u32x2 wh, wl; wh.x = (unsigned)h[0] | ((unsigned)h[1] << 16); wh.y = (unsigned)h[2] | ((unsigned)h[3] << 16);
    wl.x = (unsigned)l[0] | ((unsigned)l[1] << 16); wl.y = (unsigned)l[2] | ((unsigned)l[3] << 16);
    *(u32x2*)((im ? p.hHim : p.hHi) + rr * D + c4 * 4) = wh; *(u32x2*)((im ? p.hLom : p.hLo) + rr * D + c4 * 4) = wl;
  }
}

__device__ __forceinline__ void phase_ln(const Params& p, int layer, float* dst, bool write_split) {
  int tid_ = threadIdx.x; asm volatile("" : "+v"(tid_));
  const int tid = tid_, wid = tid >> 6, lane = tid & 63;
  const float* g = p.ln_g + layer * D; const float* bb = p.ln_b + layer * D;
  for (int row = blockIdx.x * 8 + wid; row < R; row += gridDim.x * 8) {
    float s = 0.f, q = 0.f;
    if (lane < 16) { const float2 st = *(const float2*)(p.stats + ((size_t)row * 16 + lane) * 2); s = st.x; q = st.y; }
#pragma unroll
    for (int o = 8; o > 0; o >>= 1) { s += __shfl_xor(s, o); q += __shfl_xor(q, o); }
    s = __shfl(s, 0); q = __shfl(q, 0);
    const float mean = s * (1.0f / D); const float var = fmaxf(q * (1.0f / D) - mean * mean, 0.f); const float rstd = rsqrtf(var + EPS);
#pragma unroll
    for (int i = 0; i < 4; ++i) {
      const int c = (i * 64 + lane) * 4;
      const f32x4 v = *(const f32x4*)(p.hF + (size_t)row * D + c); const f32x4 gg = *(const f32x4*)(g + c); const f32x4 bv = *(const f32x4*)(bb + c);
      const f32x4 o = (v - mean) * rstd * gg + bv;
      *(f32x4*)(dst + (size_t)row * D + c) = o;
      if (write_split) {
        bf16_t h[4], l[4];
#pragma unroll
        for (int j = 0; j < 4; ++j) { h[j] = f2bf(o[j]); l[j] = f2bf(o[j] - bf2f(h[j])); }
        u32x2 wh, wl; wh.x = (unsigned)h[0] | ((unsigned)h[1] << 16); wh.y = (unsigned)h[2] | ((unsigned)h[3] << 16);
        wl.x = (unsigned)l[0] | ((unsigned)l[1] << 16); wl.y = (unsigned)l[2] | ((unsigned)l[3] << 16);
        *(u32x2*)(p.hHi + (size_t)row * D + c) = wh; *(u32x2*)(p.hLo + (size_t)row * D + c) = wl;
      }
    }
  }
}

constexpr int K16_STRIDE = 8208;
constexpr int A_BIG = 0;
constexpr int A_SEL = 131328;
constexpr int A_CM = A_SEL + 8192;
constexpr int A_MISC = A_CM + 4096;
constexpr int A_HIST = A_MISC;
constexpr int A_CAND = A_MISC + 16448;
constexpr int A_RB = A_MISC + 16448 + 1024;
constexpr int A_BKT = A_RB + 1024;
constexpr int A_NSEL = A_BKT + 128;
static_assert(A_NSEL + 64 <= LDS_BYTES, "attention LDS map");

__device__ __forceinline__ unsigned off_b(unsigned row, unsigned ch) { return 256u * row + 16u * (ch ^ (((row & 3) << 2) | ((row >> 2) & 3))); }
__device__ __forceinline__ void glds16_asm(const void* gsrc, unsigned lds_dst) {
  unsigned keep;
  asm volatile("s_mov_b32 %0, m0\n\ts_mov_b32 m0, %2\n\ts_nop 0\n\tglobal_load_lds_dwordx4 %1, off\n\ts_mov_b32 m0, %0" : "=&s"(keep) : "v"(gsrc), "s"(lds_dst) : "memory");
}
__device__ __forceinline__ void wave_lds_sync() { asm volatile("s_waitcnt lgkmcnt(0)" ::: "memory"); }
typedef unsigned short u16x4 __attribute__((ext_vector_type(4)));
typedef unsigned short u16x8 __attribute__((ext_vector_type(8)));

typedef short s16x4 __attribute__((ext_vector_type(4)));
__device__ __forceinline__ s16x4 lds_tr(const LAS unsigned char* ptr) { return __builtin_amdgcn_ds_read_tr16_b64_v4i16((LAS s16x4*)ptr); }
__device__ __forceinline__ bf16x8 cat4(s16x4 a, s16x4 b) { return __builtin_shufflevector(a, b, 0, 1, 2, 3, 4, 5, 6, 7); }
__device__ __forceinline__ f32x4 mfma16(bf16x8 a, bf16x8 b, f32x4 c) { return __builtin_amdgcn_mfma_f32_16x16x32_bf16(a, b, c, 0, 0, 0); }

__device__ __forceinline__ void wave_find_bin(const unsigned (&c)[4], unsigned need, int lane, unsigned& bin, unsigned& above) {
  const unsigned tot = c[0] + c[1] + c[2] + c[3];
  unsigned cum = wave_incl_scan(tot) - tot;
  unsigned fb = 0xffffffffu, fa = 0;
#pragma unroll
  for (int i = 0; i < 4; ++i) { if (fb == 0xffffffffu && cum < need && cum + c[i] >= need) { fb = 255u - 4u * lane - i; fa = cum; } cum += c[i]; }
  const unsigned long long m = __ballot(fb != 0xffffffffu);
  const int src = m ? (int)__builtin_ctzll(m) : 0;
  bin = (unsigned)__builtin_amdgcn_readlane((int)fb, src); above = (unsigned)__builtin_amdgcn_readlane((int)fa, src);
  if (!m) { bin = 0; above = 0; }
}

__device__ __forceinline__ void attn_tile(const Params& p, const int layer, LAS unsigned char* lds, const bool is_meta, const int b, const int j,
                                          const bf16_t* wukT, const bf16_t* wuvT, const bool dry = false) {
  int tid_ = threadIdx.x; asm volatile("" : "+v"(tid_));
  const int tid = tid_, wid = __builtin_amdgcn_readfirstlane(tid >> 6), lane = tid & 63, fr = lane & 15, g = lane >> 4;
  const int t0 = 16 * j; const size_t r0 = is_meta ? 0 : (size_t)b * S + t0;
  const bf16_t* cNb = p.cN + (size_t)b * S * 128;
  LAS int* nselp = (LAS int*)(lds + A_NSEL);
  TS_ACC_BEGIN();
  if (!is_meta && j >= 16) {
    for (int rep_ = 0; rep_ <= PROBE_REP_SCORE; ++rep_) {
      bf16x8 qH[4][2], qL[4][2];
      const bf16_t* qh = p.qiH + (r0 + fr) * 256 + g * 8; const bf16_t* ql = p.qiL + (r0 + fr) * 256 + g * 8;
#pragma unroll
      for (int h = 0; h < 4; ++h)
#pragma unroll
        for (int ks = 0; ks < 2; ++ks) { qH[h][ks] = *(const bf16x8*)(qh + h * 64 + ks * 32); qL[h][ks] = *(const bf16x8*)(ql + h * 64 + ks * 32); }
      const f32x4 w = *(const f32x4*)(p.wi + (r0 + fr) * 4);
      const int tq = t0 + fr;
      LAS unsigned* h1 = (LAS unsigned*)(lds + A_HIST) + fr * 257;
      const bf16_t* kbh = p.kiH + (size_t)b * S * 64 + lane * 8; const bf16_t* kbl = p.kiL + (size_t)b * S * 64 + lane * 8;
      bf16x8 nH[2], nL[2], mH[2], mL[2];
      if (wid <= j) {
#pragma unroll
        for (int ks = 0; ks < 2; ++ks) { nH[ks] = *(const bf16x8*)(kbh + (size_t)wid * 1024 + ks * 512); nL[ks] = *(const bf16x8*)(kbl + (size_t)wid * 1024 + ks * 512); }
      }
      if (wid + 8 <= j) {
#pragma unroll
        for (int ks = 0; ks < 2; ++ks) { mH[ks] = *(const bf16x8*)(kbh + (size_t)(wid + 8) * 1024 + ks * 512); mL[ks] = *(const bf16x8*)(kbl + (size_t)(wid + 8) * 1024 + ks * 512); }
      }
      for (int kt = wid; kt <= j; kt += 8) {
        bf16x8 kH[2], kL[2];
#pragma unroll
        for (int ks = 0; ks < 2; ++ks) { kH[ks] = nH[ks]; kL[ks] = nL[ks]; nH[ks] = mH[ks]; nL[ks] = mL[ks]; }
        if (kt + 16 <= j) {
#pragma unroll
          for (int ks = 0; ks < 2; ++ks) { mH[ks] = *(const bf16x8*)(kbh + (size_t)(kt + 16) * 1024 + ks * 512); mL[ks] = *(const bf16x8*)(kbl + (size_t)(kt + 16) * 1024 + ks * 512); }
        }
        f32x4 sc = (f32x4){0.f, 0.f, 0.f, 0.f};
#pragma unroll
        for (int h = 0; h < 4; ++h) {
          f32x4 a = (f32x4){0.f, 0.f, 0.f, 0.f};
#pragma unroll
          for (int ks = 0; ks < 2; ++ks) { if (!(ABL_SCORE == 2 && rep_ < PROBE_REP_SCORE)) a = mfma16(kH[ks], qH[h][ks], a); if (!(ABL_SCORE >= 1 && rep_ < PROBE_REP_SCORE)) { a = mfma16(kL[ks], qH[h][ks], a); a = mfma16(kH[ks], qL[h][ks], a); } }
#pragma unroll
          for (int i = 0; i < 4; ++i) sc[i] = fmaf(w[h], fmaxf(a[i], 0.f), sc[i]);
        }
        u16x4 kk;
#pragma unroll
        for (int i = 0; i < 4; ++i) { const int s = kt * 16 + 4 * g + i; const unsigned k16 = f2key(sc[i]) >> 16; const bool ok = s <= tq; kk[i] = ok ? (unsigned short)k16 : (unsigned short)0;
          if (rep_ == PROBE_REP_SCORE && ok) __hip_atomic_fetch_add(h1 + (k16 >> 8), 1u, __ATOMIC_RELAXED, __HIP_MEMORY_SCOPE_WORKGROUP); }
        *(LAS u16x4*)(lds + A_BIG + fr * K16_STRIDE + (kt * 16 + 4 * g) * 2) = kk;
      }
    }
    TS_ACC(32);
    __syncthreads();
    TS_ACC(33);
    const int nkeys = 16 * (j + 1);
    LAS unsigned short* cand = (LAS unsigned short*)(lds + A_CAND + wid * 128);
    for (int rep_ = 0; rep_ <= PROBE_REP_SELECT; ++rep_)
    for (int qq = 0; qq < 2; ++qq) {
      const int qi = wid + 8 * qq;
      const LAS unsigned char* Kq = lds + A_BIG + qi * K16_STRIDE;
      LAS unsigned short* sel = (LAS unsigned short*)(lds + A_SEL + qi * 512);
      const int nit = (nkeys + 511) >> 9;
      const size_t qrow = r0 + qi;
      const u32x2 hq = *(const u32x2*)(p.qiH + qrow * 256 + lane * 4); const u32x2 lq = *(const u32x2*)(p.qiL + qrow * 256 + lane * 4);
      const f32x4 wq = *(const f32x4*)(p.wi + qrow * 4);
      LAS unsigned* hist = (LAS unsigned*)(lds + A_HIST) + qi * 257;
      unsigned c4[4];
#pragma unroll
      for (int i = 0; i < 4; ++i) c4[i] = hist[255 - 4 * lane - i];
      unsigned B1, above1; wave_find_bin(c4, (unsigned)TOPK, lane, B1, above1);
      wave_lds_sync();
      TS_ACC(48);
      u16x8 kr[8];
#pragma unroll
      for (int it = 0; it < 8; ++it) { const int base = (it * 64 + lane) * 8; kr[it] = (u16x8){0, 0, 0, 0, 0, 0, 0, 0}; if (it < nit && base < nkeys) kr[it] = *(const LAS u16x8*)(Kq + base * 2); }
#pragma unroll
      for (int i = 0; i < 4; ++i) hist[lane * 4 + i] = 0u;
      wave_lds_sync();
#pragma unroll
      for (int it = 0; it < 8; ++it) if (it < nit) {
#pragma unroll
        for (int e = 0; e < 8; ++e) if ((unsigned)(kr[it][e] >> 8) == B1) __hip_atomic_fetch_add(hist + (kr[it][e] & 255), 1u, __ATOMIC_RELAXED, __HIP_MEMORY_SCOPE_WORKGROUP);
      }
      wave_lds_sync();
#pragma unroll
      for (int i = 0; i < 4; ++i) c4[i] = hist[255 - 4 * lane - i];
      unsigned B2, above2; wave_find_bin(c4, (unsigned)TOPK - above1, lane, B2, above2);
      const unsigned T16 = (B1 << 8) | B2; const unsigned ngt = above1 + above2; const unsigned need = (unsigned)TOPK - ngt;
      TS_ACC(49);
      unsigned cg = 0, ce = 0;
#pragma unroll
      for (int it = 0; it < 8; ++it) if (it < nit) {
#pragma unroll
        for (int e = 0; e < 8; ++e) { cg += (unsigned)kr[it][e] > T16 ? 1u : 0u; ce += (unsigned)kr[it][e] == T16 ? 1u : 0u; }
      }
      const unsigned ig = wave_incl_scan(cg), ie = wave_incl_scan(ce);
      unsigned og = ig - cg, oe = ie - ce;
      const unsigned pos_eq = (unsigned)__builtin_amdgcn_readlane((int)ie, 63);
      TS_ACC(50);
      const bool slowpath = (T16 == 0x8000u || pos_eq > 64u);
#pragma unroll
      for (int it = 0; it < 8; ++it) if (it < nit) {
        const int base = (it * 64 + lane) * 8;
#pragma unroll
        for (int e = 0; e < 8; ++e) if ((unsigned)kr[it][e] == T16) { if (oe < 64u) cand[oe] = (unsigned short)(base + e); ++oe; }
      }
      wave_lds_sync();
      const int c = slowpath ? 0 : (int)pos_eq;
      const int myidx = lane < c ? (int)cand[lane] : 0;
      u32x4 hkA[8], lkA[8];
      if (!slowpath) {
        const size_t krow = (size_t)b * S + myidx;
#pragma unroll
        for (int dc = 0; dc < 8; ++dc) { hkA[dc] = *(const u32x4*)(p.kiH + kfrag(krow, dc * 8)); lkA[dc] = *(const u32x4*)(p.kiL + kfrag(krow, dc * 8)); }
      }
#pragma unroll
      for (int it = 0; it < 8; ++it) if (it < nit) {
        const int base = (it * 64 + lane) * 8;
#pragma unroll
        for (int e = 0; e < 8; ++e) if ((unsigned)kr[it][e] > T16) { sel[og] = (unsigned short)(base + e); ++og; }
      }
      wave_lds_sync();
      TS_ACC(51);
      if (slowpath) {
        unsigned taken = 0;
        for (int s0 = 0; s0 < nkeys && taken < need; s0 += 64) {
          const int s = s0 + lane; const bool eq = s < nkeys && (unsigned)(*(const LAS unsigned short*)(Kq + s * 2)) == T16;
          const unsigned long long me = __ballot(eq);
          const unsigned o = taken + __builtin_amdgcn_mbcnt_hi((unsigned)(me >> 32), __builtin_amdgcn_mbcnt_lo((unsigned)me, 0u));
          if (eq && o < need) sel[ngt + o] = (unsigned short)s;
          taken += (unsigned)__popcll(me);
        }
      } else {
        float qv[4];
        qv[0] = __uint_as_float(hq.x << 16) + __uint_as_float(lq.x << 16); qv[1] = __uint_as_float(hq.x & 0xffff0000u) + __uint_as_float(lq.x & 0xffff0000u);
        qv[2] = __uint_as_float(hq.y << 16) + __uint_as_float(lq.y << 16); qv[3] = __uint_as_float(hq.y & 0xffff0000u) + __uint_as_float(lq.y & 0xffff0000u);
        const f32x4 w = wq;
        float d4[4] = {0.f, 0.f, 0.f, 0.f};
#pragma unroll
        for (int dc = 0; dc < 8; ++dc) {
          const u32x4 hk = hkA[dc], lk = lkA[dc];
          float kv[8];
          kv[0] = __uint_as_float(hk.x << 16) + __uint_as_float(lk.x << 16); kv[1] = __uint_as_float(hk.x & 0xffff0000u) + __uint_as_float(lk.x & 0xffff0000u);
          kv[2] = __uint_as_float(hk.y << 16) + __uint_as_float(lk.y << 16); kv[3] = __uint_as_float(hk.y & 0xffff0000u) + __uint_as_float(lk.y & 0xffff0000u);
          kv[4] = __uint_as_float(hk.z << 16) + __uint_as_float(lk.z << 16); kv[5] = __uint_as_float(hk.z & 0xffff0000u) + __uint_as_float(lk.z & 0xffff0000u);
          kv[6] = __uint_as_float(hk.w << 16) + __uint_as_float(lk.w << 16); kv[7] = __uint_as_float(hk.w & 0xffff0000u) + __uint_as_float(lk.w & 0xffff0000u);
#pragma unroll
          for (int h = 0; h < 4; ++h)
#pragma unroll
            for (int dd = 0; dd < 8; ++dd) {
              const int srcl = h * 16 + dc * 2 + (dd >> 2);
              const float qs = __uint_as_float(__builtin_amdgcn_readlane(__float_as_uint(qv[dd & 3]), srcl));
              d4[h] = fmaf(qs, kv[dd], d4[h]);
            }
        }
        float sc = 0.f;
#pragma unroll
        for (int h = 0; h < 4; ++h) sc = fmaf(w[h], fmaxf(d4[h], 0.f), sc);
        int rank = 0;
        for (int jj = 0; jj < c; ++jj) {
          const float sj = __uint_as_float(__builtin_amdgcn_readlane(__float_as_uint(sc), jj)); const int ij = __builtin_amdgcn_readlane(myidx, jj);
          rank += (sj > sc || (sj == sc && ij < myidx)) ? 1 : 0;
        }
        if (lane < c && (unsigned)rank < need) sel[ngt + rank] = (unsigned short)myidx;
      }
      TS_ACC(52);
      if (rep_ == PROBE_REP_SELECT) {
#pragma unroll
        for (int i = 0; i < 4; ++i) hist[lane * 4 + i] = 0u;
      }
      if (lane == 0) nselp[qi] = TOPK;
      wave_lds_sync();
    }
  } else if (!is_meta) {
    for (int i = tid; i < 16 * 256; i += NTHREADS) { const int qi = i >> 8, s = i & 255; ((LAS unsigned short*)(lds + A_SEL))[i] = (unsigned short)(s <= t0 + qi ? s : 0); }
    if (tid < 16) nselp[tid] = t0 + tid + 1;
  } else {
    if (tid < 16) nselp[tid] = 0;
  }
  TS_ACC(34);
  __syncthreads();
  TS_ACC(35);
  {
    const bf16_t* qa = (is_meta ? p.qam : p.qa) + (r0 + fr) * 512 + wid * 64 + g * 8;
    bf16x8 bq[2];
#pragma unroll
    for (int ks = 0; ks < 2; ++ks) bq[ks] = *(const bf16x8*)(qa + ks * 32);
    const bf16_t* wk = wukT + ((size_t)wid * 128 + fr) * 64 + g * 8;
#pragma unroll
    for (int mt = 0; mt < 8; ++mt) {
      f32x4 a = (f32x4){0.f, 0.f, 0.f, 0.f};
#pragma unroll
      for (int ks = 0; ks < 2; ++ks) a = mfma16(*(const bf16x8*)(wk + (size_t)mt * 16 * 64 + ks * 32), bq[ks], a);
      u32x2 w2; w2.x = pack_bf16(a[0], a[1]); w2.y = pack_bf16(a[2], a[3]);
      *(LAS u32x2*)(lds + A_BIG + ((fr * 8 + wid) * 128 + mt * 16 + 4 * g) * 2) = w2;
    }
  }
  __syncthreads();
  bf16x8 qf_[2][4];
#pragma unroll
  for (int qq = 0; qq < 2; ++qq)
#pragma unroll
    for (int ks = 0; ks < 4; ++ks) {
      const bf16x8 v = *(const LAS bf16x8*)(lds + A_BIG + (((wid + 8 * qq) * 8 + (fr & 7)) * 128 + ks * 32 + g * 8) * 2);
      qf_[qq][ks] = fr < 8 ? v : (bf16x8){0, 0, 0, 0, 0, 0, 0, 0};
    }
  __syncthreads();
  TS_ACC(36);
  const LAS float* rb = (const LAS float*)(lds + A_RB);
  const LAS unsigned char* bkt = lds + A_BKT;
  f32x4 O[2][8];
  float linv[2];
  LAS unsigned char* gbuf = lds + A_BIG + wid * 16384;
  const unsigned gbase_u = (unsigned)__builtin_amdgcn_readfirstlane((int)(unsigned)(size_t)gbuf);
  const unsigned gq = (lane & 15) >> 2, gp = lane & 3;
  for (int rep_ = 0; rep_ <= PROBE_REP_ATT; ++rep_)
#pragma unroll
  for (int qq = 0; qq < 2; ++qq) {
    const int qi = wid + 8 * qq; const int nsel = nselp[qi];
    const int epos = is_meta ? qi : NM + t0 + qi;
    const LAS unsigned short* sel = (const LAS unsigned short*)(lds + A_SEL + qi * 512);
#pragma unroll
    for (int ct = 0; ct < 8; ++ct) O[qq][ct] = (f32x4){0.f, 0.f, 0.f, 0.f};
    float mrun = -INFINITY, lrun = 0.f;
    const int nch = (nsel + 31) >> 5;
#define ISSUE_GATHER(ch_) do { const unsigned dst_ = gbase_u + (unsigned)(((ch_) & 1) * 8192); \
      int idxs_[8]; \
      _Pragma("unroll") for (int i_ = 0; i_ < 8; ++i_) { const int si_ = (ch_) * 32 + 4 * i_ + g; const int v_ = (int)sel[si_ < 255 ? si_ : 255]; idxs_[i_] = si_ < nsel ? v_ : 0; } \
      asm volatile("s_waitcnt lgkmcnt(0)" ::: "memory"); \
      _Pragma("unroll") for (int i_ = 0; i_ < 8; ++i_) { \
        const int row_ = 4 * i_ + g; const unsigned f_ = (((unsigned)row_ & 3u) << 2) | (((unsigned)row_ >> 2) & 3u); \
        const bf16_t* src_ = cNb + (size_t)idxs_[i_] * 128 + (((unsigned)fr ^ f_) * 8); \
        glds16_asm(src_, dst_ + (unsigned)(i_ * 1024)); } } while (0)
    if (nch > 0) ISSUE_GATHER(0);
    if (nch > 1) ISSUE_GATHER(1);
    {
      f32x4 s0 = (f32x4){0.f, 0.f, 0.f, 0.f};
#pragma unroll
      for (int ks = 0; ks < 4; ++ks) s0 = mfma16(*(const LAS bf16x8*)(lds + A_CM + off_b(fr, 4 * ks + g)), qf_[qq][ks], s0);
      float lg[4]; float mx = -INFINITY;
#pragma unroll
      for (int i = 0; i < 4; ++i) { const int m = 4 * g + i; const int dist = epos - m; const bool valid = !is_meta || m <= qi;
        const int dcl = dist < 0 ? 0 : (dist > 127 ? 127 : dist); const int bkv = (int)bkt[dcl]; const int bk = dist >= 128 ? 31 : bkv;
        const float bias = rb[bk * 8 + (fr & 7)]; const float lv = s0[i] * 0.125f + bias;
        lg[i] = valid ? lv : -INFINITY; mx = fmaxf(mx, lg[i]); }
      mx = rows_max(mx);
      mrun = mx; float ps = 0.f; float pv[4];
#pragma unroll
      for (int i = 0; i < 4; ++i) { pv[i] = __expf(lg[i] - mrun); ps += pv[i]; }
      ps = rows_sum(ps); lrun = ps;
      bf16x8 pf; { const unsigned a0 = pack_bf16(pv[0], pv[1]), a1 = pack_bf16(pv[2], pv[3]); u32x4 t; t.x = a0; t.y = a1; t.z = 0u; t.w = 0u; pf = __builtin_bit_cast(bf16x8, t); }
      {
        s16x4 tm[8];
#pragma unroll
        for (int ct = 0; ct < 8; ++ct) tm[ct] = lds_tr(lds + A_CM + off_b(4 * g + gq, 2 * ct + (gp >> 1)) + 8 * (gp & 1));
        const s16x4 z4 = (s16x4){0, 0, 0, 0};
#pragma unroll
        for (int ct = 0; ct < 8; ++ct) O[qq][ct] = mfma16(cat4(tm[ct], z4), pf, O[qq][ct]);
      }
    }
    for (int ch = 0; ch < nch; ++ch) {
      if (ch + 1 < nch) asm volatile("s_waitcnt vmcnt(8)" ::: "memory"); else asm volatile("s_waitcnt vmcnt(0)" ::: "memory");
      const LAS unsigned char* buf = gbuf + (ch & 1) * 8192;
      f32x4 sA = (f32x4){0.f, 0.f, 0.f, 0.f}, sB = (f32x4){0.f, 0.f, 0.f, 0.f};
#pragma unroll
      for (int ks = 0; ks < 4; ++ks) {
        sA = mfma16(*(const LAS bf16x8*)(buf + off_b(fr, 4 * ks + g)), qf_[qq][ks], sA);
        sB = mfma16(*(const LAS bf16x8*)(buf + off_b(fr + 16, 4 * ks + g)), qf_[qq][ks], sB);
      }
      const u16x4 iA = *(const LAS u16x4*)(sel + ch * 32 + 4 * g); const u16x4 iB = *(const LAS u16x4*)(sel + ch * 32 + 16 + 4 * g);
      float lg[8]; float mx = -INFINITY;
#pragma unroll
      for (int i = 0; i < 8; ++i) {
        const int slot = ch * 32 + (i < 4 ? 4 * g + i : 16 + 4 * g + (i - 4)); const int kidx = i < 4 ? (int)iA[i] : (int)iB[i - 4];
        const int dist = t0 + qi - kidx; const int dcl = dist < 0 ? 0 : (dist > 127 ? 127 : dist); const int bkv = (int)bkt[dcl]; const int bk = dist >= 128 ? 31 : bkv;
        const float sv = i < 4 ? sA[i] : sB[i - 4];
        const float bias = rb[bk * 8 + (fr & 7)]; const float lv = sv * 0.125f + bias;
        lg[i] = slot < nsel ? lv : -INFINITY; mx = fmaxf(mx, lg[i]);
      }
      mx = rows_max(mx);
      const float mnew = fmaxf(mrun, mx); const float alpha = __expf(mrun - mnew); mrun = mnew;
      float pv[8]; float ps = 0.f;
#pragma unroll
      for (int i = 0; i < 8; ++i) { pv[i] = __expf(lg[i] - mnew); ps += pv[i]; }
      ps = rows_sum(ps); lrun = lrun * alpha + ps;
#pragma unroll
      for (int ct = 0; ct < 8; ++ct) O[qq][ct] *= alpha;
      bf16x8 pf; { u32x4 t; t.x = pack_bf16(pv[0], pv[1]); t.y = pack_bf16(pv[2], pv[3]); t.z = pack_bf16(pv[4], pv[5]); t.w = pack_bf16(pv[6], pv[7]); pf = __builtin_bit_cast(bf16x8, t); }
      {
        s16x4 ta[8], tb[8];
#pragma unroll
        for (int ct = 0; ct < 8; ++ct) { ta[ct] = lds_tr(buf + off_b(4 * g + gq, 2 * ct + (gp >> 1)) + 8 * (gp & 1)); tb[ct] = lds_tr(buf + off_b(16 + 4 * g + gq, 2 * ct + (gp >> 1)) + 8 * (gp & 1)); }
#pragma unroll
        for (int ct = 0; ct < 8; ++ct) O[qq][ct] = mfma16(cat4(ta[ct], tb[ct]), pf, O[qq][ct]);
      }
      if (ch + 2 < nch) ISSUE_GATHER(ch + 2);
    }
    linv[qq] = 1.0f / lrun;
  }
  TS_ACC(37);
  asm volatile("s_waitcnt vmcnt(0) lgkmcnt(0)" ::: "memory");
#pragma unroll
  for (int qq = 0; qq < 2; ++qq)
    if (fr < 8) {
#pragma unroll
      for (int ct = 0; ct < 8; ++ct) { const f32x4 o = O[qq][ct] * linv[qq]; u32x2 w2; w2.x = pack_bf16(o[0], o[1]); w2.y = pack_bf16(o[2], o[3]);
        *(LAS u32x2*)(gbuf + qq * 2048 + (fr * 128 + ct * 16 + 4 * g) * 2) = w2; }
    }
  __syncthreads();
  TS_ACC(38);
  {
    bf16x8 bo[4];
#pragma unroll
    for (int ks = 0; ks < 4; ++ks) bo[ks] = *(const LAS bf16x8*)(lds + A_BIG + (fr & 7) * 16384 + (fr >> 3) * 2048 + (wid * 128 + ks * 32 + g * 8) * 2);
    const bf16_t* wv = wuvT + ((size_t)wid * 64 + fr) * 128 + g * 8;
    bf16_t* grow = (is_meta ? p.gatesm : p.gates) + (r0 + fr) * 1024 + wid * 64 + 4 * g;
#pragma unroll
    for (int nt = 0; nt < 4; ++nt) {
      f32x4 a = (f32x4){0.f, 0.f, 0.f, 0.f};
#pragma unroll
      for (int ks = 0; ks < 4; ++ks) a = mfma16(*(const bf16x8*)(wv + (size_t)nt * 16 * 128 + ks * 32), bo[ks], a);
      const u32x2 gt = *(const u32x2*)(grow + nt * 16);
      const float g0 = __uint_as_float(gt.x << 16), g1 = __uint_as_float(gt.x & 0xffff0000u), g2 = __uint_as_float(gt.y << 16), g3 = __uint_as_float(gt.y & 0xffff0000u);
      u32x2 w2; w2.x = pack_bf16(a[0] * g0, a[1] * g1); w2.y = pack_bf16(a[2] * g2, a[3] * g3);
      *(u32x2*)((dry ? p.dummy + (r0 + fr) * 1024 + wid * 64 + 4 * g : grow) + nt * 16) = w2;
    }
  }
  __syncthreads();
  TS_ACC(39);
}

__device__ __forceinline__ void phase_attn(const Params& p, int layer, LAS unsigned char* lds, int ablk, int nablk, bool do_meta, const bool dry = false) {
  int tid_ = threadIdx.x; asm volatile("" : "+v"(tid_));
  const int tid = tid_;
  if (tid < 256) { const int row = tid >> 4, ch = tid & 15; *(LAS u32x4*)(lds + A_CM + off_b(row, ch)) = *(const u32x4*)(p.cNm + row * 128 + ch * 8); }
  if (tid < 256) ((LAS float*)(lds + A_RB))[tid] = p.rel_bias[tid];
  if (tid < 128) (lds + A_BKT)[tid] = c_bucket[tid];
  for (int i = tid; i < 16 * 257; i += NTHREADS) ((LAS unsigned*)(lds + A_HIST))[i] = 0u;
  __syncthreads();
  const bf16_t* wukT = p.wukT + (size_t)layer * 8 * 128 * 64; const bf16_t* wuvT = p.wuvT + (size_t)layer * 8 * 64 * 128;
  if ((nablk & 7) == 0 && (gridDim.x & 7) == 0) {
    const int xb = blockIdx.x & 7, nper = nablk >> 3, rank = ablk >> 3;
    for (int k = 0;; ++k) {
      const int idx = k * nper + ((k & 1) ? nper - 1 - rank : rank);
      if (idx >= 256) break;
      attn_tile(p, layer, lds, false, xb, 255 - idx, wukT, wuvT, dry);
    }
  } else {
    for (int item = ablk; item < NB * 256; item += nablk) {
      const int j = 255 - item / NB, b = item % NB;
      attn_tile(p, layer, lds, false, b, j, wukT, wuvT, dry);
    }
  }
  if (do_meta && !dry && ablk == nablk - 1) attn_tile(p, layer, lds, true, 0, 0, wukT, wuvT);
}

constexpr int H_QT = 0, H_KH = 4096, H_KT = 8192, H_VV = 12288, H_DEC = 16384, H_PART = 16384 + 512;
__device__ __forceinline__ u16x4 lds_tr4(unsigned addr) { u16x4 r; asm volatile("ds_read_b64_tr_b16 %0, %1\n\ts_waitcnt lgkmcnt(0)" : "=&v"(r) : "v"(addr) : "memory"); return r; }

__device__ __forceinline__ void phase_hgrn(const Params& p, const int layer, LAS unsigned char* lds, const int hblk, const bool dry = false) {
  int tid_ = threadIdx.x; asm volatile("" : "+v"(tid_));
  const int tid = tid_, wid = __builtin_amdgcn_readfirstlane(tid >> 6), lane = tid & 63, fr = lane & 15, g = lane >> 4;
  const int b = hblk >> 2, h = hblk & 3;
  const unsigned gq = (lane & 15) >> 2, gp = lane & 3;
  f32x4 Sacc[8];
#pragma unroll
  for (int kt = 0; kt < 8; ++kt) Sacc[kt] = (f32x4){0.f, 0.f, 0.f, 0.f};
  const float gn = p.hng[layer * 128 + wid * 16 + fr];
  const int sk = wid * 16 + (lane & 15), stg = lane >> 4;
  const int vrow = (tid & 255) >> 4, vch = tid & 15;
  float n_gv[4]; unsigned short n_q[4]; u32x4 n_v; unsigned short n_gate[4];
  {
#pragma unroll
    for (int i = 0; i < 4; ++i) { n_gv[i] = p.glm[(size_t)(4 * stg + i) * 512 + h * 128 + sk]; n_q[i] = p.qfm[(size_t)(4 * stg + i) * 512 + h * 128 + sk]; }
    n_v = *(const u32x4*)(p.vvm + (size_t)vrow * 512 + h * 128 + vch * 8);
#pragma unroll
    for (int i = 0; i < 4; ++i) n_gate[i] = p.gatesm[(size_t)(4 * g + i) * 1024 + 512 + h * 128 + wid * 16 + fr];
  }
  for (int step = 0; step <= S / 16; ++step) {
    const bool im = step == 0;
    const size_t rbase = im ? 0 : (size_t)b * S + (size_t)(step - 1) * 16;
    bf16_t* gt = (im ? p.gatesm : p.gates) + rbase * 1024 + 512 + h * 128;
    TS_ACC_BEGIN();
    float gv[4], qv[4];
#pragma unroll
    for (int i = 0; i < 4; ++i) { gv[i] = n_gv[i]; qv[i] = bf2f(n_q[i]); }
    const u32x4 vraw = n_v;
    float gate[4];
#pragma unroll
    for (int i = 0; i < 4; ++i) gate[i] = bf2f(n_gate[i]);
    if (step < S / 16) {
      const size_t rn = (size_t)b * S + (size_t)step * 16;
#pragma unroll
      for (int i = 0; i < 4; ++i) { n_gv[i] = p.gl[(rn + 4 * stg + i) * 512 + h * 128 + sk]; n_q[i] = p.qf[(rn + 4 * stg + i) * 512 + h * 128 + sk]; }
      n_v = *(const u32x4*)(p.vv + (rn + vrow) * 512 + h * 128 + vch * 8);
#pragma unroll
      for (int i = 0; i < 4; ++i) n_gate[i] = p.gates[(rn + 4 * g + i) * 1024 + 512 + h * 128 + wid * 16 + fr];
    }
    {
      float bc[4]; bc[0] = gv[0]; bc[1] = bc[0] + gv[1]; bc[2] = bc[1] + gv[2]; bc[3] = bc[2] + gv[3];
      float x = bc[3];
      { const float u = __shfl_up(x, 16); if (lane >= 16) x += u; }
      { const float u = __shfl_up(x, 32); if (lane >= 32) x += u; }
      const float ex = x - bc[3];
      const float bl = __shfl(x, 48 + (lane & 15));
#pragma unroll
      for (int i = 0; i < 4; ++i) {
        const float bci = bc[i] + ex;
        const float kc = 1.0f - __expf(gv[i]);
        const float qt = qv[i] * __expf(bci), khv = kc * __expf(fminf(-bci, 80.f)), ktv = kc * __expf(bl - bci);
        const unsigned o1 = off_b(4 * stg + i, sk >> 3) + (sk & 7) * 2;
        *(LAS unsigned short*)(lds + H_QT + o1) = f2bf(qt); *(LAS unsigned short*)(lds + H_KH + o1) = f2bf(khv); *(LAS unsigned short*)(lds + H_KT + o1) = f2bf(ktv);
      }
      if (stg == 3) *(LAS float*)(lds + H_DEC + sk * 4) = __expf(bl);
      if (tid < 256) *(LAS u32x4*)(lds + H_VV + off_b(vrow, vch)) = vraw;
    }
    TS_ACC(40);
    __syncthreads();
    TS_ACC(41);
    f32x4 o = (f32x4){0.f, 0.f, 0.f, 0.f};
    {
      bf16x8 aKH[4], aQT[4]; u32x2 q0[4], q1[4]; s16x4 ktr[8]; f32x4 dvv[8];
#pragma unroll
      for (int ks = 0; ks < 4; ++ks) {
        aKH[ks] = *(const LAS bf16x8*)(lds + H_KH + off_b(fr, 4 * ks + g)); aQT[ks] = *(const LAS bf16x8*)(lds + H_QT + off_b(fr, 4 * ks + g));
        q0[ks] = *(const LAS u32x2*)(lds + H_QT + off_b(fr, 4 * ks + (g >> 1)) + (g & 1) * 8); q1[ks] = *(const LAS u32x2*)(lds + H_QT + off_b(fr, 4 * ks + 2 + (g >> 1)) + (g & 1) * 8);
      }
      const s16x4 vt = lds_tr(lds + H_VV + off_b(4 * g + gq, 2 * wid + (gp >> 1)) + 8 * (gp & 1));
#pragma unroll
      for (int kt = 0; kt < 8; ++kt) { ktr[kt] = lds_tr(lds + H_KT + off_b(4 * g + gq, 2 * kt + (gp >> 1)) + 8 * (gp & 1)); dvv[kt] = *(const LAS f32x4*)(lds + H_DEC + (16 * kt + 4 * g) * 4); }
      const s16x4 z4 = (s16x4){0, 0, 0, 0};
      const bf16x8 bfv = cat4(vt, z4);
      f32x4 sc = (f32x4){0.f, 0.f, 0.f, 0.f};
#pragma unroll
      for (int ks = 0; ks < 4; ++ks) sc = mfma16(aKH[ks], aQT[ks], sc);
#pragma unroll
      for (int ks = 0; ks < 4; ++ks) {
        u32x4 av; av.x = q0[ks].x; av.y = q0[ks].y; av.z = q1[ks].x; av.w = q1[ks].y;
        u32x4 bv; bv.x = pack_bf16(Sacc[2 * ks][0], Sacc[2 * ks][1]); bv.y = pack_bf16(Sacc[2 * ks][2], Sacc[2 * ks][3]);
        bv.z = pack_bf16(Sacc[2 * ks + 1][0], Sacc[2 * ks + 1][1]); bv.w = pack_bf16(Sacc[2 * ks + 1][2], Sacc[2 * ks + 1][3]);
        o = mfma16(__builtin_bit_cast(bf16x8, av), __builtin_bit_cast(bf16x8, bv), o);
      }
      float ms[4];
#pragma unroll
      for (int i = 0; i < 4; ++i) ms[i] = (4 * g + i) <= fr ? sc[i] : 0.f;
      u32x4 am; am.x = pack_bf16(ms[0], ms[1]); am.y = pack_bf16(ms[2], ms[3]); am.z = 0u; am.w = 0u;
      o = mfma16(__builtin_bit_cast(bf16x8, am), bfv, o);
#pragma unroll
      for (int kt = 0; kt < 8; ++kt) Sacc[kt] = mfma16(cat4(ktr[kt], z4), bfv, Sacc[kt] * dvv[kt]);
    }
    {
      f32x4 sq = o * o;
#pragma unroll
      for (int i = 0; i < 4; ++i) sq[i] = row_sum16(sq[i]);
      if (fr == 0) *(LAS f32x4*)(lds + H_PART + (wid * 16 + 4 * g) * 4) = sq;
    }
    TS_ACC(42);
    __syncthreads();
    TS_ACC(43);
    if (!im || (b == 0 && layer == 0)) {
      f32x4 tot = (f32x4){0.f, 0.f, 0.f, 0.f};
#pragma unroll
      for (int w = 0; w < 8; ++w) tot += *(const LAS f32x4*)(lds + H_PART + (w * 16 + 4 * g) * 4);
#pragma unroll
      for (int i = 0; i < 4; ++i) {
        const float rstd = rsqrtf(tot[i] * (1.0f / 128.0f) + EPS);
        (dry ? p.dummy + rbase * 1024 + 512 + h * 128 : gt)[(size_t)(4 * g + i) * 1024 + wid * 16 + fr] = f2bf(o[i] * rstd * gn * gate[i]);
      }
    }
    TS_ACC(44);
  }
}

enum { PH_PREP = 0, PH_P1 = 1, PH_ATTN = 2, PH_P3 = 3, PH_LN = 4, PH_HGRN = 5 };
__global__ void __launch_bounds__(NTHREADS, 2) k_fast(Params p, int phase, int layer) {
  extern __shared__ __attribute__((aligned(16))) unsigned char smem[];
  LAS unsigned char* lds = (LAS unsigned char*)smem;
  if (phase == PH_PREP) phase_prep(p, lds);
  else if (phase == PH_P1) {
    SrcP1 S{(const char*)p.hHi, (const char*)p.hLo, (const char*)(p.WmT + (size_t)layer * 3072 * 1024), (const char*)(p.WsT + (size_t)layer * 512 * 3072)};
    EpiP1 E{p, layer};
    gemm_phase<SrcP1, EpiP1>(lds, S, R / BM, 14, E);
  } else if (phase == PH_P3) {
    SrcP3 S{(const char*)p.gates, (const char*)(p.WoT + (size_t)layer * 1024 * 1024)};
    EpiP3 E{p, layer == 0 ? p.x : p.hF};
    gemm_phase<SrcP3, EpiP3>(lds, S, R / BM, 4, E);
  } else if (phase == PH_ATTN) {
    phase_attn(p, layer, lds, blockIdx.x, gridDim.x, layer == 0);
  } else if (phase == PH_HGRN) {
    if (blockIdx.x < NB * 4) phase_hgrn(p, layer, lds, blockIdx.x);
  } else if (phase == PH_LN) {
    phase_ln(p, layer, layer == 0 ? p.hF : p.out, layer == 0);
  }
}

constexpr int M_A32T = 0;
constexpr int M_PART = 65536;
template <bool A_BF16>
__device__ __forceinline__ void meta_group_gemm(LAS unsigned char* lds, const void* A, const float* W, const int ldw, const int col0) {
  int tid_ = threadIdx.x; asm volatile("" : "+v"(tid_));
  const int tid = tid_, wid = __builtin_amdgcn_readfirstlane(tid >> 6), lane = tid & 63;
  LAS float* a32 = (LAS float*)(lds + M_A32T); LAS float* part = (LAS float*)(lds + M_PART);
  for (int i = tid; i < 16 * 1024; i += NTHREADS) { const int r = i >> 10, k = i & 1023; a32[k * 16 + r] = A_BF16 ? bf2f(((const bf16_t*)A)[i]) : ((const float*)A)[i]; }
  __syncthreads();
  float acc0[16], acc1[16];
#pragma unroll
  for (int r = 0; r < 16; ++r) { acc0[r] = 0.f; acc1[r] = 0.f; }
  const float* w0p = W + (size_t)(wid * 128) * ldw + col0 + lane;
#pragma unroll 4
  for (int kk = 0; kk < 128; ++kk) {
    const float w0 = w0p[(size_t)kk * ldw], w1 = w0p[(size_t)kk * ldw + 64];
    const LAS f32x4* ar = (const LAS f32x4*)(a32 + (wid * 128 + kk) * 16);
#pragma unroll
    for (int q = 0; q < 4; ++q) { const f32x4 a = ar[q];
#pragma unroll
      for (int j = 0; j < 4; ++j) { acc0[q * 4 + j] = fmaf(a[j], w0, acc0[q * 4 + j]); acc1[q * 4 + j] = fmaf(a[j], w1, acc1[q * 4 + j]); } }
  }
#pragma unroll
  for (int r = 0; r < 16; ++r) { part[(wid * 16 + r) * 128 + lane] = acc0[r]; part[(wid * 16 + r) * 128 + 64 + lane] = acc1[r]; }
  __syncthreads();
  for (int i = tid; i < 2048; i += NTHREADS) { float s = 0.f;
#pragma unroll
    for (int w = 0; w < 8; ++w) s += part[w * 2048 + i]; part[i] = s; }
  __syncthreads();
}

__device__ __forceinline__ void meta_inproj_group(const Params& p, const int layer, LAS unsigned char* lds, const int grp) {
  int tid_ = threadIdx.x; asm volatile("" : "+v"(tid_)); const int tid = tid_;
  const float* A = layer == 0 ? p.meta : p.hFm;
  int kind, sub;
  if (grp < 4) { kind = 0; sub = grp; } else if (grp == 4) { kind = 6; sub = 0; } else { kind = 1 + (grp - 5) / 4; sub = (grp - 5) % 4; }
  const int colbase = (kind == 0 ? O_QA : kind == 6 ? O_CKV : kind == 1 ? O_GA : kind == 2 ? O_QH : kind == 3 ? O_FH : kind == 4 ? O_IH : O_GH) + sub * 128;
  meta_group_gemm<false>(lds, A, p.w_in + (size_t)layer * D * NIN, NIN, colbase);
  LAS float* out = (LAS float*)(lds + M_PART);
  LAS float* rs = (LAS float*)(lds + M_PART + 2048 * 4);
  if (kind == 6) {
    if (tid < 16) { float s = 0.f; for (int c = 0; c < 128; ++c) { const float v = out[tid * 128 + c]; s = fmaf(v, v, s); } rs[tid] = rsqrtf(s * (1.0f / 128.0f) + EPS); }
    __syncthreads();
  }
  for (int i = tid; i < 2048; i += NTHREADS) {
    const int r = i >> 7, c = i & 127, cc = sub * 128 + c; const float v = out[i];
    if (kind == 0) p.qam[r * 512 + cc] = f2bf(v);
    else if (kind == 6) p.cNm[r * 128 + c] = f2bf(v * rs[r] * p.kvg[layer * 128 + c]);
    else if (kind == 1) p.gatesm[r * 1024 + cc] = f2bf(fast_silu(v));
    else if (kind == 2) p.qfm[r * 512 + cc] = f2bf(fast_silu(v) * 0.08838834764831845f);
    else if (kind == 3) { const float lb = p.lbv[layer * 512 + cc]; p.glm[r * 512 + cc] = __logf(lb + (1.0f - lb) * fast_sigmoid(v)); }
    else if (kind == 4) p.vvm[r * 512 + cc] = f2bf(v);
    else p.gatesm[r * 1024 + 512 + cc] = f2bf(fast_silu(v));
  }
  __syncthreads();
}
__device__ __forceinline__ void meta_outproj_group(const Params& p, LAS unsigned char* lds, const int grp) {
  int tid_ = threadIdx.x; asm volatile("" : "+v"(tid_)); const int tid = tid_;
  meta_group_gemm<true>(lds, p.gatesm, p.w_out, D, grp * 128);
  const LAS float* out = (const LAS float*)(lds + M_PART);
  for (int i = tid; i < 2048; i += NTHREADS) { const int r = i >> 7, c = grp * 128 + (i & 127); p.vm[r * D + c] = DN_ALPHA * p.meta[r * D + c] + out[i]; }
  __syncthreads();
}
__device__ __forceinline__ void meta_ln(const Params& p) {
  int tid_ = threadIdx.x; asm volatile("" : "+v"(tid_)); const int tid = tid_, wid = tid >> 6, lane = tid & 63;
  for (int row = wid; row < NM; row += 8) {
    f32x4 v[4]; float s = 0.f;
#pragma unroll
    for (int i = 0; i < 4; ++i) { v[i] = *(const f32x4*)(p.vm + row * D + (i * 64 + lane) * 4); s += (v[i][0] + v[i][1]) + (v[i][2] + v[i][3]); }
#pragma unroll
    for (int o = 32; o > 0; o >>= 1) s += __shfl_xor(s, o);
    const float mean = s * (1.0f / D); float q = 0.f;
#pragma unroll
    for (int i = 0; i < 4; ++i) { const f32x4 d = v[i] - mean; q += (d[0] * d[0] + d[1] * d[1]) + (d[2] * d[2] + d[3] * d[3]); }
#pragma unroll
    for (int o = 32; o > 0; o >>= 1) q += __shfl_xor(q, o);
    const float rstd = rsqrtf(q * (1.0f / D) + EPS);
#pragma unroll
    for (int i = 0; i < 4; ++i) { const int c = (i * 64 + lane) * 4; *(f32x4*)(p.hFm + row * D + c) = (v[i] - mean) * rstd * *(const f32x4*)(p.ln_g + c) + *(const f32x4*)(p.ln_b + c); }
  }
}


#define XB_TMO      128
#define XB_XCNT(j)  (256  + 64 * (j))
#define XB_XSUB(j)  (1280 + 64 * (j))
#define XB_XGEN(j)  (2304 + 64 * (j))
#define XB_TOP      3328
#define XB_TOPGEN   3392
#define XCD_BAR_WORDS 3456
#define XB_SPIN_CAP (1u << 20)
__device__ __forceinline__ unsigned xb_ld(unsigned* p)              { return __hip_atomic_load(p, __ATOMIC_RELAXED, __HIP_MEMORY_SCOPE_AGENT); }
__device__ __forceinline__ unsigned xb_add(unsigned* p, unsigned v) { return __hip_atomic_fetch_add(p, v, __ATOMIC_RELAXED, __HIP_MEMORY_SCOPE_AGENT); }
__device__ __forceinline__ unsigned xb_xcc_id() { return (unsigned)__builtin_amdgcn_s_getreg((3 << 11) | 20) & 0xFu; }
#define XB_SPIN(cond, bar) do { unsigned _sp = 0; while (cond) { __builtin_amdgcn_s_sleep(1); \
    if ((++_sp & 255u) == 0u) { if (xb_ld(&(bar)[XB_TMO])) break; if (_sp > XB_SPIN_CAP) { atomicAdd(&(bar)[XB_TMO], 1u); break; } } } } while (0)
struct XcdBarrier { unsigned* bar; unsigned x; volatile LAS unsigned* st; };
__device__ __forceinline__ XcdBarrier xcd_barrier_post(unsigned* bar, volatile LAS unsigned* st) {
  XcdBarrier b; b.bar = bar; b.x = xb_xcc_id(); b.st = st;
  if (threadIdx.x == 0) (void)xb_add(&bar[XB_XCNT(b.x)], 1u);
  return b;
}
__device__ __forceinline__ void xcd_barrier_complete(unsigned* bar, unsigned x, unsigned& nloc, unsigned& nx) {
  const unsigned G = gridDim.x * gridDim.y * gridDim.z;
  unsigned sum, cnt, mine, sp = 0u;
  for (;;) {
    sum = 0u; cnt = 0u; mine = 0u;
#pragma unroll
    for (unsigned j = 0; j < 16; ++j) { const unsigned c = xb_ld(&bar[XB_XCNT(j)]); sum += c; cnt += (c > 0u) ? 1u : 0u; mine = (j == x) ? c : mine; }
    if (sum == G) break;
    __builtin_amdgcn_s_sleep(1);
    if ((++sp & 255u) == 0u) { if (xb_ld(&bar[XB_TMO])) break; if (sp > XB_SPIN_CAP) { atomicAdd(&bar[XB_TMO], 1u); break; } }
  }
  nloc = mine > 0u ? mine : 1u; nx = cnt > 0u ? cnt : 1u;
}
__device__ __forceinline__ void xcd_barrier(const XcdBarrier& b) {
  asm volatile("s_waitcnt vmcnt(0)" ::: "memory");
  __syncthreads();
  if (threadIdx.x == 0) {
    unsigned* bar = b.bar;
    __builtin_amdgcn_s_waitcnt(0);
    unsigned nloc = b.st[0], nx = b.st[1];
    if (nloc == 0u) { xcd_barrier_complete(bar, b.x, nloc, nx); b.st[0] = nloc; b.st[1] = nx; }
    const unsigned old = xb_add(&bar[XB_XSUB(b.x)], 1u);
    const unsigned gen = old / nloc;
    if (old + 1u == (gen + 1u) * nloc) {
      __builtin_amdgcn_fence(__ATOMIC_RELEASE, "agent");
      asm volatile("s_waitcnt vmcnt(0)" ::: "memory");
      const unsigned og = xb_add(&bar[XB_TOP], 1u);
      const unsigned tg = og / nx;
      if (og + 1u == (tg + 1u) * nx) xb_add(&bar[XB_TOPGEN], 1u);
      else XB_SPIN(xb_ld(&bar[XB_TOPGEN]) == tg, bar);
      __builtin_amdgcn_fence(__ATOMIC_ACQUIRE, "agent");
      xb_add(&bar[XB_XGEN(b.x)], 1u);
      asm volatile("s_waitcnt vmcnt(0)" ::: "memory");
    } else {
      XB_SPIN(xb_ld(&bar[XB_XGEN(b.x)]) == gen, bar);
      __builtin_amdgcn_fence(__ATOMIC_ACQUIRE, "agent");
      asm volatile("s_waitcnt vmcnt(0)" ::: "memory");
    }
  }
  __syncthreads();
}

constexpr int N_HGRN_BLOCKS = NB * 4;
#ifndef PROBE_REP_PREP
#define PROBE_REP_PREP 0
#endif
#ifndef PROBE_REP_P1
#define PROBE_REP_P1 0
#endif
#ifndef PROBE_REP_P3
#define PROBE_REP_P3 0
#endif
#ifndef PROBE_DRY
#define PROBE_DRY 0
#endif
#ifndef PROBE_SYNC
#define PROBE_SYNC 0
#endif
__global__ void __launch_bounds__(NTHREADS, 2) k_mega(Params p) {
  extern __shared__ __attribute__((aligned(16))) unsigned char smem[];
  LAS unsigned char* lds = (LAS unsigned char*)smem;
  cooperative_groups::grid_group grid = cooperative_groups::this_grid();
  const int bid = blockIdx.x, G = gridDim.x;
  if (threadIdx.x < 4) ((LAS unsigned*)(lds + LDS_BYTES - 16))[threadIdx.x] = 0u;
  __syncthreads();
  const XcdBarrier xbar = xcd_barrier_post(p.bar, (volatile LAS unsigned*)(lds + LDS_BYTES - 16));
#define GRID_BAR() xcd_barrier(xbar)
  if (TPROBE) { for (int i = threadIdx.x; i < 64; i += NTHREADS) p.ts[(size_t)blockIdx.x * 64 + i] = 0ull; __syncthreads(); }
  TS_MARK(0);
  for (int i = 0; i < PROBE_SYNC; ++i) grid.sync();
  for (int i = 0; i < PROBE_REP_PREP; ++i) { phase_prep(p, lds); __syncthreads(); }
  phase_prep(p, lds);
  __syncthreads();
  if (bid >= G - 25) {
    { int t_ = threadIdx.x; asm volatile("" : "+v"(t_)); for (int i = t_; i < 512; i += NTHREADS) p.lbv[i] = 0.f; }
    __syncthreads();
    meta_inproj_group(p, 0, lds, bid - (G - 25));
  }
  TS_MARK(1); grid.sync(); TS_MARK(2);
#pragma unroll
  for (int layer = 0; layer < DEPTH; ++layer) {
    if (layer == 1 && bid < 25) meta_inproj_group(p, 1, lds, bid);
    {
      SrcP1 Sp{(const char*)p.hHi, (const char*)p.hLo, (const char*)(p.WmT + (size_t)layer * 3072 * 1024), (const char*)(p.WsT + (size_t)layer * 512 * 3072)};
      EpiP1 E{p, layer};
      for (int i = 0; i < PROBE_REP_P1; ++i) gemm_phase<SrcP1, EpiP1>(lds, Sp, R / BM, 14, E);
      gemm_phase<SrcP1, EpiP1>(lds, Sp, R / BM, 14, E);
    }
    TS_MARK(3 + 8 * layer); GRID_BAR(); TS_MARK(4 + 8 * layer);
    if (PROBE_DRY) {
      if (bid < N_HGRN_BLOCKS) { if (PROBE_DRY != 2) phase_hgrn(p, layer, lds, bid, true); }
      else { if (PROBE_DRY != 3) phase_attn(p, layer, lds, bid - N_HGRN_BLOCKS, G - N_HGRN_BLOCKS, layer == 0, true); }
      grid.sync();
    }
    if (bid < N_HGRN_BLOCKS) phase_hgrn(p, layer, lds, bid);
    else phase_attn(p, layer, lds, bid - N_HGRN_BLOCKS, G - N_HGRN_BLOCKS, layer == 0);
    TS_MARK(5 + 8 * layer); GRID_BAR(); TS_MARK(6 + 8 * layer);
    if (layer == 0 && bid < 8) meta_outproj_group(p, lds, bid);
    {
      SrcP3 Sp{(const char*)p.gates, (const char*)(p.WoT + (size_t)layer * 1024 * 1024)};
      EpiP3 E{p, layer == 0 ? p.x : p.hF};
      if (layer == 0) for (int i = 0; i < PROBE_REP_P3; ++i) gemm_phase<SrcP3, EpiP3>(lds, Sp, R / BM, 4, E);
      gemm_phase<SrcP3, EpiP3>(lds, Sp, R / BM, 4, E);
    }
    TS_MARK(7 + 8 * layer); GRID_BAR(); TS_MARK(8 + 8 * layer);
    if (layer == 0) { phase_ln(p, 0, p.hF, true); if (bid == G - 1) meta_ln(p); TS_MARK(9); GRID_BAR(); TS_MARK(10); }
    else { phase_ln(p, 1, p.out, false); TS_MARK(17); }
  }
  if (TPROBE) {
    grid.sync();
    if (bid == 0 && threadIdx.x < 64) {
      unsigned long long mx = 0;
      for (int b2 = TP_LO + (int)threadIdx.x; b2 < TP_HI; b2 += 64) { const unsigned long long e_ = __hip_atomic_load(p.ts + (size_t)b2 * 64 + TP_E, __ATOMIC_RELAXED, __HIP_MEMORY_SCOPE_AGENT), s_ = __hip_atomic_load(p.ts + (size_t)b2 * 64 + TP_S, __ATOMIC_RELAXED, __HIP_MEMORY_SCOPE_AGENT); const unsigned long long d = TPROBE == 2 ? e_ : e_ - s_; mx = d > mx ? d : mx; }
      for (int o = 32; o > 0; o >>= 1) { const unsigned long long v = __shfl_xor(mx, o); mx = v > mx ? v : mx; }
      if (threadIdx.x == 0) p.out[0] += (float)mx * 0.0001f;
    }
  }
}

}

extern "C" void kernel_launch(void* const* d_in, const int* in_sizes, int n_in, void* d_out, int out_size, void* d_ws, size_t ws_size,
                              hipStream_t stream) {
  Params p{};
  p.x = (const float*)d_in[0]; p.meta = (const float*)d_in[1]; p.rel_bias = (const float*)d_in[2]; p.lbraw = (const float*)d_in[3];
  p.w_in = (const float*)d_in[4]; p.kvg = (const float*)d_in[5]; p.w_uk = (const float*)d_in[6]; p.w_uv = (const float*)d_in[7];
  p.hng = (const float*)d_in[8]; p.w_out = (const float*)d_in[9]; p.ln_g = (const float*)d_in[10]; p.ln_b = (const float*)d_in[11];
  p.out = (float*)d_out;
  char* w = (char*)d_ws; size_t off = 0;
  auto take = [&](size_t bytes) { char* q = w + off; off += (bytes + 255) & ~(size_t)255; return q; };
  p.hF = (float*)take((size_t)R * D * 4); p.hFm = (float*)take((size_t)NM * D * 4);
  p.hHi = (bf16_t*)take((size_t)R * D * 2); p.hHim = (bf16_t*)take((size_t)NM * D * 2);
  p.hLo = (bf16_t*)take((size_t)R * D * 2); p.hLom = (bf16_t*)take((size_t)NM * D * 2);
  p.qa = (bf16_t*)take((size_t)R * 512 * 2); p.qam = (bf16_t*)take((size_t)NM * 512 * 2);
  p.cN = (bf16_t*)take((size_t)R * 128 * 2); p.cNm = (bf16_t*)take((size_t)NM * 128 * 2);
  p.gates = (bf16_t*)take((size_t)R * 1024 * 2); p.gatesm = (bf16_t*)take((size_t)NM * 1024 * 2);
  p.qfm = (bf16_t*)take((size_t)NM * 512 * 2); p.glm = (float*)take((size_t)NM * 512 * 4); p.vvm = (bf16_t*)take((size_t)NM * 512 * 2);
  p.qiH = (bf16_t*)take((size_t)R * 256 * 2); p.qiL = (bf16_t*)take((size_t)R * 256 * 2);
  p.kiH = (bf16_t*)take((size_t)R * 64 * 2); p.kiL = (bf16_t*)take((size_t)R * 64 * 2);
  p.wi = (float*)take((size_t)R * 4 * 4);
  p.sel = (int*)take(256); p.nsel = (int*)take(256);
  p.proj = (float*)take((size_t)NM * NIN * 4);
  p.ych = (float*)take((size_t)NM * D * 4);
  p.WmT = (bf16_t*)take((size_t)DEPTH * 3072 * 1024 * 2); p.WsT = (bf16_t*)take((size_t)DEPTH * 512 * 3072 * 2); p.WoT = (bf16_t*)take((size_t)DEPTH * 1024 * 1024 * 2);
  p.lbv = (float*)take((size_t)DEPTH * 512 * 4);
  p.stats = (float*)take((size_t)R * 16 * 2 * 4); p.statsm = (float*)take(256);
  p.vm = (float*)take((size_t)NM * D * 4);
  p.dummy = (bf16_t*)take((size_t)(R + NM) * 1024 * 2);
  p.bar = (unsigned*)take(XCD_BAR_WORDS * 4);
  p.ts = (unsigned long long*)take(256 * 64 * 8);
  p.wukT = (bf16_t*)take((size_t)DEPTH * 8 * 128 * 64 * 2); p.wuvT = (bf16_t*)take((size_t)DEPTH * 8 * 64 * 128 * 2);
  if (off > ws_size) return;
  p.gl = (float*)d_out; p.qf = (bf16_t*)((char*)d_out + (size_t)R * 512 * 4); p.vv = (bf16_t*)((char*)d_out + (size_t)R * 512 * 4 + (size_t)R * 512 * 2);

  static int grid_blocks = 0;
  if (!grid_blocks) {
    (void)hipFuncSetAttribute((const void*)k_mega, hipFuncAttributeMaxDynamicSharedMemorySize, LDS_BYTES);
    int dev = 0, cus = 0, per_cu = 0;
    (void)hipGetDevice(&dev);
    (void)hipDeviceGetAttribute(&cus, hipDeviceAttributeMultiprocessorCount, dev);
    (void)hipOccupancyMaxActiveBlocksPerMultiprocessor(&per_cu, (const void*)k_mega, NTHREADS, LDS_BYTES);
    grid_blocks = per_cu >= 1 ? cus : 0;
    if (grid_blocks > 256) grid_blocks = 256;
  }
  if (grid_blocks < 64) return;
  (void)hipMemsetAsync(p.bar, 0, XCD_BAR_WORDS * 4, stream);
  void* args[] = {(void*)&p};
  (void)hipLaunchCooperativeKernel((const void*)k_mega, dim3(grid_blocks), dim3(NTHREADS), args, LDS_BYTES, stream);
}
```

```cpp
#include <hip/hip_runtime.h>
#include <hip/hip_cooperative_groups.h>
#include <stdint.h>

namespace {
typedef unsigned short bf16_t;
constexpr int D = 1024, NB = 8, S = 4096, NM = 16, NIN = 3524, DEPTH = 2;
constexpr int R = NB * S;
constexpr int O_QA = 0, O_CKV = 512, O_QI = 640, O_KI = 896, O_WI = 960, O_GA = 964, O_QH = 1476, O_FH = 1988, O_IH = 2500, O_GH = 3012;
constexpr int TOPK = 256;
constexpr float EPS = 1e-6f;
constexpr float DN_ALPHA = 1.4142135623730951f;

__constant__ unsigned char c_bucket[128] = {
  0, 1, 2, 3, 4, 5, 6, 7, 8, 9, 10, 11, 12, 13, 14, 15, 16, 16, 16, 17, 17, 18, 18, 18, 19, 19, 19, 20, 20, 20, 20, 21,
  21, 21, 21, 22, 22, 22, 22, 22, 23, 23, 23, 23, 23, 23, 24, 24, 24, 24, 24, 24, 25, 25, 25, 25, 25, 25, 25, 26, 26, 26, 26, 26,
  26, 26, 26, 27, 27, 27, 27, 27, 27, 27, 27, 27, 27, 28, 28, 28, 28, 28, 28, 28, 28, 28, 28, 29, 29, 29, 29, 29, 29, 29, 29, 29,
  29, 29, 29, 30, 30, 30, 30, 30, 30, 30, 30, 30, 30, 30, 30, 30, 30, 31, 31, 31, 31, 31, 31, 31, 31, 31, 31, 31, 31, 31, 31, 31};

__device__ __forceinline__ int t5_bucket(int dist) { int n = dist < 0 ? 0 : dist; return n >= 128 ? 31 : (int)c_bucket[n]; }
__device__ __forceinline__ float sigmoidf_(float x) { return 1.0f / (1.0f + expf(-x)); }
__device__ __forceinline__ float siluf_(float x) { return x / (1.0f + expf(-x)); }
__device__ __forceinline__ bf16_t f2bf(float f) { unsigned u = __float_as_uint(f); u += 0x7fffu + ((u >> 16) & 1u); return (bf16_t)(u >> 16); }
__device__ __forceinline__ float bf2f(bf16_t h) { return __uint_as_float(((unsigned)h) << 16); }

struct Params {
  const float *x, *meta, *rel_bias, *lbraw, *w_in, *kvg, *w_uk, *w_uv, *hng, *w_out, *ln_g, *ln_b;
  float* out;
  float *hF, *hFm;
  bf16_t *hHi, *hHim, *hLo, *hLom;
  bf16_t *qa, *qam;
  bf16_t *cN, *cNm;
  bf16_t *gates, *gatesm;
  bf16_t *qf, *qfm;
  float *gl, *glm;
  bf16_t *vv, *vvm;
  bf16_t *qiH, *qiL;
  bf16_t *kiH, *kiL;
  float* wi;
  int* sel; int* nsel;
  float* proj;
  float* ych;
  bf16_t* WmT;
  bf16_t* WsT;
  bf16_t* WoT;
  float* lbv;
  float* stats;
  float* statsm;
  float* vm;
  bf16_t* dummy;
  unsigned* bar;
  unsigned long long* ts;
  bf16_t* wukT;
  bf16_t* wuvT;
};

template <typename TA>
__global__ __launch_bounds__(256) void k_sgemm(const TA* __restrict__ A, int lda, const float* __restrict__ Bm, int ldb,
                                               float* __restrict__ C, int ldc, int M, int N, int K) {
  __shared__ float As[16][64 + 4];
  __shared__ float Bs[16][64 + 4];
  const int tx = threadIdx.x & 15, ty = threadIdx.x >> 4;
  const int m0 = blockIdx.y * 64, n0 = blockIdx.x * 64;
  float acc[4][4] = {};
  for (int k0 = 0; k0 < K; k0 += 16) {
    for (int i = threadIdx.x; i < 64 * 16; i += 256) {
      int r = i >> 4, c = i & 15; int gm = m0 + r;
      float v = 0.f;
      if (gm < M) { if constexpr (sizeof(TA) == 2) v = bf2f(A[(size_t)gm * lda + k0 + c]); else v = A[(size_t)gm * lda + k0 + c]; }
      As[c][r] = v;
    }
    for (int i = threadIdx.x; i < 16 * 64; i += 256) {
      int r = i >> 6, c = i & 63; int gn = n0 + c;
      Bs[r][c] = gn < N ? Bm[(size_t)(k0 + r) * ldb + gn] : 0.f;
    }
    __syncthreads();
#pragma unroll
    for (int kk = 0; kk < 16; ++kk) {
      float a[4], b[4];
#pragma unroll
      for (int i = 0; i < 4; ++i) a[i] = As[kk][ty * 4 + i];
#pragma unroll
      for (int j = 0; j < 4; ++j) b[j] = Bs[kk][tx * 4 + j];
#pragma unroll
      for (int i = 0; i < 4; ++i)
#pragma unroll
        for (int j = 0; j < 4; ++j) acc[i][j] = fmaf(a[i], b[j], acc[i][j]);
    }
    __syncthreads();
  }
#pragma unroll
  for (int i = 0; i < 4; ++i) {
    int gm = m0 + ty * 4 + i; if (gm >= M) continue;
#pragma unroll
    for (int j = 0; j < 4; ++j) { int gn = n0 + tx * 4 + j; if (gn < N) C[(size_t)gm * ldc + gn] = acc[i][j]; }
  }
}

__global__ __launch_bounds__(256) void k_epi(Params p, int layer, int row0, int is_meta) {
  const int lr = blockIdx.x, tid = threadIdx.x;
  const float* pr = p.proj + (size_t)lr * NIN;
  const size_t r = (size_t)row0 + lr;
  bf16_t* qa = (is_meta ? p.qam : p.qa) + r * 512;
  bf16_t* cN = (is_meta ? p.cNm : p.cN) + r * 128;
  bf16_t* gates = (is_meta ? p.gatesm : p.gates) + r * 1024;
  bf16_t* qf = (is_meta ? p.qfm : p.qf) + r * 512;
  float* gl = (is_meta ? p.glm : p.gl) + r * 512;
  bf16_t* vv = (is_meta ? p.vvm : p.vv) + r * 512;
  __shared__ float red[256];
  for (int c = tid; c < 512; c += 256) {
    qa[c] = f2bf(pr[O_QA + c]);
    gates[c] = f2bf(siluf_(pr[O_GA + c]));
    gates[512 + c] = f2bf(siluf_(pr[O_GH + c]));
    qf[c] = f2bf(siluf_(pr[O_QH + c]) * 0.08838834764831845f);
    vv[c] = f2bf(pr[O_IH + c]);
    int hk = c;
    float lb = 0.f;
    if (layer == 1) { float r0 = p.lbraw[hk], r1 = p.lbraw[512 + hk]; float m = fmaxf(r0, r1); float e0 = expf(r0 - m), e1 = expf(r1 - m); lb = e1 / (e0 + e1); }
    float f = lb + (1.0f - lb) * sigmoidf_(pr[O_FH + c]);
    gl[c] = logf(f);
  }
  float v = tid < 128 ? pr[O_CKV + tid] : 0.f;
  red[tid] = v * v; __syncthreads();
  for (int s = 128; s > 0; s >>= 1) { if (tid < s) red[tid] += red[tid + s]; __syncthreads(); }
  float rstd = rsqrtf(red[0] / 128.f + EPS);
  if (tid < 128) cN[tid] = f2bf(v * rstd * p.kvg[layer * 128 + tid]);
  if (!is_meta) {
    { float q = pr[O_QI + tid] * 0.125f; bf16_t h = f2bf(q); p.qiH[r * 256 + tid] = h; p.qiL[r * 256 + tid] = f2bf(q - bf2f(h)); }
    if (tid < 64) { float k = pr[O_KI + tid]; bf16_t h = f2bf(k); p.kiH[r * 64 + tid] = h; p.kiL[r * 64 + tid] = f2bf(k - bf2f(h)); }
    if (tid < 4) p.wi[r * 4 + tid] = pr[O_WI + tid] * 0.5f;
  }
}

__device__ __forceinline__ unsigned f2key(float f) { unsigned u = __float_as_uint(f); return (u & 0x80000000u) ? ~u : (u | 0x80000000u); }

__global__ __launch_bounds__(256) void k_topk(Params p) {
  const int gq = blockIdx.x, b = gq / S, t = gq % S, tid = threadIdx.x;
  const int n = t + 1;
  int* sel = p.sel + (size_t)gq * TOPK;
  if (n <= TOPK) {
    for (int i = tid; i < TOPK; i += 256) sel[i] = i < n ? i : 0;
    if (tid == 0) p.nsel[gq] = n;
    return;
  }
  __shared__ float q[256];
  __shared__ float w[4];
  __shared__ unsigned keys[S];
  __shared__ unsigned hist[256];
  __shared__ unsigned s_prefix, s_need;
  __shared__ unsigned cg[256], ce[256];
  q[tid] = bf2f(p.qiH[(size_t)gq * 256 + tid]) + bf2f(p.qiL[(size_t)gq * 256 + tid]);
  if (tid < 4) w[tid] = p.wi[(size_t)gq * 4 + tid];
  __syncthreads();
  for (int s = tid; s < n; s += 256) {
    const bf16_t* kh = p.kiH + ((size_t)b * S + s) * 64;
    const bf16_t* kl = p.kiL + ((size_t)b * S + s) * 64;
    float sc = 0.f;
#pragma unroll 1
    for (int h = 0; h < 4; ++h) {
      float d = 0.f;
#pragma unroll 8
      for (int j = 0; j < 64; ++j) d = fmaf(q[h * 64 + j], bf2f(kh[j]) + bf2f(kl[j]), d);
      sc = fmaf(w[h], fmaxf(d, 0.f), sc);
    }
    keys[s] = f2key(sc);
  }
  if (tid == 0) { s_prefix = 0; s_need = TOPK; }
  __syncthreads();
  for (int d = 3; d >= 0; --d) {
    hist[tid] = 0; __syncthreads();
    unsigned prefix = s_prefix;
    for (int s = tid; s < n; s += 256) {
      unsigned k = keys[s];
      bool match = (d == 3) ? true : ((k >> (8 * (d + 1))) == prefix);
      if (match) atomicAdd(&hist[(k >> (8 * d)) & 255u], 1u);
    }
    __syncthreads();
    if (tid == 0) {
      unsigned need = s_need, cum = 0; int bin = 255;
      for (; bin > 0; --bin) { if (cum + hist[bin] >= need) break; cum += hist[bin]; }
      s_prefix = (prefix << 8) | (unsigned)bin; s_need = need - cum;
    }
    __syncthreads();
  }
  const unsigned T = s_prefix, need = s_need;
  const int per = (n + 255) / 256;
  const int s0 = tid * per, s1 = min(n, s0 + per);
  unsigned ng = 0, ne = 0;
  for (int s = s0; s < s1; ++s) { unsigned k = keys[s]; ng += k > T; ne += k == T; }
  cg[tid] = ng; ce[tid] = ne; __syncthreads();
  if (tid == 0) { unsigned a = 0, bb = 0; for (int i = 0; i < 256; ++i) { unsigned xx = cg[i], yy = ce[i]; cg[i] = a; ce[i] = bb; a += xx; bb += yy; } }
  __syncthreads();
  unsigned og = cg[tid], oe = ce[tid];
  const unsigned ngt = TOPK - need;
  for (int s = s0; s < s1; ++s) {
    unsigned k = keys[s];
    if (k > T) sel[og++] = s;
    else if (k == T) { if (oe < need) sel[ngt + oe] = s; oe++; }
  }
  if (tid == 0) p.nsel[gq] = TOPK;
}

__global__ __launch_bounds__(256) void k_attn(Params p, int layer) {
  const int tid = threadIdx.x;
  const bool is_meta = blockIdx.x >= R;
  const int gq = is_meta ? (int)blockIdx.x - R : (int)blockIdx.x;
  const int b = is_meta ? 0 : gq / S, t = is_meta ? gq : gq % S;
  const int e = is_meta ? gq : NM + t;
  __shared__ float qa[512];
  __shared__ float ql[8 * 128];
  __shared__ int kidx[NM + TOPK];
  __shared__ float lg[8][NM + TOPK];
  __shared__ float ol[8 * 128];
  __shared__ float red[8];
  const bf16_t* qrow = (is_meta ? p.qam : p.qa) + (size_t)gq * 512;
  qa[tid] = bf2f(qrow[tid]); qa[tid + 256] = bf2f(qrow[tid + 256]);
  int nk;
  if (is_meta) { nk = gq + 1; for (int i = tid; i < nk; i += 256) kidx[i] = -1 - i; }
  else {
    int ns = p.nsel[gq]; nk = NM + ns;
    for (int i = tid; i < nk; i += 256) kidx[i] = i < NM ? -1 - i : p.sel[(size_t)gq * TOPK + (i - NM)];
  }
  __syncthreads();
  const float* w_uk = p.w_uk + (size_t)layer * 8 * 64 * 128;
  const float* w_uv = p.w_uv + (size_t)layer * 8 * 128 * 64;
  for (int o = tid; o < 1024; o += 256) {
    int h = o >> 7, cc = o & 127; float a = 0.f;
    const float* wk = w_uk + (size_t)h * 64 * 128 + cc;
#pragma unroll 8
    for (int d = 0; d < 64; ++d) a = fmaf(qa[h * 64 + d], wk[(size_t)d * 128], a);
    ql[o] = a;
  }
  __syncthreads();
  for (int pp = tid; pp < 8 * nk; pp += 256) {
    int h = pp / nk, j = pp % nk; int kr = kidx[j];
    const bf16_t* cr = kr < 0 ? p.cNm + (size_t)(-1 - kr) * 128 : p.cN + ((size_t)b * S + kr) * 128;
    int kpos = kr < 0 ? (-1 - kr) : NM + kr;
    float a = 0.f;
#pragma unroll 8
    for (int cc = 0; cc < 128; ++cc) a = fmaf(ql[h * 128 + cc], bf2f(cr[cc]), a);
    lg[h][j] = a * 0.125f + p.rel_bias[t5_bucket(e - kpos) * 8 + h];
  }
  __syncthreads();
  {
    int h = tid >> 5, l = tid & 31;
    float m = -INFINITY;
    for (int j = l; j < nk; j += 32) m = fmaxf(m, lg[h][j]);
    for (int o = 16; o > 0; o >>= 1) m = fmaxf(m, __shfl_xor(m, o));
    float s = 0.f;
    for (int j = l; j < nk; j += 32) { float pr = expf(lg[h][j] - m); lg[h][j] = pr; s += pr; }
    for (int o = 16; o > 0; o >>= 1) s += __shfl_xor(s, o);
    if (l == 0) red[h] = 1.0f / s;
  }
  __syncthreads();
  for (int o = tid; o < 1024; o += 256) {
    int h = o >> 7, cc = o & 127; float a = 0.f;
#pragma unroll 4
    for (int j = 0; j < nk; ++j) { int kr = kidx[j]; const bf16_t* cr = kr < 0 ? p.cNm + (size_t)(-1 - kr) * 128 : p.cN + ((size_t)b * S + kr) * 128; a = fmaf(lg[h][j], bf2f(cr[cc]), a); }
    ol[o] = a * red[h];
  }
  __syncthreads();
  bf16_t* grow = (is_meta ? p.gatesm : p.gates) + (size_t)gq * 1024;
  for (int o = tid; o < 512; o += 256) {
    int h = o >> 6, d = o & 63; float a = 0.f;
    const float* wv = w_uv + (size_t)h * 128 * 64 + d;
#pragma unroll 8
    for (int cc = 0; cc < 128; ++cc) a = fmaf(ol[h * 128 + cc], wv[(size_t)cc * 64], a);
    grow[o] = f2bf(a * bf2f(grow[o]));
  }
}

__global__ __launch_bounds__(256) void k_hgrn(Params p, int layer) {
  const int b = blockIdx.x >> 2, h = blockIdx.x & 3, tid = threadIdx.x, v = tid & 127, kh = tid >> 7;
  __shared__ float sq[128], sf[128], sk[128], sv[128];
  __shared__ float so[2][128];
  __shared__ float sred[128];
  const float* gnorm = p.hng + layer * 128;
  float St[64];
#pragma unroll
  for (int i = 0; i < 64; ++i) St[i] = 0.f;
  for (int e = 0; e < NM + S; ++e) {
    const bool im = e < NM;
    const size_t r = im ? (size_t)e : (size_t)b * S + (e - NM);
    const bf16_t* qf = (im ? p.qfm : p.qf) + r * 512 + h * 128;
    const float* gl = (im ? p.glm : p.gl) + r * 512 + h * 128;
    const bf16_t* vv = (im ? p.vvm : p.vv) + r * 512 + h * 128;
    bf16_t* gt = (im ? p.gatesm : p.gates) + r * 1024 + 512 + h * 128;
    if (tid < 128) {
      float f = expf(gl[tid]);
      sq[tid] = bf2f(qf[tid]); sf[tid] = f; sk[tid] = 1.0f - f; sv[tid] = bf2f(vv[tid]);
    }
    __syncthreads();
    float vval = sv[v], o = 0.f;
#pragma unroll
    for (int i = 0; i < 64; ++i) { int k = kh * 64 + i; St[i] = fmaf(sf[k], St[i], sk[k] * vval); o = fmaf(sq[k], St[i], o); }
    so[kh][v] = o;
    __syncthreads();
    if (tid < 128) { float ot = so[0][tid] + so[1][tid]; so[0][tid] = ot; sred[tid] = ot * ot; }
    __syncthreads();
    for (int s = 64; s > 0; s >>= 1) { if (tid < s) sred[tid] += sred[tid + s]; __syncthreads(); }
    if (tid < 128 && (!im || b == 0)) {
      float rstd = rsqrtf(sred[0] / 128.f + EPS);
      gt[tid] = f2bf(so[0][tid] * rstd * gnorm[tid] * bf2f(gt[tid]));
    }
    __syncthreads();
  }
}

__global__ __launch_bounds__(256) void k_ln(const float* __restrict__ h, const float* __restrict__ y, const float* __restrict__ g,
                                            const float* __restrict__ bb, float* __restrict__ dst, bf16_t* __restrict__ hi, bf16_t* __restrict__ lo) {
  const int row = blockIdx.x, tid = threadIdx.x;
  __shared__ float red[256];
  float v[4]; float s = 0.f;
  for (int i = 0; i < 4; ++i) { int c = tid + 256 * i; v[i] = DN_ALPHA * h[(size_t)row * D + c] + y[(size_t)row * D + c]; s += v[i]; }
  red[tid] = s; __syncthreads();
  for (int o = 128; o > 0; o >>= 1) { if (tid < o) red[tid] += red[tid + o]; __syncthreads(); }
  float mu = red[0] / D; __syncthreads();
  float q = 0.f;
  for (int i = 0; i < 4; ++i) { float d = v[i] - mu; q += d * d; }
  red[tid] = q; __syncthreads();
  for (int o = 128; o > 0; o >>= 1) { if (tid < o) red[tid] += red[tid + o]; __syncthreads(); }
  float rstd = rsqrtf(red[0] / D + EPS);
  for (int i = 0; i < 4; ++i) {
    int c = tid + 256 * i; float o = (v[i] - mu) * rstd * g[c] + bb[c];
    dst[(size_t)row * D + c] = o;
    if (hi) { bf16_t hh = f2bf(o); hi[(size_t)row * D + c] = hh; lo[(size_t)row * D + c] = f2bf(o - bf2f(hh)); }
  }
}
#define LAS __attribute__((address_space(3)))
typedef short bf16x8 __attribute__((ext_vector_type(8)));
typedef float f32x4 __attribute__((ext_vector_type(4)));
typedef unsigned u32x2 __attribute__((ext_vector_type(2)));
typedef unsigned u32x4 __attribute__((ext_vector_type(4)));
constexpr int NTHREADS = 512;
constexpr int LDS_BYTES = 160 * 1024;
constexpr int BM = 256, BK = 64, HALF = 128, HTB = HALF * BK * 2, STAGE_BYTES = 8 * HTB;
constexpr int LDS_EXTRA = STAGE_BYTES;
#define TPROBE 0
#define TP_S 0
#define TP_E 1
#define TP_LO 0
#define TP_HI 256
#define TS_MARK(k) do { if (TPROBE && threadIdx.x == 0) p.ts[(size_t)blockIdx.x * 64 + (k)] = __builtin_amdgcn_s_memrealtime(); } while (0)
#define TS_ACC_BEGIN() unsigned long long tacc_ = TPROBE ? __builtin_amdgcn_s_memrealtime() : 0ull
#define TS_ACC(k) do { if (TPROBE) { const unsigned long long t2_ = __builtin_amdgcn_s_memrealtime(); if (threadIdx.x == 0) p.ts[(size_t)blockIdx.x * 64 + (k)] += t2_ - tacc_; tacc_ = t2_; } } while (0)
#define PROBE_REP_SCORE 0
#define ABL_SCORE 0
#define PROBE_REP_SELECT 0
#define PROBE_REP_ATT 0
#define PROBE_REP_QLAT 0

typedef float f32x2v __attribute__((ext_vector_type(2)));
typedef __bf16 bf16x2v __attribute__((ext_vector_type(2)));
__device__ __forceinline__ unsigned pack_bf16(float lo, float hi) { const f32x2v v = {lo, hi}; const bf16x2v b = __builtin_convertvector(v, bf16x2v); return __builtin_bit_cast(unsigned, b); }
__device__ __forceinline__ bf16_t f2bf_fast(float x) { return (bf16_t)(pack_bf16(x, 0.f) & 0xffffu); }
__device__ __forceinline__ float fast_sigmoid(float x) { return __builtin_amdgcn_rcpf(1.0f + __expf(-x)); }
__device__ __forceinline__ float fast_silu(float x) { return x * __builtin_amdgcn_rcpf(1.0f + __expf(-x)); }

__device__ __forceinline__ int lds_byte(int r, int c) { const int st = (r >> 4) * 2 + (c >> 5), rr = r & 15, cc = c & 31, ob = rr * 64 + cc * 2; return st * 1024 + (ob ^ (((ob >> 9) & 1) << 5)); }
__device__ __forceinline__ void stage_rc(int b, int& Rr, int& Cc) { const int st = b / 1024, sb = b % 1024, swz = sb ^ (((sb >> 9) & 1) << 5); Rr = (st >> 1) * 16 + swz / 64; Cc = (st & 1) * 32 + (swz % 64) / 2; }

struct GUnit { int pm, pn; };
__device__ __forceinline__ bool unit_next(int i, int nM, int nN, GUnit& u) {
  const int nwg = nM * nN; const long L = (long)i * gridDim.x + blockIdx.x; if (L >= nwg) return false;
  int wgid = (int)L; { const int q = nwg / 8, r = nwg % 8, xcd = wgid % 8, off = wgid / 8; wgid = (xcd < r ? xcd * (q + 1) : r * (q + 1) + (xcd - r) * q) + off; }
  const int nig = 8 * nN, gid = wgid / nig, fm = gid * 8, gsz = (nM - fm) < 8 ? (nM - fm) : 8;
  u.pm = fm + ((wgid % nig) % gsz); u.pn = (wgid % nig) / gsz; return true;
}

struct SrcP1 {
  const char* Ahi; const char* Alo; const char* Wm; const char* Ws;
  __device__ __forceinline__ int nt(const GUnit& u) const { return u.pn < 12 ? 16 : 48; }
  __device__ __forceinline__ int ldb(const GUnit& u) const { return u.pn < 12 ? 1024 : 3072; }
  __device__ __forceinline__ const char* a(const GUnit& u, int kt) const { const char* b = (kt >= 16 && kt < 32) ? Alo : Ahi; return b + (size_t)u.pm * (256 * 1024 * 2) + (size_t)(kt & 15) * 128; }
  __device__ __forceinline__ const char* b(const GUnit& u, int kt) const { return u.pn < 12 ? Wm + (size_t)u.pn * (256 * 1024 * 2) + (size_t)kt * 128 : Ws + (size_t)(u.pn - 12) * (256 * 3072 * 2) + (size_t)kt * 128; }
};
struct SrcP3 {
  const char* A; const char* W;
  __device__ __forceinline__ int nt(const GUnit&) const { return 16; }
  __device__ __forceinline__ int ldb(const GUnit&) const { return 1024; }
  __device__ __forceinline__ const char* a(const GUnit& u, int kt) const { return A + (size_t)u.pm * (256 * 1024 * 2) + (size_t)kt * 128; }
  __device__ __forceinline__ const char* b(const GUnit& u, int kt) const { return W + (size_t)u.pn * (256 * 1024 * 2) + (size_t)kt * 128; }
};


template <int CTRL, int ROWMASK = 0xf, bool BC = true>
__device__ __forceinline__ float dppf(float v) { return __int_as_float(__builtin_amdgcn_update_dpp(0, __float_as_int(v), CTRL, ROWMASK, 0xf, BC)); }
__device__ __forceinline__ float row_sum16(float v) { v += dppf<0x128>(v); v += dppf<0x124>(v); v += dppf<0x122>(v); v += dppf<0x121>(v); return v; }
__device__ __forceinline__ unsigned wave_incl_scan(unsigned v) {
  v += (unsigned)__builtin_amdgcn_update_dpp(0, (int)v, 0x111, 0xf, 0xf, true);
  v += (unsigned)__builtin_amdgcn_update_dpp(0, (int)v, 0x112, 0xf, 0xf, true);
  v += (unsigned)__builtin_amdgcn_update_dpp(0, (int)v, 0x114, 0xf, 0xf, true);
  v += (unsigned)__builtin_amdgcn_update_dpp(0, (int)v, 0x118, 0xf, 0xf, true);
  v += (unsigned)__builtin_amdgcn_update_dpp(0, (int)v, 0x142, 0xa, 0xf, false);
  v += (unsigned)__builtin_amdgcn_update_dpp(0, (int)v, 0x143, 0xc, 0xf, false);
  return v;
}
__device__ __forceinline__ float rows_max(float x) {
  auto r = __builtin_amdgcn_permlane16_swap(__float_as_uint(x), __float_as_uint(x), false, false); x = fmaxf(__uint_as_float(r[0]), __uint_as_float(r[1]));
  auto q = __builtin_amdgcn_permlane32_swap(__float_as_uint(x), __float_as_uint(x), false, false); return fmaxf(__uint_as_float(q[0]), __uint_as_float(q[1])); }
__device__ __forceinline__ float rows_sum(float x) {
  auto r = __builtin_amdgcn_permlane16_swap(__float_as_uint(x), __float_as_uint(x), false, false); x = __uint_as_float(r[0]) + __uint_as_float(r[1]);
  auto q = __builtin_amdgcn_permlane32_swap(__float_as_uint(x), __float_as_uint(x), false, false); return __uint_as_float(q[0]) + __uint_as_float(q[1]); }
__device__ __forceinline__ size_t kfrag(size_t row, int c) { return (((((row >> 4) * 2 + (size_t)(c >> 5)) * 4 + (size_t)((c >> 3) & 3)) * 16 + (row & 15)) * 8) + (size_t)(c & 7); }

struct EpiP1 {
  Params p; int layer;
  __device__ __forceinline__ void operator()(const f32x4 (&acc)[2][2][4][2], const GUnit& u, int wr, int wc, int fr, int fq, LAS unsigned char* lds) const {
    const int row0 = u.pm * BM + wr * 64 + fr;
    if (u.pn < 12) {
      const int kind = u.pn >> 1; const int c00 = (u.pn & 1) * 256 + wc * 32 + 4 * fq;
#pragma unroll
      for (int ai = 0; ai < 2; ++ai)
#pragma unroll
        for (int m = 0; m < 4; ++m) {
          const size_t row = (size_t)(row0 + ai * HALF + m * 16);
#pragma unroll
          for (int bj = 0; bj < 2; ++bj)
#pragma unroll
            for (int n = 0; n < 2; ++n) {
              const int c = c00 + bj * HALF + n * 16; f32x4 v = acc[ai][bj][m][n];
              if (kind == 3) {
                const f32x4 lb = *(const f32x4*)(p.lbv + layer * 512 + c); f32x4 o;
#pragma unroll
                for (int j = 0; j < 4; ++j) o[j] = __logf(lb[j] + (1.0f - lb[j]) * fast_sigmoid(v[j]));
                *(f32x4*)(p.gl + row * 512 + c) = o;
              } else {
                if (kind == 1 || kind == 5) {
#pragma unroll
                  for (int j = 0; j < 4; ++j) v[j] = fast_silu(v[j]);
                } else if (kind == 2) {
#pragma unroll
                  for (int j = 0; j < 4; ++j) v[j] = fast_silu(v[j]) * 0.08838834764831845f;
                }
                u32x2 w; w.x = pack_bf16(v[0], v[1]); w.y = pack_bf16(v[2], v[3]);
                bf16_t* dst = kind == 0 ? p.qa + row * 512 + c : kind == 1 ? p.gates + row * 1024 + c : kind == 2 ? p.qf + row * 512 + c
                            : kind == 4 ? p.vv + row * 512 + c : p.gates + row * 1024 + 512 + c;
                *(u32x2*)dst = w;
              }
            }
        }
    } else if (u.pn == 12) {
      const int c00 = wc * 32 + 4 * fq;
#pragma unroll
      for (int ai = 0; ai < 2; ++ai)
#pragma unroll
        for (int m = 0; m < 4; ++m) {
          const size_t row = (size_t)(row0 + ai * HALF + m * 16);
#pragma unroll
          for (int bj = 0; bj < 2; ++bj)
#pragma unroll
            for (int n = 0; n < 2; ++n) {
              const int c = c00 + bj * HALF + n * 16; const f32x4 v = acc[ai][bj][m][n] * 0.125f;
              u32x2 wh, wl; wh.x = pack_bf16(v[0], v[1]); wh.y = pack_bf16(v[2], v[3]);
              wl.x = pack_bf16(v[0] - __uint_as_float(wh.x << 16), v[1] - __uint_as_float(wh.x & 0xffff0000u)); wl.y = pack_bf16(v[2] - __uint_as_float(wh.y << 16), v[3] - __uint_as_float(wh.y & 0xffff0000u));
              *(u32x2*)(p.qiH + row * 256 + c) = wh; *(u32x2*)(p.qiL + row * 256 + c) = wl;
            }
        }
    } else {
      LAS float* red = (LAS float*)(lds + LDS_EXTRA);
#pragma unroll
      for (int ai = 0; ai < 2; ++ai)
#pragma unroll
        for (int m = 0; m < 4; ++m) {
          float s = 0.f;
#pragma unroll
          for (int n = 0; n < 2; ++n) { const f32x4 v = acc[ai][0][m][n]; s += (v[0] * v[0] + v[1] * v[1]) + (v[2] * v[2] + v[3] * v[3]); }
          s = rows_sum(s);
          if (fq == 0) red[(ai * HALF + wr * 64 + m * 16 + fr) * 4 + wc] = s;
        }
      asm volatile("s_waitcnt lgkmcnt(0)" ::: "memory"); __builtin_amdgcn_s_barrier(); asm volatile("" ::: "memory");
#pragma unroll
      for (int ai = 0; ai < 2; ++ai)
#pragma unroll
        for (int m = 0; m < 4; ++m) {
          const int lr = ai * HALF + wr * 64 + m * 16 + fr; const size_t row = (size_t)(u.pm * BM + lr);
          const f32x4 pr = *(const LAS f32x4*)(red + lr * 4);
          const float rstd = rsqrtf(((pr[0] + pr[1]) + (pr[2] + pr[3])) * (1.0f / 128.0f) + EPS);
#pragma unroll
          for (int n = 0; n < 2; ++n) {
            const int c = wc * 32 + n * 16 + 4 * fq; const f32x4 g = *(const f32x4*)(p.kvg + layer * 128 + c); const f32x4 v = acc[ai][0][m][n] * rstd * g;
            u32x2 w; w.x = pack_bf16(v[0], v[1]); w.y = pack_bf16(v[2], v[3]); *(u32x2*)(p.cN + row * 128 + c) = w;
          }
          if (wc < 2) {
#pragma unroll
            for (int n = 0; n < 2; ++n) {
              const int c = wc * 32 + n * 16 + 4 * fq; const f32x4 v = acc[ai][1][m][n];
              u32x2 wh, wl; wh.x = pack_bf16(v[0], v[1]); wh.y = pack_bf16(v[2], v[3]);
              wl.x = pack_bf16(v[0] - __uint_as_float(wh.x << 16), v[1] - __uint_as_float(wh.x & 0xffff0000u)); wl.y = pack_bf16(v[2] - __uint_as_float(wh.y << 16), v[3] - __uint_as_float(wh.y & 0xffff0000u));
              *(u32x2*)(p.kiH + kfrag(row, c)) = wh; *(u32x2*)(p.kiL + kfrag(row, c)) = wl;
            }
          } else if (wc == 2 && fq == 0) {
            *(f32x4*)(p.wi + row * 4) = acc[ai][1][m][0] * 0.5f;
          }
        }
    }
  }
};

struct EpiP3 {
  Params p; const float* hres;
  __device__ __forceinline__ void operator()(const f32x4 (&acc)[2][2][4][2], const GUnit& u, int wr, int wc, int fr, int fq, LAS unsigned char* lds) const {
    const int row0 = u.pm * BM + wr * 64 + fr; const int c00 = u.pn * BM + wc * 32 + 4 * fq;
#pragma unroll
    for (int ai = 0; ai < 2; ++ai)
#pragma unroll
      for (int m = 0; m < 4; ++m) {
        const size_t row = (size_t)(row0 + ai * HALF + m * 16); float s = 0.f, q = 0.f;
#pragma unroll
        for (int bj = 0; bj < 2; ++bj)
#pragma unroll
          for (int n = 0; n < 2; ++n) {
            const int c = c00 + bj * HALF + n * 16; const f32x4 h = *(const f32x4*)(hres + row * D + c);
            const f32x4 v = h * DN_ALPHA + acc[ai][bj][m][n];
            *(f32x4*)(p.hF + row * D + c) = v;
            s += (v[0] + v[1]) + (v[2] + v[3]); q += (v[0] * v[0] + v[1] * v[1]) + (v[2] * v[2] + v[3] * v[3]);
          }
        s = rows_sum(s); q = rows_sum(q);
        if (fq == 0) { float2 st; st.x = s; st.y = q; *(float2*)(p.stats + (row * 16 + u.pn * 4 + wc) * 2) = st; }
        asm volatile("" ::: "memory");
      }
  }
};

template <class Src, class Epi>
__device__ __forceinline__ void gemm_phase(LAS unsigned char* lds, const Src S, const int nM, const int nN, const Epi& E) {
  int tid_ = threadIdx.x; asm volatile("" : "+v"(tid_));
  const int tid = tid_, wid = __builtin_amdgcn_readfirstlane(tid >> 6), lane = tid & 63, wr = wid >> 2, wc = wid & 3, fr = lane & 15, fq = lane >> 4;
  unsigned voffA[2], voffB1[2], voffB3[2];
#pragma unroll
  for (int i = 0; i < 2; ++i) { int Rr, Cc; stage_rc(tid * 16 + i * 8192, Rr, Cc); voffA[i] = (unsigned)(Rr * 1024 + Cc) * 2u; voffB1[i] = voffA[i]; voffB3[i] = (unsigned)(Rr * 3072 + Cc) * 2u; }
  const size_t hstepA = (size_t)HALF * 1024 * 2;
  const unsigned ldsw = (unsigned)wid * 1024u;
  const int aoff = lds_byte(wr * 64 + fr, fq * 8), boff = lds_byte(wc * 32 + fr, fq * 8);
#define G_SA(b, h) (((b) * 2 + (h)) * HTB)
#define G_SB(b, h) ((4 + (b) * 2 + (h)) * HTB)
#define G_STAGE(bufoff, gbase, v0, v1) do { \
    __builtin_amdgcn_global_load_lds((const unsigned*)((const char*)(gbase) + (v0)), (LAS unsigned*)(lds + (bufoff) + ldsw), 16, 0, 0); \
    __builtin_amdgcn_global_load_lds((const unsigned*)((const char*)(gbase) + (v1)), (LAS unsigned*)(lds + (bufoff) + ldsw + 8192), 16, 0, 0); } while (0)
#define G_STAGE_A(bufoff, gbase) G_STAGE(bufoff, gbase, voffA[0], voffA[1])
#define G_LDA(dst, b, h) do { _Pragma("unroll") for (int m = 0; m < 4; ++m) _Pragma("unroll") for (int k = 0; k < 2; ++k) dst[m][k] = *(const LAS bf16x8*)(lds + G_SA(b, h) + aoff + m * 2048 + k * 1024); } while (0)
#define G_LDB(dst, b, h) do { _Pragma("unroll") for (int n = 0; n < 2; ++n) _Pragma("unroll") for (int k = 0; k < 2; ++k) dst[n][k] = *(const LAS bf16x8*)(lds + G_SB(b, h) + boff + n * 2048 + k * 1024); } while (0)
#define G_MMA(ai, bj, At, Bt) do { __builtin_amdgcn_s_setprio(1); _Pragma("unroll") for (int m = 0; m < 4; ++m) _Pragma("unroll") for (int n = 0; n < 2; ++n) _Pragma("unroll") for (int k = 0; k < 2; ++k) \
    acc[ai][bj][m][n] = __builtin_amdgcn_mfma_f32_16x16x32_bf16(Bt[n][k], At[m][k], acc[ai][bj][m][n], 0, 0, 0); __builtin_amdgcn_s_setprio(0); } while (0)
#define G_WAIT_V(n) asm volatile("s_waitcnt vmcnt(" #n ")" ::: "memory")
#define G_WAIT_L(n) asm volatile("s_waitcnt lgkmcnt(" #n ")" ::: "memory")
#define G_BAR __builtin_amdgcn_s_barrier()
#define G_SCHED __builtin_amdgcn_sched_barrier(0)
  const Params& p = E.p;
  GUnit cur, nxt; int ui = 0;
  if (!unit_next(0, nM, nN, cur)) return;
  f32x4 acc[2][2][4][2];
#pragma unroll
  for (int a = 0; a < 2; ++a)
#pragma unroll
    for (int b = 0; b < 2; ++b)
#pragma unroll
      for (int m = 0; m < 4; ++m)
#pragma unroll
        for (int n = 0; n < 2; ++n) acc[a][b][m][n] = (f32x4){0.f, 0.f, 0.f, 0.f};
  bf16x8 At[4][2], B0[2][2], B1[2][2];
  {
    const bool w3 = S.ldb(cur) == 3072; const unsigned vb0 = w3 ? voffB3[0] : voffB1[0], vb1 = w3 ? voffB3[1] : voffB1[1]; const size_t hsB = (size_t)HALF * S.ldb(cur) * 2;
    const char* cA0 = S.a(cur, 0); const char* cB0 = S.b(cur, 0); const char* cA1 = S.a(cur, 1); const char* cB1 = S.b(cur, 1);
    G_STAGE(G_SB(0, 0), cB0, vb0, vb1); G_STAGE_A(G_SA(0, 0), cA0); G_STAGE(G_SB(0, 1), cB0 + hsB, vb0, vb1); G_STAGE_A(G_SA(0, 1), cA0 + hstepA);
    if (wr == 1) G_BAR;
    G_WAIT_V(4); G_BAR;
    G_STAGE(G_SB(1, 0), cB1, vb0, vb1); G_STAGE_A(G_SA(1, 0), cA1); G_STAGE(G_SB(1, 1), cB1 + hsB, vb0, vb1);
    G_WAIT_V(6); G_BAR;
  }
  for (;;) {
    TS_ACC_BEGIN();
    const bool has_next = unit_next(ui + 1, nM, nN, nxt);
    const GUnit nu = has_next ? nxt : cur;
    const int nt = S.nt(cur);
    const bool cw3 = S.ldb(cur) == 3072, nw3 = S.ldb(nu) == 3072;
    for (int t = 0; t < nt; t += 2) {
      const bool last = (t == nt - 2);
      const char* a1 = S.a(cur, t + 1);
      const char* a2 = last ? S.a(nu, 0) : S.a(cur, t + 2); const char* b2 = last ? S.b(nu, 0) : S.b(cur, t + 2);
      const char* a3 = last ? S.a(nu, 1) : S.a(cur, t + 3); const char* b3 = last ? S.b(nu, 1) : S.b(cur, t + 3);
      const bool w3 = last ? nw3 : cw3;
      const unsigned vb0 = w3 ? voffB3[0] : voffB1[0], vb1 = w3 ? voffB3[1] : voffB1[1]; const size_t hsB = w3 ? (size_t)HALF * 3072 * 2 : (size_t)HALF * 1024 * 2;
      G_LDB(B0, 0, 0); G_SCHED; G_LDA(At, 0, 0); G_STAGE_A(G_SA(1, 1), a1 + hstepA);
      G_WAIT_L(8); G_BAR; G_WAIT_L(0); G_MMA(0, 0, At, B0); G_BAR; G_SCHED;
      G_LDB(B1, 0, 1); G_STAGE(G_SB(0, 0), b2, vb0, vb1);
      G_BAR; G_WAIT_L(0); G_MMA(0, 1, At, B1); G_BAR;
      G_LDA(At, 0, 1); G_STAGE_A(G_SA(0, 0), a2);
      G_BAR; G_WAIT_L(0); G_MMA(1, 0, At, B0); G_BAR; G_SCHED;
      G_STAGE(G_SB(0, 1), b2 + hsB, vb0, vb1);
      G_WAIT_V(6); G_BAR; G_MMA(1, 1, At, B1); G_BAR;
      G_LDB(B0, 1, 0); G_SCHED; G_LDA(At, 1, 0); G_STAGE_A(G_SA(0, 1), a2 + hstepA);
      G_WAIT_L(8); G_BAR; G_WAIT_L(0); G_MMA(0, 0, At, B0); G_BAR; G_SCHED;
      G_LDB(B1, 1, 1); G_STAGE(G_SB(1, 0), b3, vb0, vb1);
      G_BAR; G_WAIT_L(0); G_MMA(0, 1, At, B1); G_BAR;
      G_LDA(At, 1, 1); G_STAGE_A(G_SA(1, 0), a3);
      G_BAR; G_WAIT_L(0); G_MMA(1, 0, At, B0); G_BAR; G_SCHED;
      G_STAGE(G_SB(1, 1), b3 + hsB, vb0, vb1);
      G_WAIT_V(6); G_BAR; G_MMA(1, 1, At, B1); G_BAR;
    }
    TS_ACC(56);
    E(acc, cur, wr, wc, fr, fq, lds);
    TS_ACC(57);
    if (!has_next) break;
#pragma unroll
    for (int a = 0; a < 2; ++a)
#pragma unroll
      for (int b = 0; b < 2; ++b)
#pragma unroll
        for (int m = 0; m < 4; ++m)
#pragma unroll
          for (int n = 0; n < 2; ++n) acc[a][b][m][n] = (f32x4){0.f, 0.f, 0.f, 0.f};
    cur = nxt; ++ui;
  }
  G_WAIT_V(0);
  if (wr == 0) G_BAR;
  G_BAR;
#undef G_SA
#undef G_SB
#undef G_STAGE
#undef G_STAGE_A
#undef G_LDA
#undef G_LDB
#undef G_MMA
#undef G_WAIT_V
#undef G_WAIT_L
#undef G_BAR
#undef G_SCHED
}

__device__ __forceinline__ void phase_prep(const Params& p, LAS unsigned char* lds) {
  int tid_ = threadIdx.x; asm volatile("" : "+v"(tid_));
  const int tid = tid_, nb = gridDim.x, bid = blockIdx.x;
  LAS float* tile = (LAS float*)lds;
  const int NJ = DEPTH * (48 + 8 + 16) * 16;
  for (int job = bid; job < NJ; job += nb) {
    const int l = job / ((48 + 8 + 16) * 16); int rem = job % ((48 + 8 + 16) * 16); const int ntile = rem / 16, kt = rem % 16;
    const int kind = ntile < 48 ? 0 : ntile < 56 ? 1 : 2; const int n0 = kind == 0 ? ntile * 64 : kind == 1 ? (ntile - 48) * 64 : (ntile - 56) * 64;
    const float* src = kind == 2 ? p.w_out + (size_t)l * D * D : p.w_in + (size_t)l * D * NIN; const int lds_ = kind == 2 ? D : NIN;
    for (int i = tid; i < 64 * 64; i += NTHREADS) {
      const int kk = i >> 6, nn = i & 63; const int n = n0 + nn; int col;
      if (kind == 0) { const int grp = n >> 9, cc = n & 511; col = (grp == 0 ? O_QA : grp == 1 ? O_GA : grp == 2 ? O_QH : grp == 3 ? O_FH : grp == 4 ? O_IH : O_GH) + cc; }
      else if (kind == 1) { col = n < 256 ? O_QI + n : n < 384 ? O_CKV + (n - 256) : n < 448 ? O_KI + (n - 384) : n < 452 ? O_WI + (n - 448) : -1; }
      else col = n;
      tile[kk * 65 + nn] = col >= 0 ? src[(size_t)(kt * 64 + kk) * lds_ + col] : 0.f;
    }
    __syncthreads();
    for (int i = tid; i < 64 * 64; i += NTHREADS) {
      const int nn = i >> 6, kk = i & 63; const float v = tile[kk * 65 + nn]; const int n = n0 + nn, k = kt * 64 + kk;
      if (kind == 0) p.WmT[((size_t)l * 3072 + n) * 1024 + k] = f2bf(v);
      else if (kind == 2) p.WoT[((size_t)l * 1024 + n) * 1024 + k] = f2bf(v);
      else { const bf16_t h = f2bf(v), lo = f2bf(v - bf2f(h)); bf16_t* d = p.WsT + ((size_t)l * 512 + n) * 3072; d[k] = h; d[1024 + k] = h; d[2048 + k] = lo; }
    }
    __syncthreads();
  }
  for (int i = bid * NTHREADS + tid; i < 512; i += nb * NTHREADS) {
    const float r0 = p.lbraw[i], r1 = p.lbraw[512 + i]; const float m = fmaxf(r0, r1); const float e0 = expf(r0 - m), e1 = expf(r1 - m);
    p.lbv[i] = 0.f; p.lbv[512 + i] = e1 / (e0 + e1);
  }
  for (int i = bid * NTHREADS + tid; i < DEPTH * 8 * 128 * 64; i += nb * NTHREADS) {
    const int d = i & 63, c = (i >> 6) & 127, lh = i >> 13;
    p.wukT[i] = f2bf(p.w_uk[((size_t)lh * 64 + d) * 128 + c]);
    const int c2 = i & 127, d2 = (i >> 7) & 63;
    p.wuvT[i] = f2bf(p.w_uv[((size_t)lh * 128 + c2) * 64 + d2]);
  }
  const size_t n4 = (size_t)(R + NM) * D / 4;
  for (size_t i = (size_t)bid * NTHREADS + tid; i < n4; i += (size_t)nb * NTHREADS) {
    const size_t row = i / (D / 4); const int c4 = (int)(i % (D / 4));
    const bool im = row >= (size_t)R; const size_t rr = im ? row - R : row;
    const f32x4 v = *(const f32x4*)((im ? p.meta : p.x) + rr * D + c4 * 4);
    u32x2 wh, wl; wh.x = pack_bf16(v[0], v[1]); wh.y = pack_bf16(v[2], v[3]);
    wl.x = pack_bf16(v[0] - __uint_as_float(wh.x << 16), v[1] - __uint_as_float(wh.x & 0xffff0000u)); wl.y = pack_bf16(v[2] - __uint_as_float(wh.y << 16), v[3] - __uint_as_float(wh.y & 0xffff0000u));
    *(u32x2*)((im ? p.hHim : p.hHi) + rr * D + c4 * 4) = wh; *(u32x2*)((im ? p.hLom : p.hLo) + rr * D + c4 * 4) = wl;
  }
}

__device__ __forceinline__ void phase_ln(const Params& p, int layer, float* dst, bool write_split) {
  int tid_ = threadIdx.x; asm volatile("" : "+v"(tid_));
  const int tid = tid_, wid = tid >> 6, lane = tid & 63;
  const float* g = p.ln_g + layer * D; const float* bb = p.ln_b + layer * D;
  for (int row = blockIdx.x * 8 + wid; row < R; row += gridDim.x * 8) {
    float s = 0.f, q = 0.f;
    if (lane < 16) { const float2 st = *(const float2*)(p.stats + ((size_t)row * 16 + lane) * 2); s = st.x; q = st.y; }
#pragma unroll
    for (int o = 8; o > 0; o >>= 1) { s += __shfl_xor(s, o); q += __shfl_xor(q, o); }
    s = __shfl(s, 0); q = __shfl(q, 0);
    const float mean = s * (1.0f / D); const float var = fmaxf(q * (1.0f / D) - mean * mean, 0.f); const float rstd = rsqrtf(var + EPS);
#pragma unroll
    for (int i = 0; i < 4; ++i) {
      const int c = (i * 64 + lane) * 4;
      const f32x4 v = *(const f32x4*)(p.hF + (size_t)row * D + c); const f32x4 gg = *(const f32x4*)(g + c); const f32x4 bv = *(const f32x4*)(bb + c);
      const f32x4 o = (v - mean) * rstd * gg + bv;
      *(f32x4*)(dst + (size_t)row * D + c) = o;
      if (write_split) {
        u32x2 wh, wl; wh.x = pack_bf16(o[0], o[1]); wh.y = pack_bf16(o[2], o[3]);
        wl.x = pack_bf16(o[0] - __uint_as_float(wh.x << 16), o[1] - __uint_as_float(wh.x & 0xffff0000u)); wl.y = pack_bf16(o[2] - __uint_as_float(wh.y << 16), o[3] - __uint_as_float(wh.y & 0xffff0000u));
        *(u32x2*)(p.hHi + (size_t)row * D + c) = wh; *(u32x2*)(p.hLo + (size_t)row * D + c) = wl;
      }
    }
  }
}

constexpr int K16_STRIDE = 8208;
constexpr int A_BIG = 0;
constexpr int A_SEL = 131328;
constexpr int A_CM = A_SEL + 8192;
constexpr int A_MISC = A_CM + 4096;
constexpr int A_HIST = A_MISC;
constexpr int A_CAND = A_MISC + 16448;
constexpr int A_RB = A_MISC + 16448 + 1024;
constexpr int A_BKT = A_RB + 1024;
constexpr int A_NSEL = A_BKT + 128;
static_assert(A_NSEL + 64 <= LDS_BYTES, "attention LDS map");

__device__ __forceinline__ unsigned off_b(unsigned row, unsigned ch) { return 256u * row + 16u * (ch ^ (((row & 3) << 2) | ((row >> 2) & 3))); }
__device__ __forceinline__ void glds16_asm(const void* gsrc, unsigned lds_dst) {
  unsigned keep;
  asm volatile("s_mov_b32 %0, m0\n\ts_mov_b32 m0, %2\n\ts_nop 0\n\tglobal_load_lds_dwordx4 %1, off\n\ts_mov_b32 m0, %0" : "=&s"(keep) : "v"(gsrc), "s"(lds_dst) : "memory");
}
__device__ __forceinline__ void wave_lds_sync() { asm volatile("s_waitcnt lgkmcnt(0)" ::: "memory"); }
typedef unsigned short u16x4 __attribute__((ext_vector_type(4)));
typedef unsigned short u16x8 __attribute__((ext_vector_type(8)));

typedef short s16x4 __attribute__((ext_vector_type(4)));
__device__ __forceinline__ s16x4 lds_tr(const LAS unsigned char* ptr) { return __builtin_amdgcn_ds_read_tr16_b64_v4i16((LAS s16x4*)ptr); }
__device__ __forceinline__ bf16x8 cat4(s16x4 a, s16x4 b) { return __builtin_shufflevector(a, b, 0, 1, 2, 3, 4, 5, 6, 7); }
__device__ __forceinline__ f32x4 mfma16(bf16x8 a, bf16x8 b, f32x4 c) { return __builtin_amdgcn_mfma_f32_16x16x32_bf16(a, b, c, 0, 0, 0); }

__device__ __forceinline__ void wave_find_bin(const unsigned (&c)[4], unsigned need, int lane, unsigned& bin, unsigned& above) {
  const unsigned tot = c[0] + c[1] + c[2] + c[3];
  unsigned cum = wave_incl_scan(tot) - tot;
  unsigned fb = 0xffffffffu, fa = 0;
#pragma unroll
  for (int i = 0; i < 4; ++i) { if (fb == 0xffffffffu && cum < need && cum + c[i] >= need) { fb = 255u - 4u * lane - i; fa = cum; } cum += c[i]; }
  const unsigned long long m = __ballot(fb != 0xffffffffu);
  const int src = m ? (int)__builtin_ctzll(m) : 0;
  bin = (unsigned)__builtin_amdgcn_readlane((int)fb, src); above = (unsigned)__builtin_amdgcn_readlane((int)fa, src);
  if (!m) { bin = 0; above = 0; }
}

__device__ __forceinline__ void attn_tile(const Params& p, const int layer, LAS unsigned char* lds, const bool is_meta, const int b, const int j,
                                          const bf16_t* wukT, const bf16_t* wuvT, const bool dry = false) {
  int tid_ = threadIdx.x; asm volatile("" : "+v"(tid_));
  const int tid = tid_, wid = __builtin_amdgcn_readfirstlane(tid >> 6), lane = tid & 63, fr = lane & 15, g = lane >> 4;
  const int t0 = 16 * j; const size_t r0 = is_meta ? 0 : (size_t)b * S + t0;
  const bf16_t* cNb = p.cN + (size_t)b * S * 128;
  LAS int* nselp = (LAS int*)(lds + A_NSEL);
  TS_ACC_BEGIN();
  if (!is_meta && j >= 16) {
    for (int rep_ = 0; rep_ <= PROBE_REP_SCORE; ++rep_) {
      bf16x8 qH[4][2], qL[4][2];
      const bf16_t* qh = p.qiH + (r0 + fr) * 256 + g * 8; const bf16_t* ql = p.qiL + (r0 + fr) * 256 + g * 8;
#pragma unroll
      for (int h = 0; h < 4; ++h)
#pragma unroll
        for (int ks = 0; ks < 2; ++ks) { qH[h][ks] = *(const bf16x8*)(qh + h * 64 + ks * 32); qL[h][ks] = *(const bf16x8*)(ql + h * 64 + ks * 32); }
      const f32x4 w = *(const f32x4*)(p.wi + (r0 + fr) * 4);
      const int tq = t0 + fr;
      LAS unsigned* h1 = (LAS unsigned*)(lds + A_HIST) + fr * 257;
      const bf16_t* kbh = p.kiH + (size_t)b * S * 64 + lane * 8; const bf16_t* kbl = p.kiL + (size_t)b * S * 64 + lane * 8;
      bf16x8 nH[2], nL[2], mH[2], mL[2];
      if (wid <= j) {
#pragma unroll
        for (int ks = 0; ks < 2; ++ks) { nH[ks] = *(const bf16x8*)(kbh + (size_t)wid * 1024 + ks * 512); nL[ks] = *(const bf16x8*)(kbl + (size_t)wid * 1024 + ks * 512); }
      }
      if (wid + 8 <= j) {
#pragma unroll
        for (int ks = 0; ks < 2; ++ks) { mH[ks] = *(const bf16x8*)(kbh + (size_t)(wid + 8) * 1024 + ks * 512); mL[ks] = *(const bf16x8*)(kbl + (size_t)(wid + 8) * 1024 + ks * 512); }
      }
      for (int kt = wid; kt <= j; kt += 8) {
        bf16x8 kH[2], kL[2];
#pragma unroll
        for (int ks = 0; ks < 2; ++ks) { kH[ks] = nH[ks]; kL[ks] = nL[ks]; nH[ks] = mH[ks]; nL[ks] = mL[ks]; }
        if (kt + 16 <= j) {
#pragma unroll
          for (int ks = 0; ks < 2; ++ks) { mH[ks] = *(const bf16x8*)(kbh + (size_t)(kt + 16) * 1024 + ks * 512); mL[ks] = *(const bf16x8*)(kbl + (size_t)(kt + 16) * 1024 + ks * 512); }
        }
        f32x4 sc = (f32x4){0.f, 0.f, 0.f, 0.f};
#pragma unroll
        for (int h = 0; h < 4; ++h) {
          f32x4 a = (f32x4){0.f, 0.f, 0.f, 0.f};
#pragma unroll
          for (int ks = 0; ks < 2; ++ks) { if (!(ABL_SCORE == 2 && rep_ < PROBE_REP_SCORE)) a = mfma16(kH[ks], qH[h][ks], a); if (!(ABL_SCORE >= 1 && rep_ < PROBE_REP_SCORE)) { a = mfma16(kL[ks], qH[h][ks], a); a = mfma16(kH[ks], qL[h][ks], a); } }
#pragma unroll
          for (int i = 0; i < 4; ++i) sc[i] = fmaf(w[h], fmaxf(a[i], 0.f), sc[i]);
        }
        u16x4 kk;
#pragma unroll
        for (int i = 0; i < 4; ++i) { const int s = kt * 16 + 4 * g + i; const unsigned k16 = f2key(sc[i]) >> 16; const bool ok = s <= tq; kk[i] = ok ? (unsigned short)k16 : (unsigned short)0;
          if (rep_ == PROBE_REP_SCORE && ok) __hip_atomic_fetch_add(h1 + (k16 >> 8), 1u, __ATOMIC_RELAXED, __HIP_MEMORY_SCOPE_WORKGROUP); }
        *(LAS u16x4*)(lds + A_BIG + fr * K16_STRIDE + (kt * 16 + 4 * g) * 2) = kk;
      }
    }
    TS_ACC(32);
    __syncthreads();
    TS_ACC(33);
    const int nkeys = 16 * (j + 1);
    LAS unsigned short* cand = (LAS unsigned short*)(lds + A_CAND + wid * 128);
    for (int rep_ = 0; rep_ <= PROBE_REP_SELECT; ++rep_)
    for (int qq = 0; qq < 2; ++qq) {
      const int qi = wid + 8 * qq;
      const LAS unsigned char* Kq = lds + A_BIG + qi * K16_STRIDE;
      LAS unsigned short* sel = (LAS unsigned short*)(lds + A_SEL + qi * 512);
      const int nit = (nkeys + 511) >> 9;
      const size_t qrow = r0 + qi;
      const u32x2 hq = *(const u32x2*)(p.qiH + qrow * 256 + lane * 4); const u32x2 lq = *(const u32x2*)(p.qiL + qrow * 256 + lane * 4);
      const f32x4 wq = *(const f32x4*)(p.wi + qrow * 4);
      LAS unsigned* hist = (LAS unsigned*)(lds + A_HIST) + qi * 257;
      unsigned c4[4];
#pragma unroll
      for (int i = 0; i < 4; ++i) c4[i] = hist[255 - 4 * lane - i];
      unsigned B1, above1; wave_find_bin(c4, (unsigned)TOPK, lane, B1, above1);
      wave_lds_sync();
      TS_ACC(48);
      u16x8 kr[8];
#pragma unroll
      for (int it = 0; it < 8; ++it) { const int base = (it * 64 + lane) * 8; kr[it] = (u16x8){0, 0, 0, 0, 0, 0, 0, 0}; if (it < nit && base < nkeys) kr[it] = *(const LAS u16x8*)(Kq + base * 2); }
#pragma unroll
      for (int i = 0; i < 4; ++i) hist[lane * 4 + i] = 0u;
      wave_lds_sync();
#pragma unroll
      for (int it = 0; it < 8; ++it) if (it < nit) {
#pragma unroll
        for (int e = 0; e < 8; ++e) if ((unsigned)(kr[it][e] >> 8) == B1) __hip_atomic_fetch_add(hist + (kr[it][e] & 255), 1u, __ATOMIC_RELAXED, __HIP_MEMORY_SCOPE_WORKGROUP);
      }
      wave_lds_sync();
#pragma unroll
      for (int i = 0; i < 4; ++i) c4[i] = hist[255 - 4 * lane - i];
      unsigned B2, above2; wave_find_bin(c4, (unsigned)TOPK - above1, lane, B2, above2);
      const unsigned T16 = (B1 << 8) | B2; const unsigned ngt = above1 + above2; const unsigned need = (unsigned)TOPK - ngt;
      TS_ACC(49);
      unsigned cg = 0, ce = 0;
#pragma unroll
      for (int it = 0; it < 8; ++it) if (it < nit) {
#pragma unroll
        for (int e = 0; e < 8; ++e) { cg += (unsigned)kr[it][e] > T16 ? 1u : 0u; ce += (unsigned)kr[it][e] == T16 ? 1u : 0u; }
      }
      const unsigned ig = wave_incl_scan(cg), ie = wave_incl_scan(ce);
      unsigned og = ig - cg, oe = ie - ce;
      const unsigned pos_eq = (unsigned)__builtin_amdgcn_readlane((int)ie, 63);
      TS_ACC(50);
      const bool slowpath = (T16 == 0x8000u || pos_eq > 64u);
#pragma unroll
      for (int it = 0; it < 8; ++it) if (it < nit) {
        const int base = (it * 64 + lane) * 8;
#pragma unroll
        for (int e = 0; e < 8; ++e) if ((unsigned)kr[it][e] == T16) { if (oe < 64u) cand[oe] = (unsigned short)(base + e); ++oe; }
      }
      wave_lds_sync();
      const int c = slowpath ? 0 : (int)pos_eq;
      const int myidx = lane < c ? (int)cand[lane] : 0;
      u32x4 hkA[8], lkA[8];
      if (!slowpath) {
        const size_t krow = (size_t)b * S + myidx;
#pragma unroll
        for (int dc = 0; dc < 8; ++dc) { hkA[dc] = *(const u32x4*)(p.kiH + kfrag(krow, dc * 8)); lkA[dc] = *(const u32x4*)(p.kiL + kfrag(krow, dc * 8)); }
      }
#pragma unroll
      for (int it = 0; it < 8; ++it) if (it < nit) {
        const int base = (it * 64 + lane) * 8;
#pragma unroll
        for (int e = 0; e < 8; ++e) if ((unsigned)kr[it][e] > T16) { sel[og] = (unsigned short)(base + e); ++og; }
      }
      wave_lds_sync();
      TS_ACC(51);
      if (slowpath) {
        unsigned taken = 0;
        for (int s0 = 0; s0 < nkeys && taken < need; s0 += 64) {
          const int s = s0 + lane; const bool eq = s < nkeys && (unsigned)(*(const LAS unsigned short*)(Kq + s * 2)) == T16;
          const unsigned long long me = __ballot(eq);
          const unsigned o = taken + __builtin_amdgcn_mbcnt_hi((unsigned)(me >> 32), __builtin_amdgcn_mbcnt_lo((unsigned)me, 0u));
          if (eq && o < need) sel[ngt + o] = (unsigned short)s;
          taken += (unsigned)__popcll(me);
        }
      } else {
        float qv[4];
        qv[0] = __uint_as_float(hq.x << 16) + __uint_as_float(lq.x << 16); qv[1] = __uint_as_float(hq.x & 0xffff0000u) + __uint_as_float(lq.x & 0xffff0000u);
        qv[2] = __uint_as_float(hq.y << 16) + __uint_as_float(lq.y << 16); qv[3] = __uint_as_float(hq.y & 0xffff0000u) + __uint_as_float(lq.y & 0xffff0000u);
        const f32x4 w = wq;
        float d4[4] = {0.f, 0.f, 0.f, 0.f};
#pragma unroll
        for (int dc = 0; dc < 8; ++dc) {
          const u32x4 hk = hkA[dc], lk = lkA[dc];
          float kv[8];
          kv[0] = __uint_as_float(hk.x << 16) + __uint_as_float(lk.x << 16); kv[1] = __uint_as_float(hk.x & 0xffff0000u) + __uint_as_float(lk.x & 0xffff0000u);
          kv[2] = __uint_as_float(hk.y << 16) + __uint_as_float(lk.y << 16); kv[3] = __uint_as_float(hk.y & 0xffff0000u) + __uint_as_float(lk.y & 0xffff0000u);
          kv[4] = __uint_as_float(hk.z << 16) + __uint_as_float(lk.z << 16); kv[5] = __uint_as_float(hk.z & 0xffff0000u) + __uint_as_float(lk.z & 0xffff0000u);
          kv[6] = __uint_as_float(hk.w << 16) + __uint_as_float(lk.w << 16); kv[7] = __uint_as_float(hk.w & 0xffff0000u) + __uint_as_float(lk.w & 0xffff0000u);
#pragma unroll
          for (int h = 0; h < 4; ++h)
#pragma unroll
            for (int dd = 0; dd < 8; ++dd) {
              const int srcl = h * 16 + dc * 2 + (dd >> 2);
              const float qs = __uint_as_float(__builtin_amdgcn_readlane(__float_as_uint(qv[dd & 3]), srcl));
              d4[h] = fmaf(qs, kv[dd], d4[h]);
            }
        }
        float sc = 0.f;
#pragma unroll
        for (int h = 0; h < 4; ++h) sc = fmaf(w[h], fmaxf(d4[h], 0.f), sc);
        int rank = 0;
        for (int jj = 0; jj < c; ++jj) {
          const float sj = __uint_as_float(__builtin_amdgcn_readlane(__float_as_uint(sc), jj)); const int ij = __builtin_amdgcn_readlane(myidx, jj);
          rank += (sj > sc || (sj == sc && ij < myidx)) ? 1 : 0;
        }
        if (lane < c && (unsigned)rank < need) sel[ngt + rank] = (unsigned short)myidx;
      }
      TS_ACC(52);
      if (rep_ == PROBE_REP_SELECT) {
#pragma unroll
        for (int i = 0; i < 4; ++i) hist[lane * 4 + i] = 0u;
      }
      if (lane == 0) nselp[qi] = TOPK;
      wave_lds_sync();
    }
  } else if (!is_meta) {
    for (int i = tid; i < 16 * 256; i += NTHREADS) { const int qi = i >> 8, s = i & 255; ((LAS unsigned short*)(lds + A_SEL))[i] = (unsigned short)(s <= t0 + qi ? s : 0); }
    if (tid < 16) nselp[tid] = t0 + tid + 1;
  } else {
    if (tid < 16) nselp[tid] = 0;
  }
  TS_ACC(34);
  __syncthreads();
  TS_ACC(35);
  {
    const bf16_t* qa = (is_meta ? p.qam : p.qa) + (r0 + fr) * 512 + wid * 64 + g * 8;
    bf16x8 bq[2];
#pragma unroll
    for (int ks = 0; ks < 2; ++ks) bq[ks] = *(const bf16x8*)(qa + ks * 32);
    const bf16_t* wk = wukT + ((size_t)wid * 128 + fr) * 64 + g * 8;
#pragma unroll
    for (int mt = 0; mt < 8; ++mt) {
      f32x4 a = (f32x4){0.f, 0.f, 0.f, 0.f};
#pragma unroll
      for (int ks = 0; ks < 2; ++ks) a = mfma16(*(const bf16x8*)(wk + (size_t)mt * 16 * 64 + ks * 32), bq[ks], a);
      u32x2 w2; w2.x = pack_bf16(a[0], a[1]); w2.y = pack_bf16(a[2], a[3]);
      *(LAS u32x2*)(lds + A_BIG + ((fr * 8 + wid) * 128 + mt * 16 + 4 * g) * 2) = w2;
    }
  }
  __syncthreads();
  bf16x8 qf_[2][4];
#pragma unroll
  for (int qq = 0; qq < 2; ++qq)
#pragma unroll
    for (int ks = 0; ks < 4; ++ks) {
      const bf16x8 v = *(const LAS bf16x8*)(lds + A_BIG + (((wid + 8 * qq) * 8 + (fr & 7)) * 128 + ks * 32 + g * 8) * 2);
      qf_[qq][ks] = fr < 8 ? v : (bf16x8){0, 0, 0, 0, 0, 0, 0, 0};
    }
  __syncthreads();
  TS_ACC(36);
  const LAS float* rb = (const LAS float*)(lds + A_RB);
  const LAS unsigned char* bkt = lds + A_BKT;
  f32x4 O[2][8];
  float linv[2];
  LAS unsigned char* gbuf = lds + A_BIG + wid * 16384;
  const unsigned gbase_u = (unsigned)__builtin_amdgcn_readfirstlane((int)(unsigned)(size_t)gbuf);
  const unsigned gq = (lane & 15) >> 2, gp = lane & 3;
  for (int rep_ = 0; rep_ <= PROBE_REP_ATT; ++rep_)
#pragma unroll
  for (int qq = 0; qq < 2; ++qq) {
    const int qi = wid + 8 * qq; const int nsel = nselp[qi];
    const int epos = is_meta ? qi : NM + t0 + qi;
    const LAS unsigned short* sel = (const LAS unsigned short*)(lds + A_SEL + qi * 512);
#pragma unroll
    for (int ct = 0; ct < 8; ++ct) O[qq][ct] = (f32x4){0.f, 0.f, 0.f, 0.f};
    float mrun = -INFINITY, lrun = 0.f;
    const int nch = (nsel + 31) >> 5;
#define ISSUE_GATHER(ch_) do { const unsigned dst_ = gbase_u + (unsigned)(((ch_) & 1) * 8192); \
      int idxs_[8]; \
      _Pragma("unroll") for (int i_ = 0; i_ < 8; ++i_) { const int si_ = (ch_) * 32 + 4 * i_ + g; const int v_ = (int)sel[si_ < 255 ? si_ : 255]; idxs_[i_] = si_ < nsel ? v_ : 0; } \
      asm volatile("s_waitcnt lgkmcnt(0)" ::: "memory"); \
      _Pragma("unroll") for (int i_ = 0; i_ < 8; ++i_) { \
        const int row_ = 4 * i_ + g; const unsigned f_ = (((unsigned)row_ & 3u) << 2) | (((unsigned)row_ >> 2) & 3u); \
        const bf16_t* src_ = cNb + (size_t)idxs_[i_] * 128 + (((unsigned)fr ^ f_) * 8); \
        glds16_asm(src_, dst_ + (unsigned)(i_ * 1024)); } } while (0)
    if (nch > 0) ISSUE_GATHER(0);
    if (nch > 1) ISSUE_GATHER(1);
    {
      f32x4 s0 = (f32x4){0.f, 0.f, 0.f, 0.f};
#pragma unroll
      for (int ks = 0; ks < 4; ++ks) s0 = mfma16(*(const LAS bf16x8*)(lds + A_CM + off_b(fr, 4 * ks + g)), qf_[qq][ks], s0);
      float lg[4]; float mx = -INFINITY;
#pragma unroll
      for (int i = 0; i < 4; ++i) { const int m = 4 * g + i; const int dist = epos - m; const bool valid = !is_meta || m <= qi;
        const int dcl = dist < 0 ? 0 : (dist > 127 ? 127 : dist); const int bkv = (int)bkt[dcl]; const int bk = dist >= 128 ? 31 : bkv;
        const float bias = rb[bk * 8 + (fr & 7)]; const float lv = s0[i] * 0.125f + bias;
        lg[i] = valid ? lv : -INFINITY; mx = fmaxf(mx, lg[i]); }
      mx = rows_max(mx);
      mrun = mx; float ps = 0.f; float pv[4];
#pragma unroll
      for (int i = 0; i < 4; ++i) { pv[i] = __expf(lg[i] - mrun); ps += pv[i]; }
      ps = rows_sum(ps); lrun = ps;
      bf16x8 pf; { const unsigned a0 = pack_bf16(pv[0], pv[1]), a1 = pack_bf16(pv[2], pv[3]); u32x4 t; t.x = a0; t.y = a1; t.z = 0u; t.w = 0u; pf = __builtin_bit_cast(bf16x8, t); }
      {
        s16x4 tm[8];
#pragma unroll
        for (int ct = 0; ct < 8; ++ct) tm[ct] = lds_tr(lds + A_CM + off_b(4 * g + gq, 2 * ct + (gp >> 1)) + 8 * (gp & 1));
        const s16x4 z4 = (s16x4){0, 0, 0, 0};
#pragma unroll
        for (int ct = 0; ct < 8; ++ct) O[qq][ct] = mfma16(cat4(tm[ct], z4), pf, O[qq][ct]);
      }
    }
    for (int ch = 0; ch < nch; ++ch) {
      if (ch + 1 < nch) asm volatile("s_waitcnt vmcnt(8)" ::: "memory"); else asm volatile("s_waitcnt vmcnt(0)" ::: "memory");
      const LAS unsigned char* buf = gbuf + (ch & 1) * 8192;
      f32x4 sA = (f32x4){0.f, 0.f, 0.f, 0.f}, sB = (f32x4){0.f, 0.f, 0.f, 0.f};
#pragma unroll
      for (int ks = 0; ks < 4; ++ks) {
        sA = mfma16(*(const LAS bf16x8*)(buf + off_b(fr, 4 * ks + g)), qf_[qq][ks], sA);
        sB = mfma16(*(const LAS bf16x8*)(buf + off_b(fr + 16, 4 * ks + g)), qf_[qq][ks], sB);
      }
      const u16x4 iA = *(const LAS u16x4*)(sel + ch * 32 + 4 * g); const u16x4 iB = *(const LAS u16x4*)(sel + ch * 32 + 16 + 4 * g);
      float lg[8]; float mx = -INFINITY;
#pragma unroll
      for (int i = 0; i < 8; ++i) {
        const int slot = ch * 32 + (i < 4 ? 4 * g + i : 16 + 4 * g + (i - 4)); const int kidx = i < 4 ? (int)iA[i] : (int)iB[i - 4];
        const int dist = t0 + qi - kidx; const int dcl = dist < 0 ? 0 : (dist > 127 ? 127 : dist); const int bkv = (int)bkt[dcl]; const int bk = dist >= 128 ? 31 : bkv;
        const float sv = i < 4 ? sA[i] : sB[i - 4];
        const float bias = rb[bk * 8 + (fr & 7)]; const float lv = sv * 0.125f + bias;
        lg[i] = slot < nsel ? lv : -INFINITY; mx = fmaxf(mx, lg[i]);
      }
      mx = rows_max(mx);
      const float mnew = fmaxf(mrun, mx); const float alpha = __expf(mrun - mnew); mrun = mnew;
      float pv[8]; float ps = 0.f;
#pragma unroll
      for (int i = 0; i < 8; ++i) { pv[i] = __expf(lg[i] - mnew); ps += pv[i]; }
      ps = rows_sum(ps); lrun = lrun * alpha + ps;
#pragma unroll
      for (int ct = 0; ct < 8; ++ct) O[qq][ct] *= alpha;
      bf16x8 pf; { u32x4 t; t.x = pack_bf16(pv[0], pv[1]); t.y = pack_bf16(pv[2], pv[3]); t.z = pack_bf16(pv[4], pv[5]); t.w = pack_bf16(pv[6], pv[7]); pf = __builtin_bit_cast(bf16x8, t); }
      {
        s16x4 ta[8], tb[8];
#pragma unroll
        for (int ct = 0; ct < 8; ++ct) { ta[ct] = lds_tr(buf + off_b(4 * g + gq, 2 * ct + (gp >> 1)) + 8 * (gp & 1)); tb[ct] = lds_tr(buf + off_b(16 + 4 * g + gq, 2 * ct + (gp >> 1)) + 8 * (gp & 1)); }
#pragma unroll
        for (int ct = 0; ct < 8; ++ct) O[qq][ct] = mfma16(cat4(ta[ct], tb[ct]), pf, O[qq][ct]);
      }
      if (ch + 2 < nch) ISSUE_GATHER(ch + 2);
    }
    linv[qq] = 1.0f / lrun;
  }
  TS_ACC(37);
  asm volatile("s_waitcnt vmcnt(0) lgkmcnt(0)" ::: "memory");
#pragma unroll
  for (int qq = 0; qq < 2; ++qq)
    if (fr < 8) {
#pragma unroll
      for (int ct = 0; ct < 8; ++ct) { const f32x4 o = O[qq][ct] * linv[qq]; u32x2 w2; w2.x = pack_bf16(o[0], o[1]); w2.y = pack_bf16(o[2], o[3]);
        *(LAS u32x2*)(gbuf + qq * 2048 + (fr * 128 + ct * 16 + 4 * g) * 2) = w2; }
    }
  __syncthreads();
  TS_ACC(38);
  {
    bf16x8 bo[4];
#pragma unroll
    for (int ks = 0; ks < 4; ++ks) bo[ks] = *(const LAS bf16x8*)(lds + A_BIG + (fr & 7) * 16384 + (fr >> 3) * 2048 + (wid * 128 + ks * 32 + g * 8) * 2);
    const bf16_t* wv = wuvT + ((size_t)wid * 64 + fr) * 128 + g * 8;
    bf16_t* grow = (is_meta ? p.gatesm : p.gates) + (r0 + fr) * 1024 + wid * 64 + 4 * g;
#pragma unroll
    for (int nt = 0; nt < 4; ++nt) {
      f32x4 a = (f32x4){0.f, 0.f, 0.f, 0.f};
#pragma unroll
      for (int ks = 0; ks < 4; ++ks) a = mfma16(*(const bf16x8*)(wv + (size_t)nt * 16 * 128 + ks * 32), bo[ks], a);
      const u32x2 gt = *(const u32x2*)(grow + nt * 16);
      const float g0 = __uint_as_float(gt.x << 16), g1 = __uint_as_float(gt.x & 0xffff0000u), g2 = __uint_as_float(gt.y << 16), g3 = __uint_as_float(gt.y & 0xffff0000u);
      u32x2 w2; w2.x = pack_bf16(a[0] * g0, a[1] * g1); w2.y = pack_bf16(a[2] * g2, a[3] * g3);
      *(u32x2*)((dry ? p.dummy + (r0 + fr) * 1024 + wid * 64 + 4 * g : grow) + nt * 16) = w2;
    }
  }
  __syncthreads();
  TS_ACC(39);
}

__device__ __forceinline__ void phase_attn(const Params& p, int layer, LAS unsigned char* lds, int ablk, int nablk, bool do_meta, const bool dry = false) {
  int tid_ = threadIdx.x; asm volatile("" : "+v"(tid_));
  const int tid = tid_;
  if (tid < 256) { const int row = tid >> 4, ch = tid & 15; *(LAS u32x4*)(lds + A_CM + off_b(row, ch)) = *(const u32x4*)(p.cNm + row * 128 + ch * 8); }
  if (tid < 256) ((LAS float*)(lds + A_RB))[tid] = p.rel_bias[tid];
  if (tid < 128) (lds + A_BKT)[tid] = c_bucket[tid];
  for (int i = tid; i < 16 * 257; i += NTHREADS) ((LAS unsigned*)(lds + A_HIST))[i] = 0u;
  __syncthreads();
  const bf16_t* wukT = p.wukT + (size_t)layer * 8 * 128 * 64; const bf16_t* wuvT = p.wuvT + (size_t)layer * 8 * 64 * 128;
  if ((nablk & 7) == 0 && (gridDim.x & 7) == 0) {
    const int xb = blockIdx.x & 7, nper = nablk >> 3, rank = ablk >> 3;
    for (int k = 0;; ++k) {
      const int idx = k * nper + ((k & 1) ? nper - 1 - rank : rank);
      if (idx >= 256) break;
      attn_tile(p, layer, lds, false, xb, 255 - idx, wukT, wuvT, dry);
    }
  } else {
    for (int item = ablk; item < NB * 256; item += nablk) {
      const int j = 255 - item / NB, b = item % NB;
      attn_tile(p, layer, lds, false, b, j, wukT, wuvT, dry);
    }
  }
  if (do_meta && !dry && ablk == nablk - 1) attn_tile(p, layer, lds, true, 0, 0, wukT, wuvT);
}

constexpr int H_QT = 0, H_KH = 8192, H_KT = 16384, H_VV = 24576, H_DEC = 32768, H_PART = 32768 + 512;

__device__ __forceinline__ void phase_hgrn(const Params& p, const int layer, LAS unsigned char* lds, const int hblk, const bool dry = false) {
  int tid_ = threadIdx.x; asm volatile("" : "+v"(tid_));
  const int tid = tid_, wid = __builtin_amdgcn_readfirstlane(tid >> 6), lane = tid & 63, fr = lane & 15, g = lane >> 4;
  const int b = hblk >> 2, h = hblk & 3;
  const unsigned gq = (lane & 15) >> 2, gp = lane & 3;
  f32x4 Sacc[8];
#pragma unroll
  for (int kt = 0; kt < 8; ++kt) Sacc[kt] = (f32x4){0.f, 0.f, 0.f, 0.f};
  const float gn = p.hng[layer * 128 + wid * 16 + fr];
  const int sk = wid * 16 + (lane & 15), stg = lane >> 4;
  const int vrow = tid >> 4, vch = tid & 15;
  const int otok[2] = {4 * g, 16 + 4 * g};
  float n_gv[8]; unsigned short n_q[8]; u32x4 n_v; unsigned short n_gate[8];
  {
#pragma unroll
    for (int i = 0; i < 8; ++i) {
      const int t = 8 * stg + i;
      n_gv[i] = t < NM ? p.glm[(size_t)t * 512 + h * 128 + sk] : 0.f;
      n_q[i] = t < NM ? p.qfm[(size_t)t * 512 + h * 128 + sk] : (unsigned short)0;
    }
    n_v = vrow < NM ? *(const u32x4*)(p.vvm + (size_t)vrow * 512 + h * 128 + vch * 8) : (u32x4){0u, 0u, 0u, 0u};
#pragma unroll
    for (int mt = 0; mt < 2; ++mt)
#pragma unroll
      for (int i = 0; i < 4; ++i) { const int t = otok[mt] + i; n_gate[mt * 4 + i] = t < NM ? p.gatesm[(size_t)t * 1024 + 512 + h * 128 + wid * 16 + fr] : (unsigned short)0; }
  }
  for (int step = 0; step <= S / 32; ++step) {
    const bool im = step == 0;
    const size_t rbase = im ? 0 : (size_t)b * S + (size_t)(step - 1) * 32;
    bf16_t* gt = (im ? p.gatesm : p.gates) + rbase * 1024 + 512 + h * 128;
    TS_ACC_BEGIN();
    float gv[8], qv[8];
#pragma unroll
    for (int i = 0; i < 8; ++i) { gv[i] = n_gv[i]; qv[i] = bf2f(n_q[i]); }
    const u32x4 vraw = n_v;
    float gate[8];
#pragma unroll
    for (int i = 0; i < 8; ++i) gate[i] = bf2f(n_gate[i]);
    if (step < S / 32) {
      const size_t rn = (size_t)b * S + (size_t)step * 32;
#pragma unroll
      for (int i = 0; i < 8; ++i) { n_gv[i] = p.gl[(rn + 8 * stg + i) * 512 + h * 128 + sk]; n_q[i] = p.qf[(rn + 8 * stg + i) * 512 + h * 128 + sk]; }
      n_v = *(const u32x4*)(p.vv + (rn + vrow) * 512 + h * 128 + vch * 8);
#pragma unroll
      for (int mt = 0; mt < 2; ++mt)
#pragma unroll
        for (int i = 0; i < 4; ++i) n_gate[mt * 4 + i] = p.gates[(rn + otok[mt] + i) * 1024 + 512 + h * 128 + wid * 16 + fr];
    }
    {
      float bc[8]; bc[0] = gv[0];
#pragma unroll
      for (int i = 1; i < 8; ++i) bc[i] = bc[i - 1] + gv[i];
      float x = bc[7];
      { const float u = __shfl_up(x, 16); if (lane >= 16) x += u; }
      { const float u = __shfl_up(x, 32); if (lane >= 32) x += u; }
      const float ex = x - bc[7];
      const float bl = __shfl(x, 48 + (lane & 15));
#pragma unroll
      for (int i = 0; i < 8; ++i) {
        const float bci = bc[i] + ex;
        const float kc = 1.0f - __expf(gv[i]);
        const float qt = qv[i] * __expf(bci), khv = kc * __expf(fminf(-bci, 80.f)), ktv = kc * __expf(bl - bci);
        const unsigned o1 = off_b(8 * stg + i, sk >> 3) + (sk & 7) * 2;
        *(LAS unsigned short*)(lds + H_QT + o1) = f2bf_fast(qt); *(LAS unsigned short*)(lds + H_KH + o1) = f2bf_fast(khv); *(LAS unsigned short*)(lds + H_KT + o1) = f2bf_fast(ktv);
      }
      if (stg == 3) *(LAS float*)(lds + H_DEC + sk * 4) = __expf(bl);
      *(LAS u32x4*)(lds + H_VV + off_b(vrow, vch)) = vraw;
    }
    TS_ACC(40);
    __syncthreads();
    TS_ACC(41);
    f32x4 o[2] = {(f32x4){0.f, 0.f, 0.f, 0.f}, (f32x4){0.f, 0.f, 0.f, 0.f}};
    {
      f32x4 s00 = (f32x4){0.f, 0.f, 0.f, 0.f}, s01 = s00, s11 = s00;
      {
        bf16x8 aK0[4], aK1[4], aQ0[4], aQ1[4];
#pragma unroll
        for (int ks = 0; ks < 4; ++ks) {
          aK0[ks] = *(const LAS bf16x8*)(lds + H_KH + off_b(fr, 4 * ks + g)); aK1[ks] = *(const LAS bf16x8*)(lds + H_KH + off_b(16 + fr, 4 * ks + g));
          aQ0[ks] = *(const LAS bf16x8*)(lds + H_QT + off_b(fr, 4 * ks + g)); aQ1[ks] = *(const LAS bf16x8*)(lds + H_QT + off_b(16 + fr, 4 * ks + g));
        }
#pragma unroll
        for (int ks = 0; ks < 4; ++ks) { s00 = mfma16(aK0[ks], aQ0[ks], s00); s01 = mfma16(aK0[ks], aQ1[ks], s01); s11 = mfma16(aK1[ks], aQ1[ks], s11); }
      }
#pragma unroll
      for (int ks = 0; ks < 4; ++ks) {
        u32x4 bv; bv.x = pack_bf16(Sacc[2 * ks][0], Sacc[2 * ks][1]); bv.y = pack_bf16(Sacc[2 * ks][2], Sacc[2 * ks][3]);
        bv.z = pack_bf16(Sacc[2 * ks + 1][0], Sacc[2 * ks + 1][1]); bv.w = pack_bf16(Sacc[2 * ks + 1][2], Sacc[2 * ks + 1][3]);
#pragma unroll
        for (int mt = 0; mt < 2; ++mt) {
          const u32x2 a0 = *(const LAS u32x2*)(lds + H_QT + off_b(16 * mt + fr, 4 * ks + (g >> 1)) + (g & 1) * 8);
          const u32x2 a1 = *(const LAS u32x2*)(lds + H_QT + off_b(16 * mt + fr, 4 * ks + 2 + (g >> 1)) + (g & 1) * 8);
          u32x4 av; av.x = a0.x; av.y = a0.y; av.z = a1.x; av.w = a1.y;
          o[mt] = mfma16(__builtin_bit_cast(bf16x8, av), __builtin_bit_cast(bf16x8, bv), o[mt]);
        }
      }
      const s16x4 vt0 = lds_tr(lds + H_VV + off_b(4 * g + gq, 2 * wid + (gp >> 1)) + 8 * (gp & 1));
      const s16x4 vt1 = lds_tr(lds + H_VV + off_b(16 + 4 * g + gq, 2 * wid + (gp >> 1)) + 8 * (gp & 1));
      const bf16x8 bfv = cat4(vt0, vt1);
      {
        float m0[4], m1[4];
#pragma unroll
        for (int i = 0; i < 4; ++i) { const bool keep = (4 * g + i) <= fr; m0[i] = keep ? s00[i] : 0.f; m1[i] = keep ? s11[i] : 0.f; }
        u32x4 a0; a0.x = pack_bf16(m0[0], m0[1]); a0.y = pack_bf16(m0[2], m0[3]); a0.z = 0u; a0.w = 0u;
        u32x4 a1; a1.x = pack_bf16(s01[0], s01[1]); a1.y = pack_bf16(s01[2], s01[3]); a1.z = pack_bf16(m1[0], m1[1]); a1.w = pack_bf16(m1[2], m1[3]);
        o[0] = mfma16(__builtin_bit_cast(bf16x8, a0), bfv, o[0]);
        o[1] = mfma16(__builtin_bit_cast(bf16x8, a1), bfv, o[1]);
      }
#pragma unroll
      for (int kt = 0; kt < 8; ++kt) {
        const s16x4 k0 = lds_tr(lds + H_KT + off_b(4 * g + gq, 2 * kt + (gp >> 1)) + 8 * (gp & 1));
        const s16x4 k1 = lds_tr(lds + H_KT + off_b(16 + 4 * g + gq, 2 * kt + (gp >> 1)) + 8 * (gp & 1));
        const f32x4 dv = *(const LAS f32x4*)(lds + H_DEC + (16 * kt + 4 * g) * 4);
        Sacc[kt] = mfma16(cat4(k0, k1), bfv, Sacc[kt] * dv);
      }
    }
    {
#pragma unroll
      for (int mt = 0; mt < 2; ++mt) {
        f32x4 sq = o[mt] * o[mt];
#pragma unroll
        for (int i = 0; i < 4; ++i) sq[i] = row_sum16(sq[i]);
        if (fr == 0) *(LAS f32x4*)(lds + H_PART + (wid * 32 + otok[mt]) * 4) = sq;
      }
    }
    TS_ACC(42);
    __syncthreads();
    TS_ACC(43);
    if (!im || (b == 0 && layer == 0)) {
      f32x4 pr[2][8];
#pragma unroll
      for (int mt = 0; mt < 2; ++mt)
#pragma unroll
        for (int w = 0; w < 8; ++w) pr[mt][w] = *(const LAS f32x4*)(lds + H_PART + (w * 32 + otok[mt]) * 4);
#pragma unroll
      for (int mt = 0; mt < 2; ++mt) {
        const f32x4 tot = ((pr[mt][0] + pr[mt][1]) + (pr[mt][2] + pr[mt][3])) + ((pr[mt][4] + pr[mt][5]) + (pr[mt][6] + pr[mt][7]));
#pragma unroll
        for (int i = 0; i < 4; ++i) {
          const int t = otok[mt] + i;
          if (!im || t < NM) {
            const float rstd = rsqrtf(tot[i] * (1.0f / 128.0f) + EPS);
            (dry ? p.dummy + rbase * 1024 + 512 + h * 128 : gt)[(size_t)t * 1024 + wid * 16 + fr] = f2bf_fast(o[mt][i] * rstd * gn * gate[mt * 4 + i]);
          }
        }
      }
    }
    TS_ACC(44);
  }
}

enum { PH_PREP = 0, PH_P1 = 1, PH_ATTN = 2, PH_P3 = 3, PH_LN = 4, PH_HGRN = 5 };
__global__ void __launch_bounds__(NTHREADS, 2) k_fast(Params p, int phase, int layer) {
  extern __shared__ __attribute__((aligned(16))) unsigned char smem[];
  LAS unsigned char* lds = (LAS unsigned char*)smem;
  if (phase == PH_PREP) phase_prep(p, lds);
  else if (phase == PH_P1) {
    SrcP1 S{(const char*)p.hHi, (const char*)p.hLo, (const char*)(p.WmT + (size_t)layer * 3072 * 1024), (const char*)(p.WsT + (size_t)layer * 512 * 3072)};
    EpiP1 E{p, layer};
    gemm_phase<SrcP1, EpiP1>(lds, S, R / BM, 14, E);
  } else if (phase == PH_P3) {
    SrcP3 S{(const char*)p.gates, (const char*)(p.WoT + (size_t)layer * 1024 * 1024)};
    EpiP3 E{p, layer == 0 ? p.x : p.hF};
    gemm_phase<SrcP3, EpiP3>(lds, S, R / BM, 4, E);
  } else if (phase == PH_ATTN) {
    phase_attn(p, layer, lds, blockIdx.x, gridDim.x, layer == 0);
  } else if (phase == PH_HGRN) {
    if (blockIdx.x < NB * 4) phase_hgrn(p, layer, lds, blockIdx.x);
  } else if (phase == PH_LN) {
    phase_ln(p, layer, layer == 0 ? p.hF : p.out, layer == 0);
  }
}

constexpr int M_A32T = 0;
constexpr int M_PART = 65536;
template <bool A_BF16>
__device__ __forceinline__ void meta_group_gemm(LAS unsigned char* lds, const void* A, const float* W, const int ldw, const int col0) {
  int tid_ = threadIdx.x; asm volatile("" : "+v"(tid_));
  const int tid = tid_, wid = __builtin_amdgcn_readfirstlane(tid >> 6), lane = tid & 63;
  LAS float* a32 = (LAS float*)(lds + M_A32T); LAS float* part = (LAS float*)(lds + M_PART);
  for (int i = tid; i < 16 * 1024; i += NTHREADS) { const int r = i >> 10, k = i & 1023; a32[k * 16 + r] = A_BF16 ? bf2f(((const bf16_t*)A)[i]) : ((const float*)A)[i]; }
  __syncthreads();
  float acc0[16], acc1[16];
#pragma unroll
  for (int r = 0; r < 16; ++r) { acc0[r] = 0.f; acc1[r] = 0.f; }
  const float* w0p = W + (size_t)(wid * 128) * ldw + col0 + lane;
#pragma unroll 4
  for (int kk = 0; kk < 128; ++kk) {
    const float w0 = w0p[(size_t)kk * ldw], w1 = w0p[(size_t)kk * ldw + 64];
    const LAS f32x4* ar = (const LAS f32x4*)(a32 + (wid * 128 + kk) * 16);
#pragma unroll
    for (int q = 0; q < 4; ++q) { const f32x4 a = ar[q];
#pragma unroll
      for (int j = 0; j < 4; ++j) { acc0[q * 4 + j] = fmaf(a[j], w0, acc0[q * 4 + j]); acc1[q * 4 + j] = fmaf(a[j], w1, acc1[q * 4 + j]); } }
  }
#pragma unroll
  for (int r = 0; r < 16; ++r) { part[(wid * 16 + r) * 128 + lane] = acc0[r]; part[(wid * 16 + r) * 128 + 64 + lane] = acc1[r]; }
  __syncthreads();
  for (int i = tid; i < 2048; i += NTHREADS) { float s = 0.f;
#pragma unroll
    for (int w = 0; w < 8; ++w) s += part[w * 2048 + i]; part[i] = s; }
  __syncthreads();
}

__device__ __forceinline__ void meta_inproj_group(const Params& p, const int layer, LAS unsigned char* lds, const int grp) {
  int tid_ = threadIdx.x; asm volatile("" : "+v"(tid_)); const int tid = tid_;
  const float* A = layer == 0 ? p.meta : p.hFm;
  int kind, sub;
  if (grp < 4) { kind = 0; sub = grp; } else if (grp == 4) { kind = 6; sub = 0; } else { kind = 1 + (grp - 5) / 4; sub = (grp - 5) % 4; }
  const int colbase = (kind == 0 ? O_QA : kind == 6 ? O_CKV : kind == 1 ? O_GA : kind == 2 ? O_QH : kind == 3 ? O_FH : kind == 4 ? O_IH : O_GH) + sub * 128;
  meta_group_gemm<false>(lds, A, p.w_in + (size_t)layer * D * NIN, NIN, colbase);
  LAS float* out = (LAS float*)(lds + M_PART);
  LAS float* rs = (LAS float*)(lds + M_PART + 2048 * 4);
  if (kind == 6) {
    if (tid < 16) { float s = 0.f; for (int c = 0; c < 128; ++c) { const float v = out[tid * 128 + c]; s = fmaf(v, v, s); } rs[tid] = rsqrtf(s * (1.0f / 128.0f) + EPS); }
    __syncthreads();
  }
  for (int i = tid; i < 2048; i += NTHREADS) {
    const int r = i >> 7, c = i & 127, cc = sub * 128 + c; const float v = out[i];
    if (kind == 0) p.qam[r * 512 + cc] = f2bf(v);
    else if (kind == 6) p.cNm[r * 128 + c] = f2bf(v * rs[r] * p.kvg[layer * 128 + c]);
    else if (kind == 1) p.gatesm[r * 1024 + cc] = f2bf(fast_silu(v));
    else if (kind == 2) p.qfm[r * 512 + cc] = f2bf(fast_silu(v) * 0.08838834764831845f);
    else if (kind == 3) { const float lb = p.lbv[layer * 512 + cc]; p.glm[r * 512 + cc] = __logf(lb + (1.0f - lb) * fast_sigmoid(v)); }
    else if (kind == 4) p.vvm[r * 512 + cc] = f2bf(v);
    else p.gatesm[r * 1024 + 512 + cc] = f2bf(fast_silu(v));
  }
  __syncthreads();
}
__device__ __forceinline__ void meta_outproj_group(const Params& p, LAS unsigned char* lds, const int grp) {
  int tid_ = threadIdx.x; asm volatile("" : "+v"(tid_)); const int tid = tid_;
  meta_group_gemm<true>(lds, p.gatesm, p.w_out, D, grp * 128);
  const LAS float* out = (const LAS float*)(lds + M_PART);
  for (int i = tid; i < 2048; i += NTHREADS) { const int r = i >> 7, c = grp * 128 + (i & 127); p.vm[r * D + c] = DN_ALPHA * p.meta[r * D + c] + out[i]; }
  __syncthreads();
}
__device__ __forceinline__ void meta_ln(const Params& p) {
  int tid_ = threadIdx.x; asm volatile("" : "+v"(tid_)); const int tid = tid_, wid = tid >> 6, lane = tid & 63;
  for (int row = wid; row < NM; row += 8) {
    f32x4 v[4]; float s = 0.f;
#pragma unroll
    for (int i = 0; i < 4; ++i) { v[i] = *(const f32x4*)(p.vm + row * D + (i * 64 + lane) * 4); s += (v[i][0] + v[i][1]) + (v[i][2] + v[i][3]); }
#pragma unroll
    for (int o = 32; o > 0; o >>= 1) s += __shfl_xor(s, o);
    const float mean = s * (1.0f / D); float q = 0.f;
#pragma unroll
    for (int i = 0; i < 4; ++i) { const f32x4 d = v[i] - mean; q += (d[0] * d[0] + d[1] * d[1]) + (d[2] * d[2] + d[3] * d[3]); }
#pragma unroll
    for (int o = 32; o > 0; o >>= 1) q += __shfl_xor(q, o);
    const float rstd = rsqrtf(q * (1.0f / D) + EPS);
#pragma unroll
    for (int i = 0; i < 4; ++i) { const int c = (i * 64 + lane) * 4; *(f32x4*)(p.hFm + row * D + c) = (v[i] - mean) * rstd * *(const f32x4*)(p.ln_g + c) + *(const f32x4*)(p.ln_b + c); }
  }
}


#define XB_TMO      128
#define XB_XCNT(j)  (256  + 64 * (j))
#define XB_XSUB(j)  (1280 + 64 * (j))
#define XB_XGEN(j)  (2304 + 64 * (j))
#define XB_TOP      3328
#define XB_TOPGEN   3392
#define XCD_BAR_WORDS 3456
#define XB_SPIN_CAP (1u << 20)
__device__ __forceinline__ unsigned xb_ld(unsigned* p)              { return __hip_atomic_load(p, __ATOMIC_RELAXED, __HIP_MEMORY_SCOPE_AGENT); }
__device__ __forceinline__ unsigned xb_add(unsigned* p, unsigned v) { return __hip_atomic_fetch_add(p, v, __ATOMIC_RELAXED, __HIP_MEMORY_SCOPE_AGENT); }
__device__ __forceinline__ unsigned xb_xcc_id() { return (unsigned)__builtin_amdgcn_s_getreg((3 << 11) | 20) & 0xFu; }
#define XB_SPIN(cond, bar) do { unsigned _sp = 0; while (cond) { __builtin_amdgcn_s_sleep(1); \
    if ((++_sp & 255u) == 0u) { if (xb_ld(&(bar)[XB_TMO])) break; if (_sp > XB_SPIN_CAP) { atomicAdd(&(bar)[XB_TMO], 1u); break; } } } } while (0)
struct XcdBarrier { unsigned* bar; unsigned x; volatile LAS unsigned* st; };
__device__ __forceinline__ XcdBarrier xcd_barrier_post(unsigned* bar, volatile LAS unsigned* st) {
  XcdBarrier b; b.bar = bar; b.x = xb_xcc_id(); b.st = st;
  if (threadIdx.x == 0) (void)xb_add(&bar[XB_XCNT(b.x)], 1u);
  return b;
}
__device__ __forceinline__ void xcd_barrier_complete(unsigned* bar, unsigned x, unsigned& nloc, unsigned& nx) {
  const unsigned G = gridDim.x * gridDim.y * gridDim.z;
  unsigned sum, cnt, mine, sp = 0u;
  for (;;) {
    sum = 0u; cnt = 0u; mine = 0u;
#pragma unroll
    for (unsigned j = 0; j < 16; ++j) { const unsigned c = xb_ld(&bar[XB_XCNT(j)]); sum += c; cnt += (c > 0u) ? 1u : 0u; mine = (j == x) ? c : mine; }
    if (sum == G) break;
    __builtin_amdgcn_s_sleep(1);
    if ((++sp & 255u) == 0u) { if (xb_ld(&bar[XB_TMO])) break; if (sp > XB_SPIN_CAP) { atomicAdd(&bar[XB_TMO], 1u); break; } }
  }
  nloc = mine > 0u ? mine : 1u; nx = cnt > 0u ? cnt : 1u;
}
__device__ __forceinline__ void xcd_barrier(const XcdBarrier& b) {
  asm volatile("s_waitcnt vmcnt(0)" ::: "memory");
  __syncthreads();
  if (threadIdx.x == 0) {
    unsigned* bar = b.bar;
    __builtin_amdgcn_s_waitcnt(0);
    unsigned nloc = b.st[0], nx = b.st[1];
    if (nloc == 0u) { xcd_barrier_complete(bar, b.x, nloc, nx); b.st[0] = nloc; b.st[1] = nx; }
    const unsigned old = xb_add(&bar[XB_XSUB(b.x)], 1u);
    const unsigned gen = old / nloc;
    if (old + 1u == (gen + 1u) * nloc) {
      __builtin_amdgcn_fence(__ATOMIC_RELEASE, "agent");
      asm volatile("s_waitcnt vmcnt(0)" ::: "memory");
      const unsigned og = xb_add(&bar[XB_TOP], 1u);
      const unsigned tg = og / nx;
      if (og + 1u == (tg + 1u) * nx) xb_add(&bar[XB_TOPGEN], 1u);
      else XB_SPIN(xb_ld(&bar[XB_TOPGEN]) == tg, bar);
      __builtin_amdgcn_fence(__ATOMIC_ACQUIRE, "agent");
      xb_add(&bar[XB_XGEN(b.x)], 1u);
      asm volatile("s_waitcnt vmcnt(0)" ::: "memory");
    } else {
      XB_SPIN(xb_ld(&bar[XB_XGEN(b.x)]) == gen, bar);
      __builtin_amdgcn_fence(__ATOMIC_ACQUIRE, "agent");
      asm volatile("s_waitcnt vmcnt(0)" ::: "memory");
    }
  }
  __syncthreads();
}

constexpr int N_HGRN_BLOCKS = NB * 4;
#ifndef PROBE_REP_PREP
#define PROBE_REP_PREP 0
#endif
#ifndef PROBE_REP_P1
#define PROBE_REP_P1 0
#endif
#ifndef PROBE_REP_P3
#define PROBE_REP_P3 0
#endif
#ifndef PROBE_DRY
#define PROBE_DRY 0
#endif
#ifndef PROBE_SYNC
#define PROBE_SYNC 0
#endif
__global__ void __launch_bounds__(NTHREADS, 2) k_mega(Params p) {
  extern __shared__ __attribute__((aligned(16))) unsigned char smem[];
  LAS unsigned char* lds = (LAS unsigned char*)smem;
  cooperative_groups::grid_group grid = cooperative_groups::this_grid();
  const int bid = blockIdx.x, G = gridDim.x;
  if (threadIdx.x < 4) ((LAS unsigned*)(lds + LDS_BYTES - 16))[threadIdx.x] = 0u;
  __syncthreads();
  const XcdBarrier xbar = xcd_barrier_post(p.bar, (volatile LAS unsigned*)(lds + LDS_BYTES - 16));
#define GRID_BAR() xcd_barrier(xbar)
  if (TPROBE) { for (int i = threadIdx.x; i < 64; i += NTHREADS) p.ts[(size_t)blockIdx.x * 64 + i] = 0ull; __syncthreads(); }
  TS_MARK(0);
  for (int i = 0; i < PROBE_SYNC; ++i) grid.sync();
  for (int i = 0; i < PROBE_REP_PREP; ++i) { phase_prep(p, lds); __syncthreads(); }
  phase_prep(p, lds);
  __syncthreads();
  if (bid >= G - 25) {
    { int t_ = threadIdx.x; asm volatile("" : "+v"(t_)); for (int i = t_; i < 512; i += NTHREADS) p.lbv[i] = 0.f; }
    __syncthreads();
    meta_inproj_group(p, 0, lds, bid - (G - 25));
  }
  TS_MARK(1); grid.sync(); TS_MARK(2);
#pragma unroll
  for (int layer = 0; layer < DEPTH; ++layer) {
    if (layer == 1 && bid < 25) meta_inproj_group(p, 1, lds, bid);
    {
      SrcP1 Sp{(const char*)p.hHi, (const char*)p.hLo, (const char*)(p.WmT + (size_t)layer * 3072 * 1024), (const char*)(p.WsT + (size_t)layer * 512 * 3072)};
      EpiP1 E{p, layer};
      for (int i = 0; i < PROBE_REP_P1; ++i) gemm_phase<SrcP1, EpiP1>(lds, Sp, R / BM, 14, E);
      gemm_phase<SrcP1, EpiP1>(lds, Sp, R / BM, 14, E);
    }
    TS_MARK(3 + 8 * layer); GRID_BAR(); TS_MARK(4 + 8 * layer);
    if (PROBE_DRY) {
      if (bid < N_HGRN_BLOCKS) { if (PROBE_DRY != 2) phase_hgrn(p, layer, lds, bid, true); }
      else { if (PROBE_DRY != 3) phase_attn(p, layer, lds, bid - N_HGRN_BLOCKS, G - N_HGRN_BLOCKS, layer == 0, true); }
      grid.sync();
    }
    if (bid < N_HGRN_BLOCKS) phase_hgrn(p, layer, lds, bid);
    else phase_attn(p, layer, lds, bid - N_HGRN_BLOCKS, G - N_HGRN_BLOCKS, layer == 0);
    TS_MARK(5 + 8 * layer); GRID_BAR(); TS_MARK(6 + 8 * layer);
    if (layer == 0 && bid < 8) meta_outproj_group(p, lds, bid);
    {
      SrcP3 Sp{(const char*)p.gates, (const char*)(p.WoT + (size_t)layer * 1024 * 1024)};
      EpiP3 E{p, layer == 0 ? p.x : p.hF};
      if (layer == 0) for (int i = 0; i < PROBE_REP_P3; ++i) gemm_phase<SrcP3, EpiP3>(lds, Sp, R / BM, 4, E);
      gemm_phase<SrcP3, EpiP3>(lds, Sp, R / BM, 4, E);
    }
    TS_MARK(7 + 8 * layer); GRID_BAR(); TS_MARK(8 + 8 * layer);
    if (layer == 0) { phase_ln(p, 0, p.hF, true); if (bid == G - 1) meta_ln(p); TS_MARK(9); GRID_BAR(); TS_MARK(10); }
    else { phase_ln(p, 1, p.out, false); TS_MARK(17); }
  }
  if (TPROBE) {
    grid.sync();
    if (bid == 0 && threadIdx.x < 64) {
      unsigned long long mx = 0;
      for (int b2 = TP_LO + (int)threadIdx.x; b2 < TP_HI; b2 += 64) { const unsigned long long e_ = __hip_atomic_load(p.ts + (size_t)b2 * 64 + TP_E, __ATOMIC_RELAXED, __HIP_MEMORY_SCOPE_AGENT), s_ = __hip_atomic_load(p.ts + (size_t)b2 * 64 + TP_S, __ATOMIC_RELAXED, __HIP_MEMORY_SCOPE_AGENT); const unsigned long long d = TPROBE == 2 ? e_ : e_ - s_; mx = d > mx ? d : mx; }
      for (int o = 32; o > 0; o >>= 1) { const unsigned long long v = __shfl_xor(mx, o); mx = v > mx ? v : mx; }
      if (threadIdx.x == 0) p.out[0] += (float)mx * 0.0001f;
    }
  }
}

}

extern "C" void kernel_launch(void* const* d_in, const int* in_sizes, int n_in, void* d_out, int out_size, void* d_ws, size_t ws_size,
                              hipStream_t stream) {
  Params p{};
  p.x = (const float*)d_in[0]; p.meta = (const float*)d_in[1]; p.rel_bias = (const float*)d_in[2]; p.lbraw = (const float*)d_in[3];
  p.w_in = (const float*)d_in[4]; p.kvg = (const float*)d_in[5]; p.w_uk = (const float*)d_in[6]; p.w_uv = (const float*)d_in[7];
  p.hng = (const float*)d_in[8]; p.w_out = (const float*)d_in[9]; p.ln_g = (const float*)d_in[10]; p.ln_b = (const float*)d_in[11];
  p.out = (float*)d_out;
  char* w = (char*)d_ws; size_t off = 0;
  auto take = [&](size_t bytes) { char* q = w + off; off += (bytes + 255) & ~(size_t)255; return q; };
  p.hF = (float*)take((size_t)R * D * 4); p.hFm = (float*)take((size_t)NM * D * 4);
  p.hHi = (bf16_t*)take((size_t)R * D * 2); p.hHim = (bf16_t*)take((size_t)NM * D * 2);
  p.hLo = (bf16_t*)take((size_t)R * D * 2); p.hLom = (bf16_t*)take((size_t)NM * D * 2);
  p.qa = (bf16_t*)take((size_t)R * 512 * 2); p.qam = (bf16_t*)take((size_t)NM * 512 * 2);
  p.cN = (bf16_t*)take((size_t)R * 128 * 2); p.cNm = (bf16_t*)take((size_t)NM * 128 * 2);
  p.gates = (bf16_t*)take((size_t)R * 1024 * 2); p.gatesm = (bf16_t*)take((size_t)NM * 1024 * 2);
  p.qfm = (bf16_t*)take((size_t)NM * 512 * 2); p.glm = (float*)take((size_t)NM * 512 * 4); p.vvm = (bf16_t*)take((size_t)NM * 512 * 2);
  p.qiH = (bf16_t*)take((size_t)R * 256 * 2); p.qiL = (bf16_t*)take((size_t)R * 256 * 2);
  p.kiH = (bf16_t*)take((size_t)R * 64 * 2); p.kiL = (bf16_t*)take((size_t)R * 64 * 2);
  p.wi = (float*)take((size_t)R * 4 * 4);
  p.sel = (int*)take(256); p.nsel = (int*)take(256);
  p.proj = (float*)take((size_t)NM * NIN * 4);
  p.ych = (float*)take((size_t)NM * D * 4);
  p.WmT = (bf16_t*)take((size_t)DEPTH * 3072 * 1024 * 2); p.WsT = (bf16_t*)take((size_t)DEPTH * 512 * 3072 * 2); p.WoT = (bf16_t*)take((size_t)DEPTH * 1024 * 1024 * 2);
  p.lbv = (float*)take((size_t)DEPTH * 512 * 4);
  p.stats = (float*)take((size_t)R * 16 * 2 * 4); p.statsm = (float*)take(256);
  p.vm = (float*)take((size_t)NM * D * 4);
  p.dummy = (bf16_t*)take((size_t)(R + NM) * 1024 * 2);
  p.bar = (unsigned*)take(XCD_BAR_WORDS * 4);
  p.ts = (unsigned long long*)take(256 * 64 * 8);
  p.wukT = (bf16_t*)take((size_t)DEPTH * 8 * 128 * 64 * 2); p.wuvT = (bf16_t*)take((size_t)DEPTH * 8 * 64 * 128 * 2);
  if (off > ws_size) return;
  p.gl = (float*)d_out; p.qf = (bf16_t*)((char*)d_out + (size_t)R * 512 * 4); p.vv = (bf16_t*)((char*)d_out + (size_t)R * 512 * 4 + (size_t)R * 512 * 2);

  static int grid_blocks = 0;
  if (!grid_blocks) {
    (void)hipFuncSetAttribute((const void*)k_mega, hipFuncAttributeMaxDynamicSharedMemorySize, LDS_BYTES);
    int dev = 0, cus = 0, per_cu = 0;
    (void)hipGetDevice(&dev);
    (void)hipDeviceGetAttribute(&cus, hipDeviceAttributeMultiprocessorCount, dev);
    (void)hipOccupancyMaxActiveBlocksPerMultiprocessor(&per_cu, (const void*)k_mega, NTHREADS, LDS_BYTES);
    grid_blocks = per_cu >= 1 ? cus : 0;
    if (grid_blocks > 256) grid_blocks = 256;
  }
  if (grid_blocks < 64) return;
  (void)hipMemsetAsync(p.bar, 0, XCD_BAR_WORDS * 4, stream);
  void* args[] = {(void*)&p};
  (void)hipLaunchCooperativeKernel((const void*)k_mega, dim3(grid_blocks), dim3(NTHREADS), args, LDS_BYTES, stream);
}
```

```cpp
#include <hip/hip_runtime.h>
#include <hip/hip_cooperative_groups.h>
#include <stdint.h>

namespace {
typedef unsigned short bf16_t;
constexpr int D = 1024, NB = 8, S = 4096, NM = 16, NIN = 3524, DEPTH = 2;
constexpr int R = NB * S;
constexpr int O_QA = 0, O_CKV = 512, O_QI = 640, O_KI = 896, O_WI = 960, O_GA = 964, O_QH = 1476, O_FH = 1988, O_IH = 2500, O_GH = 3012;
constexpr int TOPK = 256;
constexpr float EPS = 1e-6f;
constexpr float DN_ALPHA = 1.4142135623730951f;

__constant__ unsigned char c_bucket[128] = {
  0, 1, 2, 3, 4, 5, 6, 7, 8, 9, 10, 11, 12, 13, 14, 15, 16, 16, 16, 17, 17, 18, 18, 18, 19, 19, 19, 20, 20, 20, 20, 21,
  21, 21, 21, 22, 22, 22, 22, 22, 23, 23, 23, 23, 23, 23, 24, 24, 24, 24, 24, 24, 25, 25, 25, 25, 25, 25, 25, 26, 26, 26, 26, 26,
  26, 26, 26, 27, 27, 27, 27, 27, 27, 27, 27, 27, 27, 28, 28, 28, 28, 28, 28, 28, 28, 28, 28, 29, 29, 29, 29, 29, 29, 29, 29, 29,
  29, 29, 29, 30, 30, 30, 30, 30, 30, 30, 30, 30, 30, 30, 30, 30, 30, 31, 31, 31, 31, 31, 31, 31, 31, 31, 31, 31, 31, 31, 31, 31};

__device__ __forceinline__ int t5_bucket(int dist) { int n = dist < 0 ? 0 : dist; return n >= 128 ? 31 : (int)c_bucket[n]; }
__device__ __forceinline__ float sigmoidf_(float x) { return 1.0f / (1.0f + expf(-x)); }
__device__ __forceinline__ float siluf_(float x) { return x / (1.0f + expf(-x)); }
__device__ __forceinline__ bf16_t f2bf(float f) { unsigned u = __float_as_uint(f); u += 0x7fffu + ((u >> 16) & 1u); return (bf16_t)(u >> 16); }
__device__ __forceinline__ float bf2f(bf16_t h) { return __uint_as_float(((unsigned)h) << 16); }

struct Params {
  const float *x, *meta, *rel_bias, *lbraw, *w_in, *kvg, *w_uk, *w_uv, *hng, *w_out, *ln_g, *ln_b;
  float* out;
  float *hF, *hFm;
  bf16_t *hHi, *hHim, *hLo, *hLom;
  bf16_t *qa, *qam;
  bf16_t *cN, *cNm;
  bf16_t *gates, *gatesm;
  bf16_t *qf, *qfm;
  float *gl, *glm;
  bf16_t *vv, *vvm;
  bf16_t *qiH, *qiL;
  bf16_t *kiH, *kiL;
  float* wi;
  int* sel; int* nsel;
  float* proj;
  float* ych;
  bf16_t* WmT;
  bf16_t* WsT;
  bf16_t* WoT;
  float* lbv;
  float* stats;
  float* statsm;
  float* vm;
  bf16_t* dummy;
  unsigned* bar;
  unsigned long long* ts;
  bf16_t* wukT;
  bf16_t* wuvT;
};

template <typename TA>
__global__ __launch_bounds__(256) void k_sgemm(const TA* __restrict__ A, int lda, const float* __restrict__ Bm, int ldb,
                                               float* __restrict__ C, int ldc, int M, int N, int K) {
  __shared__ float As[16][64 + 4];
  __shared__ float Bs[16][64 + 4];
  const int tx = threadIdx.x & 15, ty = threadIdx.x >> 4;
  const int m0 = blockIdx.y * 64, n0 = blockIdx.x * 64;
  float acc[4][4] = {};
  for (int k0 = 0; k0 < K; k0 += 16) {
    for (int i = threadIdx.x; i < 64 * 16; i += 256) {
      int r = i >> 4, c = i & 15; int gm = m0 + r;
      float v = 0.f;
      if (gm < M) { if constexpr (sizeof(TA) == 2) v = bf2f(A[(size_t)gm * lda + k0 + c]); else v = A[(size_t)gm * lda + k0 + c]; }
      As[c][r] = v;
    }
    for (int i = threadIdx.x; i < 16 * 64; i += 256) {
      int r = i >> 6, c = i & 63; int gn = n0 + c;
      Bs[r][c] = gn < N ? Bm[(size_t)(k0 + r) * ldb + gn] : 0.f;
    }
    __syncthreads();
#pragma unroll
    for (int kk = 0; kk < 16; ++kk) {
      float a[4], b[4];
#pragma unroll
      for (int i = 0; i < 4; ++i) a[i] = As[kk][ty * 4 + i];
#pragma unroll
      for (int j = 0; j < 4; ++j) b[j] = Bs[kk][tx * 4 + j];
#pragma unroll
      for (int i = 0; i < 4; ++i)
#pragma unroll
        for (int j = 0; j < 4; ++j) acc[i][j] = fmaf(a[i], b[j], acc[i][j]);
    }
    __syncthreads();
  }
#pragma unroll
  for (int i = 0; i < 4; ++i) {
    int gm = m0 + ty * 4 + i; if (gm >= M) continue;
#pragma unroll
    for (int j = 0; j < 4; ++j) { int gn = n0 + tx * 4 + j; if (gn < N) C[(size_t)gm * ldc + gn] = acc[i][j]; }
  }
}

__global__ __launch_bounds__(256) void k_epi(Params p, int layer, int row0, int is_meta) {
  const int lr = blockIdx.x, tid = threadIdx.x;
  const float* pr = p.proj + (size_t)lr * NIN;
  const size_t r = (size_t)row0 + lr;
  bf16_t* qa = (is_meta ? p.qam : p.qa) + r * 512;
  bf16_t* cN = (is_meta ? p.cNm : p.cN) + r * 128;
  bf16_t* gates = (is_meta ? p.gatesm : p.gates) + r * 1024;
  bf16_t* qf = (is_meta ? p.qfm : p.qf) + r * 512;
  float* gl = (is_meta ? p.glm : p.gl) + r * 512;
  bf16_t* vv = (is_meta ? p.vvm : p.vv) + r * 512;
  __shared__ float red[256];
  for (int c = tid; c < 512; c += 256) {
    qa[c] = f2bf(pr[O_QA + c]);
    gates[c] = f2bf(siluf_(pr[O_GA + c]));
    gates[512 + c] = f2bf(siluf_(pr[O_GH + c]));
    qf[c] = f2bf(siluf_(pr[O_QH + c]) * 0.08838834764831845f);
    vv[c] = f2bf(pr[O_IH + c]);
    int hk = c;
    float lb = 0.f;
    if (layer == 1) { float r0 = p.lbraw[hk], r1 = p.lbraw[512 + hk]; float m = fmaxf(r0, r1); float e0 = expf(r0 - m), e1 = expf(r1 - m); lb = e1 / (e0 + e1); }
    float f = lb + (1.0f - lb) * sigmoidf_(pr[O_FH + c]);
    gl[c] = logf(f);
  }
  float v = tid < 128 ? pr[O_CKV + tid] : 0.f;
  red[tid] = v * v; __syncthreads();
  for (int s = 128; s > 0; s >>= 1) { if (tid < s) red[tid] += red[tid + s]; __syncthreads(); }
  float rstd = rsqrtf(red[0] / 128.f + EPS);
  if (tid < 128) cN[tid] = f2bf(v * rstd * p.kvg[layer * 128 + tid]);
  if (!is_meta) {
    { float q = pr[O_QI + tid] * 0.125f; bf16_t h = f2bf(q); p.qiH[r * 256 + tid] = h; p.qiL[r * 256 + tid] = f2bf(q - bf2f(h)); }
    if (tid < 64) { float k = pr[O_KI + tid]; bf16_t h = f2bf(k); p.kiH[r * 64 + tid] = h; p.kiL[r * 64 + tid] = f2bf(k - bf2f(h)); }
    if (tid < 4) p.wi[r * 4 + tid] = pr[O_WI + tid] * 0.5f;
  }
}

__device__ __forceinline__ unsigned f2key(float f) { unsigned u = __float_as_uint(f); return (u & 0x80000000u) ? ~u : (u | 0x80000000u); }

__global__ __launch_bounds__(256) void k_topk(Params p) {
  const int gq = blockIdx.x, b = gq / S, t = gq % S, tid = threadIdx.x;
  const int n = t + 1;
  int* sel = p.sel + (size_t)gq * TOPK;
  if (n <= TOPK) {
    for (int i = tid; i < TOPK; i += 256) sel[i] = i < n ? i : 0;
    if (tid == 0) p.nsel[gq] = n;
    return;
  }
  __shared__ float q[256];
  __shared__ float w[4];
  __shared__ unsigned keys[S];
  __shared__ unsigned hist[256];
  __shared__ unsigned s_prefix, s_need;
  __shared__ unsigned cg[256], ce[256];
  q[tid] = bf2f(p.qiH[(size_t)gq * 256 + tid]) + bf2f(p.qiL[(size_t)gq * 256 + tid]);
  if (tid < 4) w[tid] = p.wi[(size_t)gq * 4 + tid];
  __syncthreads();
  for (int s = tid; s < n; s += 256) {
    const bf16_t* kh = p.kiH + ((size_t)b * S + s) * 64;
    const bf16_t* kl = p.kiL + ((size_t)b * S + s) * 64;
    float sc = 0.f;
#pragma unroll 1
    for (int h = 0; h < 4; ++h) {
      float d = 0.f;
#pragma unroll 8
      for (int j = 0; j < 64; ++j) d = fmaf(q[h * 64 + j], bf2f(kh[j]) + bf2f(kl[j]), d);
      sc = fmaf(w[h], fmaxf(d, 0.f), sc);
    }
    keys[s] = f2key(sc);
  }
  if (tid == 0) { s_prefix = 0; s_need = TOPK; }
  __syncthreads();
  for (int d = 3; d >= 0; --d) {
    hist[tid] = 0; __syncthreads();
    unsigned prefix = s_prefix;
    for (int s = tid; s < n; s += 256) {
      unsigned k = keys[s];
      bool match = (d == 3) ? true : ((k >> (8 * (d + 1))) == prefix);
      if (match) atomicAdd(&hist[(k >> (8 * d)) & 255u], 1u);
    }
    __syncthreads();
    if (tid == 0) {
      unsigned need = s_need, cum = 0; int bin = 255;
      for (; bin > 0; --bin) { if (cum + hist[bin] >= need) break; cum += hist[bin]; }
      s_prefix = (prefix << 8) | (unsigned)bin; s_need = need - cum;
    }
    __syncthreads();
  }
  const unsigned T = s_prefix, need = s_need;
  const int per = (n + 255) / 256;
  const int s0 = tid * per, s1 = min(n, s0 + per);
  unsigned ng = 0, ne = 0;
  for (int s = s0; s < s1; ++s) { unsigned k = keys[s]; ng += k > T; ne += k == T; }
  cg[tid] = ng; ce[tid] = ne; __syncthreads();
  if (tid == 0) { unsigned a = 0, bb = 0; for (int i = 0; i < 256; ++i) { unsigned xx = cg[i], yy = ce[i]; cg[i] = a; ce[i] = bb; a += xx; bb += yy; } }
  __syncthreads();
  unsigned og = cg[tid], oe = ce[tid];
  const unsigned ngt = TOPK - need;
  for (int s = s0; s < s1; ++s) {
    unsigned k = keys[s];
    if (k > T) sel[og++] = s;
    else if (k == T) { if (oe < need) sel[ngt + oe] = s; oe++; }
  }
  if (tid == 0) p.nsel[gq] = TOPK;
}

__global__ __launch_bounds__(256) void k_attn(Params p, int layer) {
  const int tid = threadIdx.x;
  const bool is_meta = blockIdx.x >= R;
  const int gq = is_meta ? (int)blockIdx.x - R : (int)blockIdx.x;
  const int b = is_meta ? 0 : gq / S, t = is_meta ? gq : gq % S;
  const int e = is_meta ? gq : NM + t;
  __shared__ float qa[512];
  __shared__ float ql[8 * 128];
  __shared__ int kidx[NM + TOPK];
  __shared__ float lg[8][NM + TOPK];
  __shared__ float ol[8 * 128];
  __shared__ float red[8];
  const bf16_t* qrow = (is_meta ? p.qam : p.qa) + (size_t)gq * 512;
  qa[tid] = bf2f(qrow[tid]); qa[tid + 256] = bf2f(qrow[tid + 256]);
  int nk;
  if (is_meta) { nk = gq + 1; for (int i = tid; i < nk; i += 256) kidx[i] = -1 - i; }
  else {
    int ns = p.nsel[gq]; nk = NM + ns;
    for (int i = tid; i < nk; i += 256) kidx[i] = i < NM ? -1 - i : p.sel[(size_t)gq * TOPK + (i - NM)];
  }
  __syncthreads();
  const float* w_uk = p.w_uk + (size_t)layer * 8 * 64 * 128;
  const float* w_uv = p.w_uv + (size_t)layer * 8 * 128 * 64;
  for (int o = tid; o < 1024; o += 256) {
    int h = o >> 7, cc = o & 127; float a = 0.f;
    const float* wk = w_uk + (size_t)h * 64 * 128 + cc;
#pragma unroll 8
    for (int d = 0; d < 64; ++d) a = fmaf(qa[h * 64 + d], wk[(size_t)d * 128], a);
    ql[o] = a;
  }
  __syncthreads();
  for (int pp = tid; pp < 8 * nk; pp += 256) {
    int h = pp / nk, j = pp % nk; int kr = kidx[j];
    const bf16_t* cr = kr < 0 ? p.cNm + (size_t)(-1 - kr) * 128 : p.cN + ((size_t)b * S + kr) * 128;
    int kpos = kr < 0 ? (-1 - kr) : NM + kr;
    float a = 0.f;
#pragma unroll 8
    for (int cc = 0; cc < 128; ++cc) a = fmaf(ql[h * 128 + cc], bf2f(cr[cc]), a);
    lg[h][j] = a * 0.125f + p.rel_bias[t5_bucket(e - kpos) * 8 + h];
  }
  __syncthreads();
  {
    int h = tid >> 5, l = tid & 31;
    float m = -INFINITY;
    for (int j = l; j < nk; j += 32) m = fmaxf(m, lg[h][j]);
    for (int o = 16; o > 0; o >>= 1) m = fmaxf(m, __shfl_xor(m, o));
    float s = 0.f;
    for (int j = l; j < nk; j += 32) { float pr = expf(lg[h][j] - m); lg[h][j] = pr; s += pr; }
    for (int o = 16; o > 0; o >>= 1) s += __shfl_xor(s, o);
    if (l == 0) red[h] = 1.0f / s;
  }
  __syncthreads();
  for (int o = tid; o < 1024; o += 256) {
    int h = o >> 7, cc = o & 127; float a = 0.f;
#pragma unroll 4
    for (int j = 0; j < nk; ++j) { int kr = kidx[j]; const bf16_t* cr = kr < 0 ? p.cNm + (size_t)(-1 - kr) * 128 : p.cN + ((size_t)b * S + kr) * 128; a = fmaf(lg[h][j], bf2f(cr[cc]), a); }
    ol[o] = a * red[h];
  }
  __syncthreads();
  bf16_t* grow = (is_meta ? p.gatesm : p.gates) + (size_t)gq * 1024;
  for (int o = tid; o < 512; o += 256) {
    int h = o >> 6, d = o & 63; float a = 0.f;
    const float* wv = w_uv + (size_t)h * 128 * 64 + d;
#pragma unroll 8
    for (int cc = 0; cc < 128; ++cc) a = fmaf(ol[h * 128 + cc], wv[(size_t)cc * 64], a);
    grow[o] = f2bf(a * bf2f(grow[o]));
  }
}

__global__ __launch_bounds__(256) void k_hgrn(Params p, int layer) {
  const int b = blockIdx.x >> 2, h = blockIdx.x & 3, tid = threadIdx.x, v = tid & 127, kh = tid >> 7;
  __shared__ float sq[128], sf[128], sk[128], sv[128];
  __shared__ float so[2][128];
  __shared__ float sred[128];
  const float* gnorm = p.hng + layer * 128;
  float St[64];
#pragma unroll
  for (int i = 0; i < 64; ++i) St[i] = 0.f;
  for (int e = 0; e < NM + S; ++e) {
    const bool im = e < NM;
    const size_t r = im ? (size_t)e : (size_t)b * S + (e - NM);
    const bf16_t* qf = (im ? p.qfm : p.qf) + r * 512 + h * 128;
    const float* gl = (im ? p.glm : p.gl) + r * 512 + h * 128;
    const bf16_t* vv = (im ? p.vvm : p.vv) + r * 512 + h * 128;
    bf16_t* gt = (im ? p.gatesm : p.gates) + r * 1024 + 512 + h * 128;
    if (tid < 128) {
      float f = expf(gl[tid]);
      sq[tid] = bf2f(qf[tid]); sf[tid] = f; sk[tid] = 1.0f - f; sv[tid] = bf2f(vv[tid]);
    }
    __syncthreads();
    float vval = sv[v], o = 0.f;
#pragma unroll
    for (int i = 0; i < 64; ++i) { int k = kh * 64 + i; St[i] = fmaf(sf[k], St[i], sk[k] * vval); o = fmaf(sq[k], St[i], o); }
    so[kh][v] = o;
    __syncthreads();
    if (tid < 128) { float ot = so[0][tid] + so[1][tid]; so[0][tid] = ot; sred[tid] = ot * ot; }
    __syncthreads();
    for (int s = 64; s > 0; s >>= 1) { if (tid < s) sred[tid] += sred[tid + s]; __syncthreads(); }
    if (tid < 128 && (!im || b == 0)) {
      float rstd = rsqrtf(sred[0] / 128.f + EPS);
      gt[tid] = f2bf(so[0][tid] * rstd * gnorm[tid] * bf2f(gt[tid]));
    }
    __syncthreads();
  }
}

__global__ __launch_bounds__(256) void k_ln(const float* __restrict__ h, const float* __restrict__ y, const float* __restrict__ g,
                                            const float* __restrict__ bb, float* __restrict__ dst, bf16_t* __restrict__ hi, bf16_t* __restrict__ lo) {
  const int row = blockIdx.x, tid = threadIdx.x;
  __shared__ float red[256];
  float v[4]; float s = 0.f;
  for (int i = 0; i < 4; ++i) { int c = tid + 256 * i; v[i] = DN_ALPHA * h[(size_t)row * D + c] + y[(size_t)row * D + c]; s += v[i]; }
  red[tid] = s; __syncthreads();
  for (int o = 128; o > 0; o >>= 1) { if (tid < o) red[tid] += red[tid + o]; __syncthreads(); }
  float mu = red[0] / D; __syncthreads();
  float q = 0.f;
  for (int i = 0; i < 4; ++i) { float d = v[i] - mu; q += d * d; }
  red[tid] = q; __syncthreads();
  for (int o = 128; o > 0; o >>= 1) { if (tid < o) red[tid] += red[tid + o]; __syncthreads(); }
  float rstd = rsqrtf(red[0] / D + EPS);
  for (int i = 0; i < 4; ++i) {
    int c = tid + 256 * i; float o = (v[i] - mu) * rstd * g[c] + bb[c];
    dst[(size_t)row * D + c] = o;
    if (hi) { bf16_t hh = f2bf(o); hi[(size_t)row * D + c] = hh; lo[(size_t)row * D + c] = f2bf(o - bf2f(hh)); }
  }
}
#define LAS __attribute__((address_space(3)))
typedef short bf16x8 __attribute__((ext_vector_type(8)));
typedef float f32x4 __attribute__((ext_vector_type(4)));
typedef unsigned u32x2 __attribute__((ext_vector_type(2)));
typedef unsigned u32x4 __attribute__((ext_vector_type(4)));
constexpr int NTHREADS = 512;
constexpr int LDS_BYTES = 160 * 1024;
constexpr int BM = 256, BK = 64, HALF = 128, HTB = HALF * BK * 2, STAGE_BYTES = 8 * HTB;
constexpr int LDS_EXTRA = STAGE_BYTES;
#define IDX_SPLIT 0
#define TPROBE 0
#define TP_S 0
#define TP_E 1
#define TP_LO 0
#define TP_HI 256
#define TS_MARK(k) do { if (TPROBE && threadIdx.x == 0) p.ts[(size_t)blockIdx.x * 64 + (k)] = __builtin_amdgcn_s_memrealtime(); } while (0)
#define TS_ACC_BEGIN() unsigned long long tacc_ = TPROBE ? __builtin_amdgcn_s_memrealtime() : 0ull
#define TS_ACC(k) do { if (TPROBE) { const unsigned long long t2_ = __builtin_amdgcn_s_memrealtime(); if (threadIdx.x == 0) p.ts[(size_t)blockIdx.x * 64 + (k)] += t2_ - tacc_; tacc_ = t2_; } } while (0)
#define PROBE_REP_SCORE 0
#define ABL_SCORE 0
#define PROBE_REP_SELECT 0
#define PROBE_REP_ATT 0
#define PROBE_REP_QLAT 0

typedef float f32x2v __attribute__((ext_vector_type(2)));
typedef __bf16 bf16x2v __attribute__((ext_vector_type(2)));
__device__ __forceinline__ unsigned pack_bf16(float lo, float hi) { const f32x2v v = {lo, hi}; const bf16x2v b = __builtin_convertvector(v, bf16x2v); return __builtin_bit_cast(unsigned, b); }
__device__ __forceinline__ bf16_t f2bf_fast(float x) { return (bf16_t)(pack_bf16(x, 0.f) & 0xffffu); }
__device__ __forceinline__ float fast_sigmoid(float x) { return __builtin_amdgcn_rcpf(1.0f + __expf(-x)); }
__device__ __forceinline__ float fast_silu(float x) { return x * __builtin_amdgcn_rcpf(1.0f + __expf(-x)); }

__device__ __forceinline__ int lds_byte(int r, int c) { const int st = (r >> 4) * 2 + (c >> 5), rr = r & 15, cc = c & 31, ob = rr * 64 + cc * 2; return st * 1024 + (ob ^ (((ob >> 9) & 1) << 5)); }
__device__ __forceinline__ void stage_rc(int b, int& Rr, int& Cc) { const int st = b / 1024, sb = b % 1024, swz = sb ^ (((sb >> 9) & 1) << 5); Rr = (st >> 1) * 16 + swz / 64; Cc = (st & 1) * 32 + (swz % 64) / 2; }

struct GUnit { int pm, pn; };
__device__ __forceinline__ bool unit_next(int i, int nM, int nN, GUnit& u) {
  const int nwg = nM * nN; const long L = (long)i * gridDim.x + blockIdx.x; if (L >= nwg) return false;
  int wgid = (int)L; { const int q = nwg / 8, r = nwg % 8, xcd = wgid % 8, off = wgid / 8; wgid = (xcd < r ? xcd * (q + 1) : r * (q + 1) + (xcd - r) * q) + off; }
  const int nig = 8 * nN, gid = wgid / nig, fm = gid * 8, gsz = (nM - fm) < 8 ? (nM - fm) : 8;
  u.pm = fm + ((wgid % nig) % gsz); u.pn = (wgid % nig) / gsz; return true;
}

struct SrcP1 {
  const char* Ahi; const char* Alo; const char* Wm; const char* Ws;
  __device__ __forceinline__ int nt(const GUnit& u) const { return (IDX_SPLIT && u.pn >= 12) ? 48 : 16; }
  __device__ __forceinline__ int ldb(const GUnit& u) const { return u.pn < 12 ? 1024 : 3072; }
  __device__ __forceinline__ const char* a(const GUnit& u, int kt) const { const char* b = (kt >= 16 && kt < 32) ? Alo : Ahi; return b + (size_t)u.pm * (256 * 1024 * 2) + (size_t)(kt & 15) * 128; }
  __device__ __forceinline__ const char* b(const GUnit& u, int kt) const { return u.pn < 12 ? Wm + (size_t)u.pn * (256 * 1024 * 2) + (size_t)kt * 128 : Ws + (size_t)(u.pn - 12) * (256 * 3072 * 2) + (size_t)kt * 128; }
};
struct SrcP3 {
  const char* A; const char* W;
  __device__ __forceinline__ int nt(const GUnit&) const { return 16; }
  __device__ __forceinline__ int ldb(const GUnit&) const { return 1024; }
  __device__ __forceinline__ const char* a(const GUnit& u, int kt) const { return A + (size_t)u.pm * (256 * 1024 * 2) + (size_t)kt * 128; }
  __device__ __forceinline__ const char* b(const GUnit& u, int kt) const { return W + (size_t)u.pn * (256 * 1024 * 2) + (size_t)kt * 128; }
};


template <int CTRL, int ROWMASK = 0xf, bool BC = true>
__device__ __forceinline__ float dppf(float v) { return __int_as_float(__builtin_amdgcn_update_dpp(0, __float_as_int(v), CTRL, ROWMASK, 0xf, BC)); }
__device__ __forceinline__ float row_sum16(float v) { v += dppf<0x128>(v); v += dppf<0x124>(v); v += dppf<0x122>(v); v += dppf<0x121>(v); return v; }
__device__ __forceinline__ unsigned wave_incl_scan(unsigned v) {
  v += (unsigned)__builtin_amdgcn_update_dpp(0, (int)v, 0x111, 0xf, 0xf, true);
  v += (unsigned)__builtin_amdgcn_update_dpp(0, (int)v, 0x112, 0xf, 0xf, true);
  v += (unsigned)__builtin_amdgcn_update_dpp(0, (int)v, 0x114, 0xf, 0xf, true);
  v += (unsigned)__builtin_amdgcn_update_dpp(0, (int)v, 0x118, 0xf, 0xf, true);
  v += (unsigned)__builtin_amdgcn_update_dpp(0, (int)v, 0x142, 0xa, 0xf, false);
  v += (unsigned)__builtin_amdgcn_update_dpp(0, (int)v, 0x143, 0xc, 0xf, false);
  return v;
}
__device__ __forceinline__ float rows_max(float x) {
  auto r = __builtin_amdgcn_permlane16_swap(__float_as_uint(x), __float_as_uint(x), false, false); x = fmaxf(__uint_as_float(r[0]), __uint_as_float(r[1]));
  auto q = __builtin_amdgcn_permlane32_swap(__float_as_uint(x), __float_as_uint(x), false, false); return fmaxf(__uint_as_float(q[0]), __uint_as_float(q[1])); }
__device__ __forceinline__ float rows_sum(float x) {
  auto r = __builtin_amdgcn_permlane16_swap(__float_as_uint(x), __float_as_uint(x), false, false); x = __uint_as_float(r[0]) + __uint_as_float(r[1]);
  auto q = __builtin_amdgcn_permlane32_swap(__float_as_uint(x), __float_as_uint(x), false, false); return __uint_as_float(q[0]) + __uint_as_float(q[1]); }
__device__ __forceinline__ size_t kfrag(size_t row, int c) { return (((((row >> 4) * 2 + (size_t)(c >> 5)) * 4 + (size_t)((c >> 3) & 3)) * 16 + (row & 15)) * 8) + (size_t)(c & 7); }

struct EpiP1 {
  Params p; int layer;
  __device__ __forceinline__ void operator()(const f32x4 (&acc)[2][2][4][2], const GUnit& u, int wr, int wc, int fr, int fq, LAS unsigned char* lds) const {
    const int row0 = u.pm * BM + wr * 64 + fr;
    if (u.pn < 12) {
      const int kind = u.pn >> 1; const int c00 = (u.pn & 1) * 256 + wc * 32 + 4 * fq;
#pragma unroll
      for (int ai = 0; ai < 2; ++ai)
#pragma unroll
        for (int m = 0; m < 4; ++m) {
          const size_t row = (size_t)(row0 + ai * HALF + m * 16);
#pragma unroll
          for (int bj = 0; bj < 2; ++bj)
#pragma unroll
            for (int n = 0; n < 2; ++n) {
              const int c = c00 + bj * HALF + n * 16; f32x4 v = acc[ai][bj][m][n];
              if (kind == 3) {
                const f32x4 lb = *(const f32x4*)(p.lbv + layer * 512 + c); f32x4 o;
#pragma unroll
                for (int j = 0; j < 4; ++j) o[j] = __logf(lb[j] + (1.0f - lb[j]) * fast_sigmoid(v[j]));
                *(f32x4*)(p.gl + row * 512 + c) = o;
              } else {
                if (kind == 1 || kind == 5) {
#pragma unroll
                  for (int j = 0; j < 4; ++j) v[j] = fast_silu(v[j]);
                } else if (kind == 2) {
#pragma unroll
                  for (int j = 0; j < 4; ++j) v[j] = fast_silu(v[j]) * 0.08838834764831845f;
                }
                u32x2 w; w.x = pack_bf16(v[0], v[1]); w.y = pack_bf16(v[2], v[3]);
                bf16_t* dst = kind == 0 ? p.qa + row * 512 + c : kind == 1 ? p.gates + row * 1024 + c : kind == 2 ? p.qf + row * 512 + c
                            : kind == 4 ? p.vv + row * 512 + c : p.gates + row * 1024 + 512 + c;
                *(u32x2*)dst = w;
              }
            }
        }
    } else if (u.pn == 12) {
      const int c00 = wc * 32 + 4 * fq;
#pragma unroll
      for (int ai = 0; ai < 2; ++ai)
#pragma unroll
        for (int m = 0; m < 4; ++m) {
          const size_t row = (size_t)(row0 + ai * HALF + m * 16);
#pragma unroll
          for (int bj = 0; bj < 2; ++bj)
#pragma unroll
            for (int n = 0; n < 2; ++n) {
              const int c = c00 + bj * HALF + n * 16; const f32x4 v = acc[ai][bj][m][n] * 0.125f;
              u32x2 wh, wl; wh.x = pack_bf16(v[0], v[1]); wh.y = pack_bf16(v[2], v[3]);
              wl.x = pack_bf16(v[0] - __uint_as_float(wh.x << 16), v[1] - __uint_as_float(wh.x & 0xffff0000u)); wl.y = pack_bf16(v[2] - __uint_as_float(wh.y << 16), v[3] - __uint_as_float(wh.y & 0xffff0000u));
              *(u32x2*)(p.qiH + row * 256 + c) = wh; *(u32x2*)(p.qiL + row * 256 + c) = wl;
            }
        }
    } else {
      LAS float* red = (LAS float*)(lds + LDS_EXTRA);
#pragma unroll
      for (int ai = 0; ai < 2; ++ai)
#pragma unroll
        for (int m = 0; m < 4; ++m) {
          float s = 0.f;
#pragma unroll
          for (int n = 0; n < 2; ++n) { const f32x4 v = acc[ai][0][m][n]; s += (v[0] * v[0] + v[1] * v[1]) + (v[2] * v[2] + v[3] * v[3]); }
          s = rows_sum(s);
          if (fq == 0) red[(ai * HALF + wr * 64 + m * 16 + fr) * 4 + wc] = s;
        }
      asm volatile("s_waitcnt lgkmcnt(0)" ::: "memory"); __builtin_amdgcn_s_barrier(); asm volatile("" ::: "memory");
#pragma unroll
      for (int ai = 0; ai < 2; ++ai)
#pragma unroll
        for (int m = 0; m < 4; ++m) {
          const int lr = ai * HALF + wr * 64 + m * 16 + fr; const size_t row = (size_t)(u.pm * BM + lr);
          const f32x4 pr = *(const LAS f32x4*)(red + lr * 4);
          const float rstd = rsqrtf(((pr[0] + pr[1]) + (pr[2] + pr[3])) * (1.0f / 128.0f) + EPS);
#pragma unroll
          for (int n = 0; n < 2; ++n) {
            const int c = wc * 32 + n * 16 + 4 * fq; const f32x4 g = *(const f32x4*)(p.kvg + layer * 128 + c); const f32x4 v = acc[ai][0][m][n] * rstd * g;
            u32x2 w; w.x = pack_bf16(v[0], v[1]); w.y = pack_bf16(v[2], v[3]); *(u32x2*)(p.cN + row * 128 + c) = w;
          }
          if (wc < 2) {
#pragma unroll
            for (int n = 0; n < 2; ++n) {
              const int c = wc * 32 + n * 16 + 4 * fq; const f32x4 v = acc[ai][1][m][n];
              u32x2 wh, wl; wh.x = pack_bf16(v[0], v[1]); wh.y = pack_bf16(v[2], v[3]);
              wl.x = pack_bf16(v[0] - __uint_as_float(wh.x << 16), v[1] - __uint_as_float(wh.x & 0xffff0000u)); wl.y = pack_bf16(v[2] - __uint_as_float(wh.y << 16), v[3] - __uint_as_float(wh.y & 0xffff0000u));
              *(u32x2*)(p.kiH + kfrag(row, c)) = wh; *(u32x2*)(p.kiL + kfrag(row, c)) = wl;
            }
          } else if (wc == 2 && fq == 0) {
            *(f32x4*)(p.wi + row * 4) = acc[ai][1][m][0] * 0.5f;
          }
        }
    }
  }
};

struct EpiP3 {
  Params p; const float* hres;
  __device__ __forceinline__ void operator()(const f32x4 (&acc)[2][2][4][2], const GUnit& u, int wr, int wc, int fr, int fq, LAS unsigned char* lds) const {
    const int row0 = u.pm * BM + wr * 64 + fr; const int c00 = u.pn * BM + wc * 32 + 4 * fq;
#pragma unroll
    for (int ai = 0; ai < 2; ++ai)
#pragma unroll
      for (int m = 0; m < 4; ++m) {
        const size_t row = (size_t)(row0 + ai * HALF + m * 16); float s = 0.f, q = 0.f;
#pragma unroll
        for (int bj = 0; bj < 2; ++bj)
#pragma unroll
          for (int n = 0; n < 2; ++n) {
            const int c = c00 + bj * HALF + n * 16; const f32x4 h = *(const f32x4*)(hres + row * D + c);
            const f32x4 v = h * DN_ALPHA + acc[ai][bj][m][n];
            *(f32x4*)(p.hF + row * D + c) = v;
            s += (v[0] + v[1]) + (v[2] + v[3]); q += (v[0] * v[0] + v[1] * v[1]) + (v[2] * v[2] + v[3] * v[3]);
          }
        s = rows_sum(s); q = rows_sum(q);
        if (fq == 0) { float2 st; st.x = s; st.y = q; *(float2*)(p.stats + (row * 16 + u.pn * 4 + wc) * 2) = st; }
        asm volatile("" ::: "memory");
      }
  }
};

template <class Src, class Epi>
__device__ __forceinline__ void gemm_phase(LAS unsigned char* lds, const Src S, const int nM, const int nN, const Epi& E) {
  int tid_ = threadIdx.x; asm volatile("" : "+v"(tid_));
  const int tid = tid_, wid = __builtin_amdgcn_readfirstlane(tid >> 6), lane = tid & 63, wr = wid >> 2, wc = wid & 3, fr = lane & 15, fq = lane >> 4;
  unsigned voffA[2], voffB1[2], voffB3[2];
#pragma unroll
  for (int i = 0; i < 2; ++i) { int Rr, Cc; stage_rc(tid * 16 + i * 8192, Rr, Cc); voffA[i] = (unsigned)(Rr * 1024 + Cc) * 2u; voffB1[i] = voffA[i]; voffB3[i] = (unsigned)(Rr * 3072 + Cc) * 2u; }
  const size_t hstepA = (size_t)HALF * 1024 * 2;
  const unsigned ldsw = (unsigned)wid * 1024u;
  const int aoff = lds_byte(wr * 64 + fr, fq * 8), boff = lds_byte(wc * 32 + fr, fq * 8);
#define G_SA(b, h) (((b) * 2 + (h)) * HTB)
#define G_SB(b, h) ((4 + (b) * 2 + (h)) * HTB)
#define G_STAGE(bufoff, gbase, v0, v1) do { \
    __builtin_amdgcn_global_load_lds((const unsigned*)((const char*)(gbase) + (v0)), (LAS unsigned*)(lds + (bufoff) + ldsw), 16, 0, 0); \
    __builtin_amdgcn_global_load_lds((const unsigned*)((const char*)(gbase) + (v1)), (LAS unsigned*)(lds + (bufoff) + ldsw + 8192), 16, 0, 0); } while (0)
#define G_STAGE_A(bufoff, gbase) G_STAGE(bufoff, gbase, voffA[0], voffA[1])
#define G_LDA(dst, b, h) do { _Pragma("unroll") for (int m = 0; m < 4; ++m) _Pragma("unroll") for (int k = 0; k < 2; ++k) dst[m][k] = *(const LAS bf16x8*)(lds + G_SA(b, h) + aoff + m * 2048 + k * 1024); } while (0)
#define G_LDB(dst, b, h) do { _Pragma("unroll") for (int n = 0; n < 2; ++n) _Pragma("unroll") for (int k = 0; k < 2; ++k) dst[n][k] = *(const LAS bf16x8*)(lds + G_SB(b, h) + boff + n * 2048 + k * 1024); } while (0)
#define G_MMA(ai, bj, At, Bt) do { __builtin_amdgcn_s_setprio(1); _Pragma("unroll") for (int m = 0; m < 4; ++m) _Pragma("unroll") for (int n = 0; n < 2; ++n) _Pragma("unroll") for (int k = 0; k < 2; ++k) \
    acc[ai][bj][m][n] = __builtin_amdgcn_mfma_f32_16x16x32_bf16(Bt[n][k], At[m][k], acc[ai][bj][m][n], 0, 0, 0); __builtin_amdgcn_s_setprio(0); } while (0)
#define G_WAIT_V(n) asm volatile("s_waitcnt vmcnt(" #n ")" ::: "memory")
#define G_WAIT_L(n) asm volatile("s_waitcnt lgkmcnt(" #n ")" ::: "memory")
#define G_BAR __builtin_amdgcn_s_barrier()
#define G_SCHED __builtin_amdgcn_sched_barrier(0)
  const Params& p = E.p;
  GUnit cur, nxt; int ui = 0;
  if (!unit_next(0, nM, nN, cur)) return;
  f32x4 acc[2][2][4][2];
#pragma unroll
  for (int a = 0; a < 2; ++a)
#pragma unroll
    for (int b = 0; b < 2; ++b)
#pragma unroll
      for (int m = 0; m < 4; ++m)
#pragma unroll
        for (int n = 0; n < 2; ++n) acc[a][b][m][n] = (f32x4){0.f, 0.f, 0.f, 0.f};
  bf16x8 At[4][2], B0[2][2], B1[2][2];
  {
    const bool w3 = S.ldb(cur) == 3072; const unsigned vb0 = w3 ? voffB3[0] : voffB1[0], vb1 = w3 ? voffB3[1] : voffB1[1]; const size_t hsB = (size_t)HALF * S.ldb(cur) * 2;
    const char* cA0 = S.a(cur, 0); const char* cB0 = S.b(cur, 0); const char* cA1 = S.a(cur, 1); const char* cB1 = S.b(cur, 1);
    G_STAGE(G_SB(0, 0), cB0, vb0, vb1); G_STAGE_A(G_SA(0, 0), cA0); G_STAGE(G_SB(0, 1), cB0 + hsB, vb0, vb1); G_STAGE_A(G_SA(0, 1), cA0 + hstepA);
    if (wr == 1) G_BAR;
    G_WAIT_V(4); G_BAR;
    G_STAGE(G_SB(1, 0), cB1, vb0, vb1); G_STAGE_A(G_SA(1, 0), cA1); G_STAGE(G_SB(1, 1), cB1 + hsB, vb0, vb1);
    G_WAIT_V(6); G_BAR;
  }
  for (;;) {
    TS_ACC_BEGIN();
    const bool has_next = unit_next(ui + 1, nM, nN, nxt);
    const GUnit nu = has_next ? nxt : cur;
    const int nt = S.nt(cur);
    const bool cw3 = S.ldb(cur) == 3072, nw3 = S.ldb(nu) == 3072;
    for (int t = 0; t < nt; t += 2) {
      const bool last = (t == nt - 2);
      const char* a1 = S.a(cur, t + 1);
      const char* a2 = last ? S.a(nu, 0) : S.a(cur, t + 2); const char* b2 = last ? S.b(nu, 0) : S.b(cur, t + 2);
      const char* a3 = last ? S.a(nu, 1) : S.a(cur, t + 3); const char* b3 = last ? S.b(nu, 1) : S.b(cur, t + 3);
      const bool w3 = last ? nw3 : cw3;
      const unsigned vb0 = w3 ? voffB3[0] : voffB1[0], vb1 = w3 ? voffB3[1] : voffB1[1]; const size_t hsB = w3 ? (size_t)HALF * 3072 * 2 : (size_t)HALF * 1024 * 2;
      G_LDB(B0, 0, 0); G_SCHED; G_LDA(At, 0, 0); G_STAGE_A(G_SA(1, 1), a1 + hstepA);
      G_WAIT_L(8); G_BAR; G_WAIT_L(0); G_MMA(0, 0, At, B0); G_BAR; G_SCHED;
      G_LDB(B1, 0, 1); G_STAGE(G_SB(0, 0), b2, vb0, vb1);
      G_BAR; G_WAIT_L(0); G_MMA(0, 1, At, B1); G_BAR;
      G_LDA(At, 0, 1); G_STAGE_A(G_SA(0, 0), a2);
      G_BAR; G_WAIT_L(0); G_MMA(1, 0, At, B0); G_BAR; G_SCHED;
      G_STAGE(G_SB(0, 1), b2 + hsB, vb0, vb1);
      G_WAIT_V(6); G_BAR; G_MMA(1, 1, At, B1); G_BAR;
      G_LDB(B0, 1, 0); G_SCHED; G_LDA(At, 1, 0); G_STAGE_A(G_SA(0, 1), a2 + hstepA);
      G_WAIT_L(8); G_BAR; G_WAIT_L(0); G_MMA(0, 0, At, B0); G_BAR; G_SCHED;
      G_LDB(B1, 1, 1); G_STAGE(G_SB(1, 0), b3, vb0, vb1);
      G_BAR; G_WAIT_L(0); G_MMA(0, 1, At, B1); G_BAR;
      G_LDA(At, 1, 1); G_STAGE_A(G_SA(1, 0), a3);
      G_BAR; G_WAIT_L(0); G_MMA(1, 0, At, B0); G_BAR; G_SCHED;
      G_STAGE(G_SB(1, 1), b3 + hsB, vb0, vb1);
      G_WAIT_V(6); G_BAR; G_MMA(1, 1, At, B1); G_BAR;
    }
    TS_ACC(56);
    E(acc, cur, wr, wc, fr, fq, lds);
    TS_ACC(57);
    if (!has_next) break;
#pragma unroll
    for (int a = 0; a < 2; ++a)
#pragma unroll
      for (int b = 0; b < 2; ++b)
#pragma unroll
        for (int m = 0; m < 4; ++m)
#pragma unroll
          for (int n = 0; n < 2; ++n) acc[a][b][m][n] = (f32x4){0.f, 0.f, 0.f, 0.f};
    cur = nxt; ++ui;
  }
  G_WAIT_V(0);
  if (wr == 0) G_BAR;
  G_BAR;
#undef G_SA
#undef G_SB
#undef G_STAGE
#undef G_STAGE_A
#undef G_LDA
#undef G_LDB
#undef G_MMA
#undef G_WAIT_V
#undef G_WAIT_L
#undef G_BAR
#undef G_SCHED
}

__device__ __forceinline__ void phase_prep(const Params& p, LAS unsigned char* lds) {
  int tid_ = threadIdx.x; asm volatile("" : "+v"(tid_));
  const int tid = tid_, nb = gridDim.x, bid = blockIdx.x;
  LAS float* tile = (LAS float*)lds;
  const int NJ = DEPTH * (48 + 8 + 16) * 16;
  for (int job = bid; job < NJ; job += nb) {
    const int l = job / ((48 + 8 + 16) * 16); int rem = job % ((48 + 8 + 16) * 16); const int ntile = rem / 16, kt = rem % 16;
    const int kind = ntile < 48 ? 0 : ntile < 56 ? 1 : 2; const int n0 = kind == 0 ? ntile * 64 : kind == 1 ? (ntile - 48) * 64 : (ntile - 56) * 64;
    const float* src = kind == 2 ? p.w_out + (size_t)l * D * D : p.w_in + (size_t)l * D * NIN; const int lds_ = kind == 2 ? D : NIN;
    for (int i = tid; i < 64 * 64; i += NTHREADS) {
      const int kk = i >> 6, nn = i & 63; const int n = n0 + nn; int col;
      if (kind == 0) { const int grp = n >> 9, cc = n & 511; col = (grp == 0 ? O_QA : grp == 1 ? O_GA : grp == 2 ? O_QH : grp == 3 ? O_FH : grp == 4 ? O_IH : O_GH) + cc; }
      else if (kind == 1) { col = n < 256 ? O_QI + n : n < 384 ? O_CKV + (n - 256) : n < 448 ? O_KI + (n - 384) : n < 452 ? O_WI + (n - 448) : -1; }
      else col = n;
      tile[kk * 65 + nn] = col >= 0 ? src[(size_t)(kt * 64 + kk) * lds_ + col] : 0.f;
    }
    __syncthreads();
    for (int i = tid; i < 64 * 64; i += NTHREADS) {
      const int nn = i >> 6, kk = i & 63; const float v = tile[kk * 65 + nn]; const int n = n0 + nn, k = kt * 64 + kk;
      if (kind == 0) p.WmT[((size_t)l * 3072 + n) * 1024 + k] = f2bf(v);
      else if (kind == 2) p.WoT[((size_t)l * 1024 + n) * 1024 + k] = f2bf(v);
      else { const bf16_t h = f2bf(v), lo = f2bf(v - bf2f(h)); bf16_t* d = p.WsT + ((size_t)l * 512 + n) * 3072; d[k] = h; d[1024 + k] = h; d[2048 + k] = lo; }
    }
    __syncthreads();
  }
  for (int i = bid * NTHREADS + tid; i < 512; i += nb * NTHREADS) {
    const float r0 = p.lbraw[i], r1 = p.lbraw[512 + i]; const float m = fmaxf(r0, r1); const float e0 = expf(r0 - m), e1 = expf(r1 - m);
    p.lbv[i] = 0.f; p.lbv[512 + i] = e1 / (e0 + e1);
  }
  for (int i = bid * NTHREADS + tid; i < DEPTH * 8 * 128 * 64; i += nb * NTHREADS) {
    const int d = i & 63, c = (i >> 6) & 127, lh = i >> 13;
    p.wukT[i] = f2bf(p.w_uk[((size_t)lh * 64 + d) * 128 + c]);
    const int c2 = i & 127, d2 = (i >> 7) & 63;
    p.wuvT[i] = f2bf(p.w_uv[((size_t)lh * 128 + c2) * 64 + d2]);
  }
  const size_t n4 = (size_t)(R + NM) * D / 4;
  for (size_t i = (size_t)bid * NTHREADS + tid; i < n4; i += (size_t)nb * NTHREADS) {
    const size_t row = i / (D / 4); const int c4 = (int)(i % (D / 4));
    const bool im = row >= (size_t)R; const size_t rr = im ? row - R : row;
    const f32x4 v = *(const f32x4*)((im ? p.meta : p.x) + rr * D + c4 * 4);
    u32x2 wh, wl; wh.x = pack_bf16(v[0], v[1]); wh.y = pack_bf16(v[2], v[3]);
    wl.x = pack_bf16(v[0] - __uint_as_float(wh.x << 16), v[1] - __uint_as_float(wh.x & 0xffff0000u)); wl.y = pack_bf16(v[2] - __uint_as_float(wh.y << 16), v[3] - __uint_as_float(wh.y & 0xffff0000u));
    *(u32x2*)((im ? p.hHim : p.hHi) + rr * D + c4 * 4) = wh; *(u32x2*)((im ? p.hLom : p.hLo) + rr * D + c4 * 4) = wl;
  }
}

__device__ __forceinline__ void phase_ln(const Params& p, int layer, float* dst, bool write_split) {
  int tid_ = threadIdx.x; asm volatile("" : "+v"(tid_));
  const int tid = tid_, wid = tid >> 6, lane = tid & 63;
  const float* g = p.ln_g + layer * D; const float* bb = p.ln_b + layer * D;
  for (int row = blockIdx.x * 8 + wid; row < R; row += gridDim.x * 8) {
    float s = 0.f, q = 0.f;
    if (lane < 16) { const float2 st = *(const float2*)(p.stats + ((size_t)row * 16 + lane) * 2); s = st.x; q = st.y; }
#pragma unroll
    for (int o = 8; o > 0; o >>= 1) { s += __shfl_xor(s, o); q += __shfl_xor(q, o); }
    s = __shfl(s, 0); q = __shfl(q, 0);
    const float mean = s * (1.0f / D); const float var = fmaxf(q * (1.0f / D) - mean * mean, 0.f); const float rstd = rsqrtf(var + EPS);
#pragma unroll
    for (int i = 0; i < 4; ++i) {
      const int c = (i * 64 + lane) * 4;
      const f32x4 v = *(const f32x4*)(p.hF + (size_t)row * D + c); const f32x4 gg = *(const f32x4*)(g + c); const f32x4 bv = *(const f32x4*)(bb + c);
      const f32x4 o = (v - mean) * rstd * gg + bv;
      *(f32x4*)(dst + (size_t)row * D + c) = o;
      if (write_split) {
        u32x2 wh, wl; wh.x = pack_bf16(o[0], o[1]); wh.y = pack_bf16(o[2], o[3]);
        wl.x = pack_bf16(o[0] - __uint_as_float(wh.x << 16), o[1] - __uint_as_float(wh.x & 0xffff0000u)); wl.y = pack_bf16(o[2] - __uint_as_float(wh.y << 16), o[3] - __uint_as_float(wh.y & 0xffff0000u));
        *(u32x2*)(p.hHi + (size_t)row * D + c) = wh; *(u32x2*)(p.hLo + (size_t)row * D + c) = wl;
      }
    }
  }
}

constexpr int K16_STRIDE = 8208;
constexpr int A_BIG = 0;
constexpr int A_SEL = 131328;
constexpr int A_CM = A_SEL + 8192;
constexpr int A_MISC = A_CM + 4096;
constexpr int A_HIST = A_MISC;
constexpr int A_CAND = A_MISC + 16448;
constexpr int A_RB = A_MISC + 16448 + 1024;
constexpr int A_BKT = A_RB + 1024;
constexpr int A_NSEL = A_BKT + 128;
static_assert(A_NSEL + 64 <= LDS_BYTES, "attention LDS map");

__device__ __forceinline__ unsigned off_b(unsigned row, unsigned ch) { return 256u * row + 16u * (ch ^ (((row & 3) << 2) | ((row >> 2) & 3))); }
__device__ __forceinline__ void glds16_asm(const void* gsrc, unsigned lds_dst) {
  unsigned keep;
  asm volatile("s_mov_b32 %0, m0\n\ts_mov_b32 m0, %2\n\ts_nop 0\n\tglobal_load_lds_dwordx4 %1, off\n\ts_mov_b32 m0, %0" : "=&s"(keep) : "v"(gsrc), "s"(lds_dst) : "memory");
}
__device__ __forceinline__ void wave_lds_sync() { asm volatile("s_waitcnt lgkmcnt(0)" ::: "memory"); }
typedef unsigned short u16x4 __attribute__((ext_vector_type(4)));
typedef unsigned short u16x8 __attribute__((ext_vector_type(8)));

typedef short s16x4 __attribute__((ext_vector_type(4)));
__device__ __forceinline__ s16x4 lds_tr(const LAS unsigned char* ptr) { return __builtin_amdgcn_ds_read_tr16_b64_v4i16((LAS s16x4*)ptr); }
__device__ __forceinline__ bf16x8 cat4(s16x4 a, s16x4 b) { return __builtin_shufflevector(a, b, 0, 1, 2, 3, 4, 5, 6, 7); }
__device__ __forceinline__ f32x4 mfma16(bf16x8 a, bf16x8 b, f32x4 c) { return __builtin_amdgcn_mfma_f32_16x16x32_bf16(a, b, c, 0, 0, 0); }

__device__ __forceinline__ void wave_find_bin(const unsigned (&c)[4], unsigned need, int lane, unsigned& bin, unsigned& above) {
  const unsigned tot = c[0] + c[1] + c[2] + c[3];
  unsigned cum = wave_incl_scan(tot) - tot;
  unsigned fb = 0xffffffffu, fa = 0;
#pragma unroll
  for (int i = 0; i < 4; ++i) { if (fb == 0xffffffffu && cum < need && cum + c[i] >= need) { fb = 255u - 4u * lane - i; fa = cum; } cum += c[i]; }
  const unsigned long long m = __ballot(fb != 0xffffffffu);
  const int src = m ? (int)__builtin_ctzll(m) : 0;
  bin = (unsigned)__builtin_amdgcn_readlane((int)fb, src); above = (unsigned)__builtin_amdgcn_readlane((int)fa, src);
  if (!m) { bin = 0; above = 0; }
}

__device__ __forceinline__ void attn_tile(const Params& p, const int layer, LAS unsigned char* lds, const bool is_meta, const int b, const int j,
                                          const bf16_t* wukT, const bf16_t* wuvT, const bool dry = false) {
  int tid_ = threadIdx.x; asm volatile("" : "+v"(tid_));
  const int tid = tid_, wid = __builtin_amdgcn_readfirstlane(tid >> 6), lane = tid & 63, fr = lane & 15, g = lane >> 4;
  const int t0 = 16 * j; const size_t r0 = is_meta ? 0 : (size_t)b * S + t0;
  const bf16_t* cNb = p.cN + (size_t)b * S * 128;
  LAS int* nselp = (LAS int*)(lds + A_NSEL);
  TS_ACC_BEGIN();
  if (!is_meta && j >= 16) {
    for (int rep_ = 0; rep_ <= PROBE_REP_SCORE; ++rep_) {
      bf16x8 qH[4][2], qL[4][2];
      const bf16_t* qh = p.qiH + (r0 + fr) * 256 + g * 8; const bf16_t* ql = p.qiL + (r0 + fr) * 256 + g * 8;
#pragma unroll
      for (int h = 0; h < 4; ++h)
#pragma unroll
        for (int ks = 0; ks < 2; ++ks) { qH[h][ks] = *(const bf16x8*)(qh + h * 64 + ks * 32); qL[h][ks] = IDX_SPLIT ? *(const bf16x8*)(ql + h * 64 + ks * 32) : qH[h][ks]; }
      const f32x4 w = *(const f32x4*)(p.wi + (r0 + fr) * 4);
      const int tq = t0 + fr;
      LAS unsigned* h1 = (LAS unsigned*)(lds + A_HIST) + fr * 257;
      const bf16_t* kbh = p.kiH + (size_t)b * S * 64 + lane * 8; const bf16_t* kbl = p.kiL + (size_t)b * S * 64 + lane * 8;
      bf16x8 nH[2], nL[2], mH[2], mL[2];
      if (wid <= j) {
#pragma unroll
        for (int ks = 0; ks < 2; ++ks) { nH[ks] = *(const bf16x8*)(kbh + (size_t)wid * 1024 + ks * 512); nL[ks] = IDX_SPLIT ? *(const bf16x8*)(kbl + (size_t)wid * 1024 + ks * 512) : nH[ks]; }
      }
      if (wid + 8 <= j) {
#pragma unroll
        for (int ks = 0; ks < 2; ++ks) { mH[ks] = *(const bf16x8*)(kbh + (size_t)(wid + 8) * 1024 + ks * 512); mL[ks] = IDX_SPLIT ? *(const bf16x8*)(kbl + (size_t)(wid + 8) * 1024 + ks * 512) : mH[ks]; }
      }
      for (int kt = wid; kt <= j; kt += 8) {
        bf16x8 kH[2], kL[2];
#pragma unroll
        for (int ks = 0; ks < 2; ++ks) { kH[ks] = nH[ks]; kL[ks] = nL[ks]; nH[ks] = mH[ks]; nL[ks] = mL[ks]; }
        if (kt + 16 <= j) {
#pragma unroll
          for (int ks = 0; ks < 2; ++ks) { mH[ks] = *(const bf16x8*)(kbh + (size_t)(kt + 16) * 1024 + ks * 512); mL[ks] = IDX_SPLIT ? *(const bf16x8*)(kbl + (size_t)(kt + 16) * 1024 + ks * 512) : mH[ks]; }
        }
        f32x4 sc = (f32x4){0.f, 0.f, 0.f, 0.f};
#pragma unroll
        for (int h = 0; h < 4; ++h) {
          f32x4 a = (f32x4){0.f, 0.f, 0.f, 0.f};
#pragma unroll
          for (int ks = 0; ks < 2; ++ks) { if (!(ABL_SCORE == 2 && rep_ < PROBE_REP_SCORE)) a = mfma16(kH[ks], qH[h][ks], a); if (IDX_SPLIT && !(ABL_SCORE >= 1 && rep_ < PROBE_REP_SCORE)) { a = mfma16(kL[ks], qH[h][ks], a); a = mfma16(kH[ks], qL[h][ks], a); } }
#pragma unroll
          for (int i = 0; i < 4; ++i) sc[i] = fmaf(w[h], fmaxf(a[i], 0.f), sc[i]);
        }
        u16x4 kk;
#pragma unroll
        for (int i = 0; i < 4; ++i) { const int s = kt * 16 + 4 * g + i; const unsigned k16 = f2key(sc[i]) >> 16; const bool ok = s <= tq; kk[i] = ok ? (unsigned short)k16 : (unsigned short)0;
          if (rep_ == PROBE_REP_SCORE && ok) __hip_atomic_fetch_add(h1 + (k16 >> 8), 1u, __ATOMIC_RELAXED, __HIP_MEMORY_SCOPE_WORKGROUP); }
        *(LAS u16x4*)(lds + A_BIG + fr * K16_STRIDE + (kt * 16 + 4 * g) * 2) = kk;
      }
    }
    TS_ACC(32);
    __syncthreads();
    TS_ACC(33);
    const int nkeys = 16 * (j + 1);
    LAS unsigned short* cand = (LAS unsigned short*)(lds + A_CAND + wid * 128);
    for (int rep_ = 0; rep_ <= PROBE_REP_SELECT; ++rep_)
    for (int qq = 0; qq < 2; ++qq) {
      const int qi = wid + 8 * qq;
      const LAS unsigned char* Kq = lds + A_BIG + qi * K16_STRIDE;
      LAS unsigned short* sel = (LAS unsigned short*)(lds + A_SEL + qi * 512);
      const int nit = (nkeys + 511) >> 9;
      const size_t qrow = r0 + qi;
      const u32x2 hq = *(const u32x2*)(p.qiH + qrow * 256 + lane * 4); const u32x2 lq = *(const u32x2*)(p.qiL + qrow * 256 + lane * 4);
      const f32x4 wq = *(const f32x4*)(p.wi + qrow * 4);
      LAS unsigned* hist = (LAS unsigned*)(lds + A_HIST) + qi * 257;
      unsigned c4[4];
#pragma unroll
      for (int i = 0; i < 4; ++i) c4[i] = hist[255 - 4 * lane - i];
      unsigned B1, above1; wave_find_bin(c4, (unsigned)TOPK, lane, B1, above1);
      wave_lds_sync();
      TS_ACC(48);
      u16x8 kr[8];
#pragma unroll
      for (int it = 0; it < 8; ++it) { const int base = (it * 64 + lane) * 8; kr[it] = (u16x8){0, 0, 0, 0, 0, 0, 0, 0}; if (it < nit && base < nkeys) kr[it] = *(const LAS u16x8*)(Kq + base * 2); }
#pragma unroll
      for (int i = 0; i < 4; ++i) hist[lane * 4 + i] = 0u;
      wave_lds_sync();
#pragma unroll
      for (int it = 0; it < 8; ++it) if (it < nit) {
#pragma unroll
        for (int e = 0; e < 8; ++e) if ((unsigned)(kr[it][e] >> 8) == B1) __hip_atomic_fetch_add(hist + (kr[it][e] & 255), 1u, __ATOMIC_RELAXED, __HIP_MEMORY_SCOPE_WORKGROUP);
      }
      wave_lds_sync();
#pragma unroll
      for (int i = 0; i < 4; ++i) c4[i] = hist[255 - 4 * lane - i];
      unsigned B2, above2; wave_find_bin(c4, (unsigned)TOPK - above1, lane, B2, above2);
      const unsigned T16 = (B1 << 8) | B2; const unsigned ngt = above1 + above2; const unsigned need = (unsigned)TOPK - ngt;
      TS_ACC(49);
      unsigned cg = 0, ce = 0;
#pragma unroll
      for (int it = 0; it < 8; ++it) if (it < nit) {
#pragma unroll
        for (int e = 0; e < 8; ++e) { cg += (unsigned)kr[it][e] > T16 ? 1u : 0u; ce += (unsigned)kr[it][e] == T16 ? 1u : 0u; }
      }
      const unsigned ig = wave_incl_scan(cg), ie = wave_incl_scan(ce);
      unsigned og = ig - cg, oe = ie - ce;
      const unsigned pos_eq = (unsigned)__builtin_amdgcn_readlane((int)ie, 63);
      TS_ACC(50);
      const bool slowpath = (T16 == 0x8000u || pos_eq > 64u);
#pragma unroll
      for (int it = 0; it < 8; ++it) if (it < nit) {
        const int base = (it * 64 + lane) * 8;
#pragma unroll
        for (int e = 0; e < 8; ++e) if ((unsigned)kr[it][e] == T16) { if (oe < 64u) cand[oe] = (unsigned short)(base + e); ++oe; }
      }
      wave_lds_sync();
      const int c = slowpath ? 0 : (int)pos_eq;
      const int myidx = lane < c ? (int)cand[lane] : 0;
      u32x4 hkA[8], lkA[8];
      if (!slowpath) {
        const size_t krow = (size_t)b * S + myidx;
#pragma unroll
        for (int dc = 0; dc < 8; ++dc) { hkA[dc] = *(const u32x4*)(p.kiH + kfrag(krow, dc * 8)); lkA[dc] = *(const u32x4*)(p.kiL + kfrag(krow, dc * 8)); }
      }
#pragma unroll
      for (int it = 0; it < 8; ++it) if (it < nit) {
        const int base = (it * 64 + lane) * 8;
#pragma unroll
        for (int e = 0; e < 8; ++e) if ((unsigned)kr[it][e] > T16) { sel[og] = (unsigned short)(base + e); ++og; }
      }
      wave_lds_sync();
      TS_ACC(51);
      if (slowpath) {
        unsigned taken = 0;
        for (int s0 = 0; s0 < nkeys && taken < need; s0 += 64) {
          const int s = s0 + lane; const bool eq = s < nkeys && (unsigned)(*(const LAS unsigned short*)(Kq + s * 2)) == T16;
          const unsigned long long me = __ballot(eq);
          const unsigned o = taken + __builtin_amdgcn_mbcnt_hi((unsigned)(me >> 32), __builtin_amdgcn_mbcnt_lo((unsigned)me, 0u));
          if (eq && o < need) sel[ngt + o] = (unsigned short)s;
          taken += (unsigned)__popcll(me);
        }
      } else {
        float qv[4];
        qv[0] = __uint_as_float(hq.x << 16) + __uint_as_float(lq.x << 16); qv[1] = __uint_as_float(hq.x & 0xffff0000u) + __uint_as_float(lq.x & 0xffff0000u);
        qv[2] = __uint_as_float(hq.y << 16) + __uint_as_float(lq.y << 16); qv[3] = __uint_as_float(hq.y & 0xffff0000u) + __uint_as_float(lq.y & 0xffff0000u);
        const f32x4 w = wq;
        float d4[4] = {0.f, 0.f, 0.f, 0.f};
#pragma unroll
        for (int dc = 0; dc < 8; ++dc) {
          const u32x4 hk = hkA[dc], lk = lkA[dc];
          float kv[8];
          kv[0] = __uint_as_float(hk.x << 16) + __uint_as_float(lk.x << 16); kv[1] = __uint_as_float(hk.x & 0xffff0000u) + __uint_as_float(lk.x & 0xffff0000u);
          kv[2] = __uint_as_float(hk.y << 16) + __uint_as_float(lk.y << 16); kv[3] = __uint_as_float(hk.y & 0xffff0000u) + __uint_as_float(lk.y & 0xffff0000u);
          kv[4] = __uint_as_float(hk.z << 16) + __uint_as_float(lk.z << 16); kv[5] = __uint_as_float(hk.z & 0xffff0000u) + __uint_as_float(lk.z & 0xffff0000u);
          kv[6] = __uint_as_float(hk.w << 16) + __uint_as_float(lk.w << 16); kv[7] = __uint_as_float(hk.w & 0xffff0000u) + __uint_as_float(lk.w & 0xffff0000u);
#pragma unroll
          for (int h = 0; h < 4; ++h)
#pragma unroll
            for (int dd = 0; dd < 8; ++dd) {
              const int srcl = h * 16 + dc * 2 + (dd >> 2);
              const float qs = __uint_as_float(__builtin_amdgcn_readlane(__float_as_uint(qv[dd & 3]), srcl));
              d4[h] = fmaf(qs, kv[dd], d4[h]);
            }
        }
        float sc = 0.f;
#pragma unroll
        for (int h = 0; h < 4; ++h) sc = fmaf(w[h], fmaxf(d4[h], 0.f), sc);
        int rank = 0;
        for (int jj = 0; jj < c; ++jj) {
          const float sj = __uint_as_float(__builtin_amdgcn_readlane(__float_as_uint(sc), jj)); const int ij = __builtin_amdgcn_readlane(myidx, jj);
          rank += (sj > sc || (sj == sc && ij < myidx)) ? 1 : 0;
        }
        if (lane < c && (unsigned)rank < need) sel[ngt + rank] = (unsigned short)myidx;
      }
      TS_ACC(52);
      if (rep_ == PROBE_REP_SELECT) {
#pragma unroll
        for (int i = 0; i < 4; ++i) hist[lane * 4 + i] = 0u;
      }
      if (lane == 0) nselp[qi] = TOPK;
      wave_lds_sync();
    }
  } else if (!is_meta) {
    for (int i = tid; i < 16 * 256; i += NTHREADS) { const int qi = i >> 8, s = i & 255; ((LAS unsigned short*)(lds + A_SEL))[i] = (unsigned short)(s <= t0 + qi ? s : 0); }
    if (tid < 16) nselp[tid] = t0 + tid + 1;
  } else {
    if (tid < 16) nselp[tid] = 0;
  }
  TS_ACC(34);
  __syncthreads();
  TS_ACC(35);
  {
    const bf16_t* qa = (is_meta ? p.qam : p.qa) + (r0 + fr) * 512 + wid * 64 + g * 8;
    bf16x8 bq[2];
#pragma unroll
    for (int ks = 0; ks < 2; ++ks) bq[ks] = *(const bf16x8*)(qa + ks * 32);
    const bf16_t* wk = wukT + ((size_t)wid * 128 + fr) * 64 + g * 8;
#pragma unroll
    for (int mt = 0; mt < 8; ++mt) {
      f32x4 a = (f32x4){0.f, 0.f, 0.f, 0.f};
#pragma unroll
      for (int ks = 0; ks < 2; ++ks) a = mfma16(*(const bf16x8*)(wk + (size_t)mt * 16 * 64 + ks * 32), bq[ks], a);
      u32x2 w2; w2.x = pack_bf16(a[0], a[1]); w2.y = pack_bf16(a[2], a[3]);
      *(LAS u32x2*)(lds + A_BIG + ((fr * 8 + wid) * 128 + mt * 16 + 4 * g) * 2) = w2;
    }
  }
  __syncthreads();
  bf16x8 qf_[2][4];
#pragma unroll
  for (int qq = 0; qq < 2; ++qq)
#pragma unroll
    for (int ks = 0; ks < 4; ++ks) {
      const bf16x8 v = *(const LAS bf16x8*)(lds + A_BIG + (((wid + 8 * qq) * 8 + (fr & 7)) * 128 + ks * 32 + g * 8) * 2);
      qf_[qq][ks] = fr < 8 ? v : (bf16x8){0, 0, 0, 0, 0, 0, 0, 0};
    }
  __syncthreads();
  TS_ACC(36);
  const LAS float* rb = (const LAS float*)(lds + A_RB);
  const LAS unsigned char* bkt = lds + A_BKT;
  f32x4 O[2][8];
  float linv[2];
  LAS unsigned char* gbuf = lds + A_BIG + wid * 16384;
  const unsigned gbase_u = (unsigned)__builtin_amdgcn_readfirstlane((int)(unsigned)(size_t)gbuf);
  const unsigned gq = (lane & 15) >> 2, gp = lane & 3;
  for (int rep_ = 0; rep_ <= PROBE_REP_ATT; ++rep_)
#pragma unroll
  for (int qq = 0; qq < 2; ++qq) {
    const int qi = wid + 8 * qq; const int nsel = nselp[qi];
    const int epos = is_meta ? qi : NM + t0 + qi;
    const LAS unsigned short* sel = (const LAS unsigned short*)(lds + A_SEL + qi * 512);
#pragma unroll
    for (int ct = 0; ct < 8; ++ct) O[qq][ct] = (f32x4){0.f, 0.f, 0.f, 0.f};
    float mrun = -INFINITY, lrun = 0.f;
    const int nch = (nsel + 31) >> 5;
#define ISSUE_GATHER(ch_) do { const unsigned dst_ = gbase_u + (unsigned)(((ch_) & 1) * 8192); \
      int idxs_[8]; \
      _Pragma("unroll") for (int i_ = 0; i_ < 8; ++i_) { const int si_ = (ch_) * 32 + 4 * i_ + g; const int v_ = (int)sel[si_ < 255 ? si_ : 255]; idxs_[i_] = si_ < nsel ? v_ : 0; } \
      asm volatile("s_waitcnt lgkmcnt(0)" ::: "memory"); \
      _Pragma("unroll") for (int i_ = 0; i_ < 8; ++i_) { \
        const int row_ = 4 * i_ + g; const unsigned f_ = (((unsigned)row_ & 3u) << 2) | (((unsigned)row_ >> 2) & 3u); \
        const bf16_t* src_ = cNb + (size_t)idxs_[i_] * 128 + (((unsigned)fr ^ f_) * 8); \
        glds16_asm(src_, dst_ + (unsigned)(i_ * 1024)); } } while (0)
    if (nch > 0) ISSUE_GATHER(0);
    if (nch > 1) ISSUE_GATHER(1);
    {
      f32x4 s0 = (f32x4){0.f, 0.f, 0.f, 0.f};
#pragma unroll
      for (int ks = 0; ks < 4; ++ks) s0 = mfma16(*(const LAS bf16x8*)(lds + A_CM + off_b(fr, 4 * ks + g)), qf_[qq][ks], s0);
      float lg[4]; float mx = -INFINITY;
#pragma unroll
      for (int i = 0; i < 4; ++i) { const int m = 4 * g + i; const int dist = epos - m; const bool valid = !is_meta || m <= qi;
        const int dcl = dist < 0 ? 0 : (dist > 127 ? 127 : dist); const int bkv = (int)bkt[dcl]; const int bk = dist >= 128 ? 31 : bkv;
        const float bias = rb[bk * 8 + (fr & 7)]; const float lv = s0[i] * 0.125f + bias;
        lg[i] = valid ? lv : -INFINITY; mx = fmaxf(mx, lg[i]); }
      mx = rows_max(mx);
      mrun = mx; float ps = 0.f; float pv[4];
#pragma unroll
      for (int i = 0; i < 4; ++i) { pv[i] = __expf(lg[i] - mrun); ps += pv[i]; }
      ps = rows_sum(ps); lrun = ps;
      bf16x8 pf; { const unsigned a0 = pack_bf16(pv[0], pv[1]), a1 = pack_bf16(pv[2], pv[3]); u32x4 t; t.x = a0; t.y = a1; t.z = 0u; t.w = 0u; pf = __builtin_bit_cast(bf16x8, t); }
      {
        s16x4 tm[8];
#pragma unroll
        for (int ct = 0; ct < 8; ++ct) tm[ct] = lds_tr(lds + A_CM + off_b(4 * g + gq, 2 * ct + (gp >> 1)) + 8 * (gp & 1));
        const s16x4 z4 = (s16x4){0, 0, 0, 0};
#pragma unroll
        for (int ct = 0; ct < 8; ++ct) O[qq][ct] = mfma16(cat4(tm[ct], z4), pf, O[qq][ct]);
      }
    }
    for (int ch = 0; ch < nch; ++ch) {
      if (ch + 1 < nch) asm volatile("s_waitcnt vmcnt(8)" ::: "memory"); else asm volatile("s_waitcnt vmcnt(0)" ::: "memory");
      const LAS unsigned char* buf = gbuf + (ch & 1) * 8192;
      f32x4 sA = (f32x4){0.f, 0.f, 0.f, 0.f}, sB = (f32x4){0.f, 0.f, 0.f, 0.f};
#pragma unroll
      for (int ks = 0; ks < 4; ++ks) {
        sA = mfma16(*(const LAS bf16x8*)(buf + off_b(fr, 4 * ks + g)), qf_[qq][ks], sA);
        sB = mfma16(*(const LAS bf16x8*)(buf + off_b(fr + 16, 4 * ks + g)), qf_[qq][ks], sB);
      }
      const u16x4 iA = *(const LAS u16x4*)(sel + ch * 32 + 4 * g); const u16x4 iB = *(const LAS u16x4*)(sel + ch * 32 + 16 + 4 * g);
      float lg[8]; float mx = -INFINITY;
#pragma unroll
      for (int i = 0; i < 8; ++i) {
        const int slot = ch * 32 + (i < 4 ? 4 * g + i : 16 + 4 * g + (i - 4)); const int kidx = i < 4 ? (int)iA[i] : (int)iB[i - 4];
        const int dist = t0 + qi - kidx; const int dcl = dist < 0 ? 0 : (dist > 127 ? 127 : dist); const int bkv = (int)bkt[dcl]; const int bk = dist >= 128 ? 31 : bkv;
        const float sv = i < 4 ? sA[i] : sB[i - 4];
        const float bias = rb[bk * 8 + (fr & 7)]; const float lv = sv * 0.125f + bias;
        lg[i] = slot < nsel ? lv : -INFINITY; mx = fmaxf(mx, lg[i]);
      }
      mx = rows_max(mx);
      const float mnew = fmaxf(mrun, mx); const float alpha = __expf(mrun - mnew); mrun = mnew;
      float pv[8]; float ps = 0.f;
#pragma unroll
      for (int i = 0; i < 8; ++i) { pv[i] = __expf(lg[i] - mnew); ps += pv[i]; }
      ps = rows_sum(ps); lrun = lrun * alpha + ps;
#pragma unroll
      for (int ct = 0; ct < 8; ++ct) O[qq][ct] *= alpha;
      bf16x8 pf; { u32x4 t; t.x = pack_bf16(pv[0], pv[1]); t.y = pack_bf16(pv[2], pv[3]); t.z = pack_bf16(pv[4], pv[5]); t.w = pack_bf16(pv[6], pv[7]); pf = __builtin_bit_cast(bf16x8, t); }
      {
        s16x4 ta[8], tb[8];
#pragma unroll
        for (int ct = 0; ct < 8; ++ct) { ta[ct] = lds_tr(buf + off_b(4 * g + gq, 2 * ct + (gp >> 1)) + 8 * (gp & 1)); tb[ct] = lds_tr(buf + off_b(16 + 4 * g + gq, 2 * ct + (gp >> 1)) + 8 * (gp & 1)); }
#pragma unroll
        for (int ct = 0; ct < 8; ++ct) O[qq][ct] = mfma16(cat4(ta[ct], tb[ct]), pf, O[qq][ct]);
      }
      if (ch + 2 < nch) ISSUE_GATHER(ch + 2);
    }
    linv[qq] = 1.0f / lrun;
  }
  TS_ACC(37);
  asm volatile("s_waitcnt vmcnt(0) lgkmcnt(0)" ::: "memory");
#pragma unroll
  for (int qq = 0; qq < 2; ++qq)
    if (fr < 8) {
#pragma unroll
      for (int ct = 0; ct < 8; ++ct) { const f32x4 o = O[qq][ct] * linv[qq]; u32x2 w2; w2.x = pack_bf16(o[0], o[1]); w2.y = pack_bf16(o[2], o[3]);
        *(LAS u32x2*)(gbuf + qq * 2048 + (fr * 128 + ct * 16 + 4 * g) * 2) = w2; }
    }
  __syncthreads();
  TS_ACC(38);
  {
    bf16x8 bo[4];
#pragma unroll
    for (int ks = 0; ks < 4; ++ks) bo[ks] = *(const LAS bf16x8*)(lds + A_BIG + (fr & 7) * 16384 + (fr >> 3) * 2048 + (wid * 128 + ks * 32 + g * 8) * 2);
    const bf16_t* wv = wuvT + ((size_t)wid * 64 + fr) * 128 + g * 8;
    bf16_t* grow = (is_meta ? p.gatesm : p.gates) + (r0 + fr) * 1024 + wid * 64 + 4 * g;
#pragma unroll
    for (int nt = 0; nt < 4; ++nt) {
      f32x4 a = (f32x4){0.f, 0.f, 0.f, 0.f};
#pragma unroll
      for (int ks = 0; ks < 4; ++ks) a = mfma16(*(const bf16x8*)(wv + (size_t)nt * 16 * 128 + ks * 32), bo[ks], a);
      const u32x2 gt = *(const u32x2*)(grow + nt * 16);
      const float g0 = __uint_as_float(gt.x << 16), g1 = __uint_as_float(gt.x & 0xffff0000u), g2 = __uint_as_float(gt.y << 16), g3 = __uint_as_float(gt.y & 0xffff0000u);
      u32x2 w2; w2.x = pack_bf16(a[0] * g0, a[1] * g1); w2.y = pack_bf16(a[2] * g2, a[3] * g3);
      *(u32x2*)((dry ? p.dummy + (r0 + fr) * 1024 + wid * 64 + 4 * g : grow) + nt * 16) = w2;
    }
  }
  __syncthreads();
  TS_ACC(39);
}

__device__ __forceinline__ void phase_attn(const Params& p, int layer, LAS unsigned char* lds, int ablk, int nablk, bool do_meta, const bool dry = false) {
  int tid_ = threadIdx.x; asm volatile("" : "+v"(tid_));
  const int tid = tid_;
  if (tid < 256) { const int row = tid >> 4, ch = tid & 15; *(LAS u32x4*)(lds + A_CM + off_b(row, ch)) = *(const u32x4*)(p.cNm + row * 128 + ch * 8); }
  if (tid < 256) ((LAS float*)(lds + A_RB))[tid] = p.rel_bias[tid];
  if (tid < 128) (lds + A_BKT)[tid] = c_bucket[tid];
  for (int i = tid; i < 16 * 257; i += NTHREADS) ((LAS unsigned*)(lds + A_HIST))[i] = 0u;
  __syncthreads();
  const bf16_t* wukT = p.wukT + (size_t)layer * 8 * 128 * 64; const bf16_t* wuvT = p.wuvT + (size_t)layer * 8 * 64 * 128;
  if ((nablk & 7) == 0 && (gridDim.x & 7) == 0) {
    const int xb = blockIdx.x & 7, nper = nablk >> 3, rank = ablk >> 3;
    for (int k = 0;; ++k) {
      const int idx = k * nper + ((k & 1) ? nper - 1 - rank : rank);
      if (idx >= 256) break;
      attn_tile(p, layer, lds, false, xb, 255 - idx, wukT, wuvT, dry);
    }
  } else {
    for (int item = ablk; item < NB * 256; item += nablk) {
      const int j = 255 - item / NB, b = item % NB;
      attn_tile(p, layer, lds, false, b, j, wukT, wuvT, dry);
    }
  }
  if (do_meta && !dry && ablk == nablk - 1) attn_tile(p, layer, lds, true, 0, 0, wukT, wuvT);
}

constexpr int H_QT = 0, H_KH = 8192, H_KT = 16384, H_VV = 24576, H_DEC = 32768, H_PART = 32768 + 512;

__device__ __forceinline__ void phase_hgrn(const Params& p, const int layer, LAS unsigned char* lds, const int hblk, const bool dry = false) {
  int tid_ = threadIdx.x; asm volatile("" : "+v"(tid_));
  const int tid = tid_, wid = __builtin_amdgcn_readfirstlane(tid >> 6), lane = tid & 63, fr = lane & 15, g = lane >> 4;
  const int b = hblk >> 2, h = hblk & 3;
  const unsigned gq = (lane & 15) >> 2, gp = lane & 3;
  f32x4 Sacc[8];
#pragma unroll
  for (int kt = 0; kt < 8; ++kt) Sacc[kt] = (f32x4){0.f, 0.f, 0.f, 0.f};
  const float gn = p.hng[layer * 128 + wid * 16 + fr];
  const int sk = wid * 16 + (lane & 15), stg = lane >> 4;
  const int vrow = tid >> 4, vch = tid & 15;
  const int otok[2] = {4 * g, 16 + 4 * g};
  float n_gv[8]; unsigned short n_q[8]; u32x4 n_v; unsigned short n_gate[8];
  {
#pragma unroll
    for (int i = 0; i < 8; ++i) {
      const int t = 8 * stg + i;
      n_gv[i] = t < NM ? p.glm[(size_t)t * 512 + h * 128 + sk] : 0.f;
      n_q[i] = t < NM ? p.qfm[(size_t)t * 512 + h * 128 + sk] : (unsigned short)0;
    }
    n_v = vrow < NM ? *(const u32x4*)(p.vvm + (size_t)vrow * 512 + h * 128 + vch * 8) : (u32x4){0u, 0u, 0u, 0u};
#pragma unroll
    for (int mt = 0; mt < 2; ++mt)
#pragma unroll
      for (int i = 0; i < 4; ++i) { const int t = otok[mt] + i; n_gate[mt * 4 + i] = t < NM ? p.gatesm[(size_t)t * 1024 + 512 + h * 128 + wid * 16 + fr] : (unsigned short)0; }
  }
  for (int step = 0; step <= S / 32; ++step) {
    const bool im = step == 0;
    const size_t rbase = im ? 0 : (size_t)b * S + (size_t)(step - 1) * 32;
    bf16_t* gt = (im ? p.gatesm : p.gates) + rbase * 1024 + 512 + h * 128;
    TS_ACC_BEGIN();
    float gv[8], qv[8];
#pragma unroll
    for (int i = 0; i < 8; ++i) { gv[i] = n_gv[i]; qv[i] = bf2f(n_q[i]); }
    const u32x4 vraw = n_v;
    float gate[8];
#pragma unroll
    for (int i = 0; i < 8; ++i) gate[i] = bf2f(n_gate[i]);
    if (step < S / 32) {
      const size_t rn = (size_t)b * S + (size_t)step * 32;
#pragma unroll
      for (int i = 0; i < 8; ++i) { n_gv[i] = p.gl[(rn + 8 * stg + i) * 512 + h * 128 + sk]; n_q[i] = p.qf[(rn + 8 * stg + i) * 512 + h * 128 + sk]; }
      n_v = *(const u32x4*)(p.vv + (rn + vrow) * 512 + h * 128 + vch * 8);
#pragma unroll
      for (int mt = 0; mt < 2; ++mt)
#pragma unroll
        for (int i = 0; i < 4; ++i) n_gate[mt * 4 + i] = p.gates[(rn + otok[mt] + i) * 1024 + 512 + h * 128 + wid * 16 + fr];
    }
    {
      float bc[8]; bc[0] = gv[0];
#pragma unroll
      for (int i = 1; i < 8; ++i) bc[i] = bc[i - 1] + gv[i];
      float x = bc[7];
      { const float u = __shfl_up(x, 16); if (lane >= 16) x += u; }
      { const float u = __shfl_up(x, 32); if (lane >= 32) x += u; }
      const float ex = x - bc[7];
      const float bl = __shfl(x, 48 + (lane & 15));
#pragma unroll
      for (int i = 0; i < 8; ++i) {
        const float bci = bc[i] + ex;
        const float kc = 1.0f - __expf(gv[i]);
        const float qt = qv[i] * __expf(bci), khv = kc * __expf(fminf(-bci, 80.f)), ktv = kc * __expf(bl - bci);
        const unsigned o1 = off_b(8 * stg + i, sk >> 3) + (sk & 7) * 2;
        *(LAS unsigned short*)(lds + H_QT + o1) = f2bf_fast(qt); *(LAS unsigned short*)(lds + H_KH + o1) = f2bf_fast(khv); *(LAS unsigned short*)(lds + H_KT + o1) = f2bf_fast(ktv);
      }
      if (stg == 3) *(LAS float*)(lds + H_DEC + sk * 4) = __expf(bl);
      *(LAS u32x4*)(lds + H_VV + off_b(vrow, vch)) = vraw;
    }
    TS_ACC(40);
    __syncthreads();
    TS_ACC(41);
    f32x4 o[2] = {(f32x4){0.f, 0.f, 0.f, 0.f}, (f32x4){0.f, 0.f, 0.f, 0.f}};
    {
      f32x4 s00 = (f32x4){0.f, 0.f, 0.f, 0.f}, s01 = s00, s11 = s00;
      {
        bf16x8 aK0[4], aK1[4], aQ0[4], aQ1[4];
#pragma unroll
        for (int ks = 0; ks < 4; ++ks) {
          aK0[ks] = *(const LAS bf16x8*)(lds + H_KH + off_b(fr, 4 * ks + g)); aK1[ks] = *(const LAS bf16x8*)(lds + H_KH + off_b(16 + fr, 4 * ks + g));
          aQ0[ks] = *(const LAS bf16x8*)(lds + H_QT + off_b(fr, 4 * ks + g)); aQ1[ks] = *(const LAS bf16x8*)(lds + H_QT + off_b(16 + fr, 4 * ks + g));
        }
#pragma unroll
        for (int ks = 0; ks < 4; ++ks) { s00 = mfma16(aK0[ks], aQ0[ks], s00); s01 = mfma16(aK0[ks], aQ1[ks], s01); s11 = mfma16(aK1[ks], aQ1[ks], s11); }
      }
#pragma unroll
      for (int ks = 0; ks < 4; ++ks) {
        u32x4 bv; bv.x = pack_bf16(Sacc[2 * ks][0], Sacc[2 * ks][1]); bv.y = pack_bf16(Sacc[2 * ks][2], Sacc[2 * ks][3]);
        bv.z = pack_bf16(Sacc[2 * ks + 1][0], Sacc[2 * ks + 1][1]); bv.w = pack_bf16(Sacc[2 * ks + 1][2], Sacc[2 * ks + 1][3]);
#pragma unroll
        for (int mt = 0; mt < 2; ++mt) {
          const u32x2 a0 = *(const LAS u32x2*)(lds + H_QT + off_b(16 * mt + fr, 4 * ks + (g >> 1)) + (g & 1) * 8);
          const u32x2 a1 = *(const LAS u32x2*)(lds + H_QT + off_b(16 * mt + fr, 4 * ks + 2 + (g >> 1)) + (g & 1) * 8);
          u32x4 av; av.x = a0.x; av.y = a0.y; av.z = a1.x; av.w = a1.y;
          o[mt] = mfma16(__builtin_bit_cast(bf16x8, av), __builtin_bit_cast(bf16x8, bv), o[mt]);
        }
      }
      const s16x4 vt0 = lds_tr(lds + H_VV + off_b(4 * g + gq, 2 * wid + (gp >> 1)) + 8 * (gp & 1));
      const s16x4 vt1 = lds_tr(lds + H_VV + off_b(16 + 4 * g + gq, 2 * wid + (gp >> 1)) + 8 * (gp & 1));
      const bf16x8 bfv = cat4(vt0, vt1);
      {
        float m0[4], m1[4];
#pragma unroll
        for (int i = 0; i < 4; ++i) { const bool keep = (4 * g + i) <= fr; m0[i] = keep ? s00[i] : 0.f; m1[i] = keep ? s11[i] : 0.f; }
        u32x4 a0; a0.x = pack_bf16(m0[0], m0[1]); a0.y = pack_bf16(m0[2], m0[3]); a0.z = 0u; a0.w = 0u;
        u32x4 a1; a1.x = pack_bf16(s01[0], s01[1]); a1.y = pack_bf16(s01[2], s01[3]); a1.z = pack_bf16(m1[0], m1[1]); a1.w = pack_bf16(m1[2], m1[3]);
        o[0] = mfma16(__builtin_bit_cast(bf16x8, a0), bfv, o[0]);
        o[1] = mfma16(__builtin_bit_cast(bf16x8, a1), bfv, o[1]);
      }
#pragma unroll
      for (int kt = 0; kt < 8; ++kt) {
        const s16x4 k0 = lds_tr(lds + H_KT + off_b(4 * g + gq, 2 * kt + (gp >> 1)) + 8 * (gp & 1));
        const s16x4 k1 = lds_tr(lds + H_KT + off_b(16 + 4 * g + gq, 2 * kt + (gp >> 1)) + 8 * (gp & 1));
        const f32x4 dv = *(const LAS f32x4*)(lds + H_DEC + (16 * kt + 4 * g) * 4);
        Sacc[kt] = mfma16(cat4(k0, k1), bfv, Sacc[kt] * dv);
      }
    }
    {
#pragma unroll
      for (int mt = 0; mt < 2; ++mt) {
        f32x4 sq = o[mt] * o[mt];
#pragma unroll
        for (int i = 0; i < 4; ++i) sq[i] = row_sum16(sq[i]);
        if (fr == 0) *(LAS f32x4*)(lds + H_PART + (wid * 32 + otok[mt]) * 4) = sq;
      }
    }
    TS_ACC(42);
    __syncthreads();
    TS_ACC(43);
    if (!im || (b == 0 && layer == 0)) {
      f32x4 pr[2][8];
#pragma unroll
      for (int mt = 0; mt < 2; ++mt)
#pragma unroll
        for (int w = 0; w < 8; ++w) pr[mt][w] = *(const LAS f32x4*)(lds + H_PART + (w * 32 + otok[mt]) * 4);
#pragma unroll
      for (int mt = 0; mt < 2; ++mt) {
        const f32x4 tot = ((pr[mt][0] + pr[mt][1]) + (pr[mt][2] + pr[mt][3])) + ((pr[mt][4] + pr[mt][5]) + (pr[mt][6] + pr[mt][7]));
#pragma unroll
        for (int i = 0; i < 4; ++i) {
          const int t = otok[mt] + i;
          if (!im || t < NM) {
            const float rstd = rsqrtf(tot[i] * (1.0f / 128.0f) + EPS);
            (dry ? p.dummy + rbase * 1024 + 512 + h * 128 : gt)[(size_t)t * 1024 + wid * 16 + fr] = f2bf_fast(o[mt][i] * rstd * gn * gate[mt * 4 + i]);
          }
        }
      }
    }
    TS_ACC(44);
  }
}

enum { PH_PREP = 0, PH_P1 = 1, PH_ATTN = 2, PH_P3 = 3, PH_LN = 4, PH_HGRN = 5 };
__global__ void __launch_bounds__(NTHREADS, 2) k_fast(Params p, int phase, int layer) {
  extern __shared__ __attribute__((aligned(16))) unsigned char smem[];
  LAS unsigned char* lds = (LAS unsigned char*)smem;
  if (phase == PH_PREP) phase_prep(p, lds);
  else if (phase == PH_P1) {
    SrcP1 S{(const char*)p.hHi, (const char*)p.hLo, (const char*)(p.WmT + (size_t)layer * 3072 * 1024), (const char*)(p.WsT + (size_t)layer * 512 * 3072)};
    EpiP1 E{p, layer};
    gemm_phase<SrcP1, EpiP1>(lds, S, R / BM, 14, E);
  } else if (phase == PH_P3) {
    SrcP3 S{(const char*)p.gates, (const char*)(p.WoT + (size_t)layer * 1024 * 1024)};
    EpiP3 E{p, layer == 0 ? p.x : p.hF};
    gemm_phase<SrcP3, EpiP3>(lds, S, R / BM, 4, E);
  } else if (phase == PH_ATTN) {
    phase_attn(p, layer, lds, blockIdx.x, gridDim.x, layer == 0);
  } else if (phase == PH_HGRN) {
    if (blockIdx.x < NB * 4) phase_hgrn(p, layer, lds, blockIdx.x);
  } else if (phase == PH_LN) {
    phase_ln(p, layer, layer == 0 ? p.hF : p.out, layer == 0);
  }
}

constexpr int M_A32T = 0;
constexpr int M_PART = 65536;
template <bool A_BF16>
__device__ __forceinline__ void meta_group_gemm(LAS unsigned char* lds, const void* A, const float* W, const int ldw, const int col0) {
  int tid_ = threadIdx.x; asm volatile("" : "+v"(tid_));
  const int tid = tid_, wid = __builtin_amdgcn_readfirstlane(tid >> 6), lane = tid & 63;
  LAS float* a32 = (LAS float*)(lds + M_A32T); LAS float* part = (LAS float*)(lds + M_PART);
  for (int i = tid; i < 16 * 1024; i += NTHREADS) { const int r = i >> 10, k = i & 1023; a32[k * 16 + r] = A_BF16 ? bf2f(((const bf16_t*)A)[i]) : ((const float*)A)[i]; }
  __syncthreads();
  float acc0[16], acc1[16];
#pragma unroll
  for (int r = 0; r < 16; ++r) { acc0[r] = 0.f; acc1[r] = 0.f; }
  const float* w0p = W + (size_t)(wid * 128) * ldw + col0 + lane;
#pragma unroll 4
  for (int kk = 0; kk < 128; ++kk) {
    const float w0 = w0p[(size_t)kk * ldw], w1 = w0p[(size_t)kk * ldw + 64];
    const LAS f32x4* ar = (const LAS f32x4*)(a32 + (wid * 128 + kk) * 16);
#pragma unroll
    for (int q = 0; q < 4; ++q) { const f32x4 a = ar[q];
#pragma unroll
      for (int j = 0; j < 4; ++j) { acc0[q * 4 + j] = fmaf(a[j], w0, acc0[q * 4 + j]); acc1[q * 4 + j] = fmaf(a[j], w1, acc1[q * 4 + j]); } }
  }
#pragma unroll
  for (int r = 0; r < 16; ++r) { part[(wid * 16 + r) * 128 + lane] = acc0[r]; part[(wid * 16 + r) * 128 + 64 + lane] = acc1[r]; }
  __syncthreads();
  for (int i = tid; i < 2048; i += NTHREADS) { float s = 0.f;
#pragma unroll
    for (int w = 0; w < 8; ++w) s += part[w * 2048 + i]; part[i] = s; }
  __syncthreads();
}


template <bool A_F32, bool SPLIT>
__device__ __forceinline__ void meta_group_mfma(LAS unsigned char* lds, const void* A, const bf16_t* Wt, const int ldw) {
  int tid_ = threadIdx.x; asm volatile("" : "+v"(tid_));
  const int tid = tid_, wid = __builtin_amdgcn_readfirstlane(tid >> 6), lane = tid & 63, fr = lane & 15, g = lane >> 4;
  LAS float* out = (LAS float*)(lds + M_PART);
  const bf16_t* wrow = Wt + (size_t)(wid * 16 + fr) * ldw + g * 8;
  f32x4 acc = (f32x4){0.f, 0.f, 0.f, 0.f};
#pragma unroll 4
  for (int ks = 0; ks < 32; ++ks) {
    bf16x8 ah, al;
    if (A_F32) {
      const f32x4 v0 = *(const f32x4*)((const float*)A + fr * 1024 + ks * 32 + g * 8), v1 = *(const f32x4*)((const float*)A + fr * 1024 + ks * 32 + g * 8 + 4);
      u32x4 h; h.x = pack_bf16(v0[0], v0[1]); h.y = pack_bf16(v0[2], v0[3]); h.z = pack_bf16(v1[0], v1[1]); h.w = pack_bf16(v1[2], v1[3]);
      ah = __builtin_bit_cast(bf16x8, h);
      if (SPLIT) { u32x4 l; l.x = pack_bf16(v0[0] - __uint_as_float(h.x << 16), v0[1] - __uint_as_float(h.x & 0xffff0000u)); l.y = pack_bf16(v0[2] - __uint_as_float(h.y << 16), v0[3] - __uint_as_float(h.y & 0xffff0000u));
        l.z = pack_bf16(v1[0] - __uint_as_float(h.z << 16), v1[1] - __uint_as_float(h.z & 0xffff0000u)); l.w = pack_bf16(v1[2] - __uint_as_float(h.w << 16), v1[3] - __uint_as_float(h.w & 0xffff0000u));
        al = __builtin_bit_cast(bf16x8, l); }
    } else {
      ah = *(const bf16x8*)((const bf16_t*)A + fr * 1024 + ks * 32 + g * 8);
    }
    acc = mfma16(ah, *(const bf16x8*)(wrow + ks * 32), acc);
    if (SPLIT) { acc = mfma16(al, *(const bf16x8*)(wrow + 1024 + ks * 32), acc); acc = mfma16(ah, *(const bf16x8*)(wrow + 2048 + ks * 32), acc); }
  }
#pragma unroll
  for (int i = 0; i < 4; ++i) out[(4 * g + i) * 128 + wid * 16 + fr] = acc[i];
  __syncthreads();
}

__device__ __forceinline__ void meta_inproj_group(const Params& p, const int layer, LAS unsigned char* lds, const int grp) {
  int tid_ = threadIdx.x; asm volatile("" : "+v"(tid_)); const int tid = tid_;
  const float* A = layer == 0 ? p.meta : p.hFm;
  int kind, sub;
  if (grp < 4) { kind = 0; sub = grp; } else if (grp == 4) { kind = 6; sub = 0; } else { kind = 1 + (grp - 5) / 4; sub = (grp - 5) % 4; }
  const int colbase = (kind == 0 ? O_QA : kind == 6 ? O_CKV : kind == 1 ? O_GA : kind == 2 ? O_QH : kind == 3 ? O_FH : kind == 4 ? O_IH : O_GH) + sub * 128;
  (void)colbase;
  if (kind == 6) meta_group_mfma<true, IDX_SPLIT != 0>(lds, A, p.WsT + ((size_t)layer * 512 + 256) * 3072, 3072);
  else meta_group_mfma<true, false>(lds, A, p.WmT + ((size_t)layer * 3072 + (size_t)kind * 512 + sub * 128) * 1024, 1024);
  LAS float* out = (LAS float*)(lds + M_PART);
  LAS float* rs = (LAS float*)(lds + M_PART + 2048 * 4);
  if (kind == 6) {
    if (tid < 16) { float s = 0.f; for (int c = 0; c < 128; ++c) { const float v = out[tid * 128 + c]; s = fmaf(v, v, s); } rs[tid] = rsqrtf(s * (1.0f / 128.0f) + EPS); }
    __syncthreads();
  }
  for (int i = tid; i < 2048; i += NTHREADS) {
    const int r = i >> 7, c = i & 127, cc = sub * 128 + c; const float v = out[i];
    if (kind == 0) p.qam[r * 512 + cc] = f2bf(v);
    else if (kind == 6) p.cNm[r * 128 + c] = f2bf(v * rs[r] * p.kvg[layer * 128 + c]);
    else if (kind == 1) p.gatesm[r * 1024 + cc] = f2bf(fast_silu(v));
    else if (kind == 2) p.qfm[r * 512 + cc] = f2bf(fast_silu(v) * 0.08838834764831845f);
    else if (kind == 3) { const float lb = p.lbv[layer * 512 + cc]; p.glm[r * 512 + cc] = __logf(lb + (1.0f - lb) * fast_sigmoid(v)); }
    else if (kind == 4) p.vvm[r * 512 + cc] = f2bf(v);
    else p.gatesm[r * 1024 + 512 + cc] = f2bf(fast_silu(v));
  }
  __syncthreads();
}
__device__ __forceinline__ void meta_outproj_group(const Params& p, LAS unsigned char* lds, const int grp) {
  int tid_ = threadIdx.x; asm volatile("" : "+v"(tid_)); const int tid = tid_;
  meta_group_mfma<false, false>(lds, p.gatesm, p.WoT + (size_t)grp * 128 * 1024, 1024);
  const LAS float* out = (const LAS float*)(lds + M_PART);
  for (int i = tid; i < 2048; i += NTHREADS) { const int r = i >> 7, c = grp * 128 + (i & 127); p.vm[r * D + c] = DN_ALPHA * p.meta[r * D + c] + out[i]; }
  __syncthreads();
}
__device__ __forceinline__ void meta_ln(const Params& p) {
  int tid_ = threadIdx.x; asm volatile("" : "+v"(tid_)); const int tid = tid_, wid = tid >> 6, lane = tid & 63;
  for (int row = wid; row < NM; row += 8) {
    f32x4 v[4]; float s = 0.f;
#pragma unroll
    for (int i = 0; i < 4; ++i) { v[i] = *(const f32x4*)(p.vm + row * D + (i * 64 + lane) * 4); s += (v[i][0] + v[i][1]) + (v[i][2] + v[i][3]); }
#pragma unroll
    for (int o = 32; o > 0; o >>= 1) s += __shfl_xor(s, o);
    const float mean = s * (1.0f / D); float q = 0.f;
#pragma unroll
    for (int i = 0; i < 4; ++i) { const f32x4 d = v[i] - mean; q += (d[0] * d[0] + d[1] * d[1]) + (d[2] * d[2] + d[3] * d[3]); }
#pragma unroll
    for (int o = 32; o > 0; o >>= 1) q += __shfl_xor(q, o);
    const float rstd = rsqrtf(q * (1.0f / D) + EPS);
#pragma unroll
    for (int i = 0; i < 4; ++i) { const int c = (i * 64 + lane) * 4; *(f32x4*)(p.hFm + row * D + c) = (v[i] - mean) * rstd * *(const f32x4*)(p.ln_g + c) + *(const f32x4*)(p.ln_b + c); }
  }
}


#define XB_TMO      128
#define XB_XCNT(j)  (256  + 64 * (j))
#define XB_XSUB(j)  (1280 + 64 * (j))
#define XB_XGEN(j)  (2304 + 64 * (j))
#define XB_TOP      3328
#define XB_TOPGEN   3392
#define XCD_BAR_WORDS 3456
#define XB_SPIN_CAP (1u << 20)
__device__ __forceinline__ unsigned xb_ld(unsigned* p)              { return __hip_atomic_load(p, __ATOMIC_RELAXED, __HIP_MEMORY_SCOPE_AGENT); }
__device__ __forceinline__ unsigned xb_add(unsigned* p, unsigned v) { return __hip_atomic_fetch_add(p, v, __ATOMIC_RELAXED, __HIP_MEMORY_SCOPE_AGENT); }
__device__ __forceinline__ unsigned xb_xcc_id() { return (unsigned)__builtin_amdgcn_s_getreg((3 << 11) | 20) & 0xFu; }
#define XB_SPIN(cond, bar) do { unsigned _sp = 0; while (cond) { __builtin_amdgcn_s_sleep(1); \
    if ((++_sp & 255u) == 0u) { if (xb_ld(&(bar)[XB_TMO])) break; if (_sp > XB_SPIN_CAP) { atomicAdd(&(bar)[XB_TMO], 1u); break; } } } } while (0)
struct XcdBarrier { unsigned* bar; unsigned x; volatile LAS unsigned* st; };
__device__ __forceinline__ XcdBarrier xcd_barrier_post(unsigned* bar, volatile LAS unsigned* st) {
  XcdBarrier b; b.bar = bar; b.x = xb_xcc_id(); b.st = st;
  if (threadIdx.x == 0) (void)xb_add(&bar[XB_XCNT(b.x)], 1u);
  return b;
}
__device__ __forceinline__ void xcd_barrier_complete(unsigned* bar, unsigned x, unsigned& nloc, unsigned& nx) {
  const unsigned G = gridDim.x * gridDim.y * gridDim.z;
  unsigned sum, cnt, mine, sp = 0u;
  for (;;) {
    sum = 0u; cnt = 0u; mine = 0u;
#pragma unroll
    for (unsigned j = 0; j < 16; ++j) { const unsigned c = xb_ld(&bar[XB_XCNT(j)]); sum += c; cnt += (c > 0u) ? 1u : 0u; mine = (j == x) ? c : mine; }
    if (sum == G) break;
    __builtin_amdgcn_s_sleep(1);
    if ((++sp & 255u) == 0u) { if (xb_ld(&bar[XB_TMO])) break; if (sp > XB_SPIN_CAP) { atomicAdd(&bar[XB_TMO], 1u); break; } }
  }
  nloc = mine > 0u ? mine : 1u; nx = cnt > 0u ? cnt : 1u;
}
__device__ __forceinline__ void xcd_barrier(const XcdBarrier& b) {
  asm volatile("s_waitcnt vmcnt(0)" ::: "memory");
  __syncthreads();
  if (threadIdx.x == 0) {
    unsigned* bar = b.bar;
    __builtin_amdgcn_s_waitcnt(0);
    unsigned nloc = b.st[0], nx = b.st[1];
    if (nloc == 0u) { xcd_barrier_complete(bar, b.x, nloc, nx); b.st[0] = nloc; b.st[1] = nx; }
    const unsigned old = xb_add(&bar[XB_XSUB(b.x)], 1u);
    const unsigned gen = old / nloc;
    if (old + 1u == (gen + 1u) * nloc) {
      __builtin_amdgcn_fence(__ATOMIC_RELEASE, "agent");
      asm volatile("s_waitcnt vmcnt(0)" ::: "memory");
      const unsigned og = xb_add(&bar[XB_TOP], 1u);
      const unsigned tg = og / nx;
      if (og + 1u == (tg + 1u) * nx) xb_add(&bar[XB_TOPGEN], 1u);
      else XB_SPIN(xb_ld(&bar[XB_TOPGEN]) == tg, bar);
      __builtin_amdgcn_fence(__ATOMIC_ACQUIRE, "agent");
      xb_add(&bar[XB_XGEN(b.x)], 1u);
      asm volatile("s_waitcnt vmcnt(0)" ::: "memory");
    } else {
      XB_SPIN(xb_ld(&bar[XB_XGEN(b.x)]) == gen, bar);
      __builtin_amdgcn_fence(__ATOMIC_ACQUIRE, "agent");
      asm volatile("s_waitcnt vmcnt(0)" ::: "memory");
    }
  }
  __syncthreads();
}

constexpr int N_HGRN_BLOCKS = NB * 4;
#ifndef PROBE_REP_PREP
#define PROBE_REP_PREP 0
#endif
#ifndef PROBE_REP_P1
#define PROBE_REP_P1 0
#endif
#ifndef PROBE_REP_P3
#define PROBE_REP_P3 0
#endif
#ifndef PROBE_DRY
#define PROBE_DRY 0
#endif
#ifndef PROBE_SYNC
#define PROBE_SYNC 0
#endif
__global__ void __launch_bounds__(NTHREADS, 2) k_mega(Params p) {
  extern __shared__ __attribute__((aligned(16))) unsigned char smem[];
  LAS unsigned char* lds = (LAS unsigned char*)smem;
  cooperative_groups::grid_group grid = cooperative_groups::this_grid();
  const int bid = blockIdx.x, G = gridDim.x;
  if (threadIdx.x < 4) ((LAS unsigned*)(lds + LDS_BYTES - 16))[threadIdx.x] = 0u;
  __syncthreads();
  const XcdBarrier xbar = xcd_barrier_post(p.bar, (volatile LAS unsigned*)(lds + LDS_BYTES - 16));
#define GRID_BAR() xcd_barrier(xbar)
  if (TPROBE) { for (int i = threadIdx.x; i < 64; i += NTHREADS) p.ts[(size_t)blockIdx.x * 64 + i] = 0ull; __syncthreads(); }
  TS_MARK(0);
  for (int i = 0; i < PROBE_SYNC; ++i) grid.sync();
  for (int i = 0; i < PROBE_REP_PREP; ++i) { phase_prep(p, lds); __syncthreads(); }
  phase_prep(p, lds);
  __syncthreads();
  TS_MARK(1); grid.sync(); TS_MARK(2);
#pragma unroll
  for (int layer = 0; layer < DEPTH; ++layer) {
    if (bid < 25) meta_inproj_group(p, layer, lds, bid);
    {
      SrcP1 Sp{(const char*)p.hHi, (const char*)p.hLo, (const char*)(p.WmT + (size_t)layer * 3072 * 1024), (const char*)(p.WsT + (size_t)layer * 512 * 3072)};
      EpiP1 E{p, layer};
      for (int i = 0; i < PROBE_REP_P1; ++i) gemm_phase<SrcP1, EpiP1>(lds, Sp, R / BM, 14, E);
      gemm_phase<SrcP1, EpiP1>(lds, Sp, R / BM, 14, E);
    }
    TS_MARK(3 + 8 * layer); GRID_BAR(); TS_MARK(4 + 8 * layer);
    if (PROBE_DRY) {
      if (bid < N_HGRN_BLOCKS) { if (PROBE_DRY != 2) phase_hgrn(p, layer, lds, bid, true); }
      else { if (PROBE_DRY != 3) phase_attn(p, layer, lds, bid - N_HGRN_BLOCKS, G - N_HGRN_BLOCKS, layer == 0, true); }
      grid.sync();
    }
    if (bid < N_HGRN_BLOCKS) phase_hgrn(p, layer, lds, bid);
    else phase_attn(p, layer, lds, bid - N_HGRN_BLOCKS, G - N_HGRN_BLOCKS, layer == 0);
    TS_MARK(5 + 8 * layer); GRID_BAR(); TS_MARK(6 + 8 * layer);
    if (layer == 0 && bid < 8) meta_outproj_group(p, lds, bid);
    {
      SrcP3 Sp{(const char*)p.gates, (const char*)(p.WoT + (size_t)layer * 1024 * 1024)};
      EpiP3 E{p, layer == 0 ? p.x : p.hF};
      if (layer == 0) for (int i = 0; i < PROBE_REP_P3; ++i) gemm_phase<SrcP3, EpiP3>(lds, Sp, R / BM, 4, E);
      gemm_phase<SrcP3, EpiP3>(lds, Sp, R / BM, 4, E);
    }
    TS_MARK(7 + 8 * layer); GRID_BAR(); TS_MARK(8 + 8 * layer);
    if (layer == 0) { phase_ln(p, 0, p.hF, true); if (bid == G - 1) meta_ln(p); TS_MARK(9); GRID_BAR(); TS_MARK(10); }
    else { phase_ln(p, 1, p.out, false); TS_MARK(17); }
  }
  if (TPROBE) {
    grid.sync();
    if (bid == 0 && threadIdx.x < 64) {
      unsigned long long mx = 0;
      for (int b2 = TP_LO + (int)threadIdx.x; b2 < TP_HI; b2 += 64) { const unsigned long long e_ = __hip_atomic_load(p.ts + (size_t)b2 * 64 + TP_E, __ATOMIC_RELAXED, __HIP_MEMORY_SCOPE_AGENT), s_ = __hip_atomic_load(p.ts + (size_t)b2 * 64 + TP_S, __ATOMIC_RELAXED, __HIP_MEMORY_SCOPE_AGENT); const unsigned long long d = TPROBE == 2 ? e_ : e_ - s_; mx = d > mx ? d : mx; }
      for (int o = 32; o > 0; o >>= 1) { const unsigned long long v = __shfl_xor(mx, o); mx = v > mx ? v : mx; }
      if (threadIdx.x == 0) p.out[0] += (float)mx * 0.0001f;
    }
  }
}

}

extern "C" void kernel_launch(void* const* d_in, const int* in_sizes, int n_in, void* d_out, int out_size, void* d_ws, size_t ws_size,
                              hipStream_t stream) {
  Params p{};
  p.x = (const float*)d_in[0]; p.meta = (const float*)d_in[1]; p.rel_bias = (const float*)d_in[2]; p.lbraw = (const float*)d_in[3];
  p.w_in = (const float*)d_in[4]; p.kvg = (const float*)d_in[5]; p.w_uk = (const float*)d_in[6]; p.w_uv = (const float*)d_in[7];
  p.hng = (const float*)d_in[8]; p.w_out = (const float*)d_in[9]; p.ln_g = (const float*)d_in[10]; p.ln_b = (const float*)d_in[11];
  p.out = (float*)d_out;
  char* w = (char*)d_ws; size_t off = 0;
  auto take = [&](size_t bytes) { char* q = w + off; off += (bytes + 255) & ~(size_t)255; return q; };
  p.hF = (float*)take((size_t)R * D * 4); p.hFm = (float*)take((size_t)NM * D * 4);
  p.hHi = (bf16_t*)take((size_t)R * D * 2); p.hHim = (bf16_t*)take((size_t)NM * D * 2);
  p.hLo = (bf16_t*)take((size_t)R * D * 2); p.hLom = (bf16_t*)take((size_t)NM * D * 2);
  p.qa = (bf16_t*)take((size_t)R * 512 * 2); p.qam = (bf16_t*)take((size_t)NM * 512 * 2);
  p.cN = (bf16_t*)take((size_t)R * 128 * 2); p.cNm = (bf16_t*)take((size_t)NM * 128 * 2);
  p.gates = (bf16_t*)take((size_t)R * 1024 * 2); p.gatesm = (bf16_t*)take((size_t)NM * 1024 * 2);
  p.qfm = (bf16_t*)take((size_t)NM * 512 * 2); p.glm = (float*)take((size_t)NM * 512 * 4); p.vvm = (bf16_t*)take((size_t)NM * 512 * 2);
  p.qiH = (bf16_t*)take((size_t)R * 256 * 2); p.qiL = (bf16_t*)take((size_t)R * 256 * 2);
  p.kiH = (bf16_t*)take((size_t)R * 64 * 2); p.kiL = (bf16_t*)take((size_t)R * 64 * 2);
  p.wi = (float*)take((size_t)R * 4 * 4);
  p.sel = (int*)take(256); p.nsel = (int*)take(256);
  p.proj = (float*)take((size_t)NM * NIN * 4);
  p.ych = (float*)take((size_t)NM * D * 4);
  p.WmT = (bf16_t*)take((size_t)DEPTH * 3072 * 1024 * 2); p.WsT = (bf16_t*)take((size_t)DEPTH * 512 * 3072 * 2); p.WoT = (bf16_t*)take((size_t)DEPTH * 1024 * 1024 * 2);
  p.lbv = (float*)take((size_t)DEPTH * 512 * 4);
  p.stats = (float*)take((size_t)R * 16 * 2 * 4); p.statsm = (float*)take(256);
  p.vm = (float*)take((size_t)NM * D * 4);
  p.dummy = (bf16_t*)take((size_t)(R + NM) * 1024 * 2);
  p.bar = (unsigned*)take(XCD_BAR_WORDS * 4);
  p.ts = (unsigned long long*)take(256 * 64 * 8);
  p.wukT = (bf16_t*)take((size_t)DEPTH * 8 * 128 * 64 * 2); p.wuvT = (bf16_t*)take((size_t)DEPTH * 8 * 64 * 128 * 2);
  if (off > ws_size) return;
  p.gl = (float*)d_out; p.qf = (bf16_t*)((char*)d_out + (size_t)R * 512 * 4); p.vv = (bf16_t*)((char*)d_out + (size_t)R * 512 * 4 + (size_t)R * 512 * 2);

  static int grid_blocks = 0;
  if (!grid_blocks) {
    (void)hipFuncSetAttribute((const void*)k_mega, hipFuncAttributeMaxDynamicSharedMemorySize, LDS_BYTES);
    int dev = 0, cus = 0, per_cu = 0;
    (void)hipGetDevice(&dev);
    (void)hipDeviceGetAttribute(&cus, hipDeviceAttributeMultiprocessorCount, dev);
    (void)hipOccupancyMaxActiveBlocksPerMultiprocessor(&per_cu, (const void*)k_mega, NTHREADS, LDS_BYTES);
    grid_blocks = per_cu >= 1 ? cus : 0;
    if (grid_blocks > 256) grid_blocks = 256;
  }
  if (grid_blocks < 64) return;
  (void)hipMemsetAsync(p.bar, 0, XCD_BAR_WORDS * 4, stream);
  void* args[] = {(void*)&p};
  (void)hipLaunchCooperativeKernel((const void*)k_mega, dim3(grid_blocks), dim3(NTHREADS), args, LDS_BYTES, stream);
}
```

```cpp
#include <hip/hip_runtime.h>
#include <hip/hip_cooperative_groups.h>
#include <stdint.h>

namespace {
typedef unsigned short bf16_t;
constexpr int D = 1024, NB = 8, S = 4096, NM = 16, NIN = 3524, DEPTH = 2;
constexpr int R = NB * S;
constexpr int O_QA = 0, O_CKV = 512, O_QI = 640, O_KI = 896, O_WI = 960, O_GA = 964, O_QH = 1476, O_FH = 1988, O_IH = 2500, O_GH = 3012;
constexpr int TOPK = 256;
constexpr float EPS = 1e-6f;
constexpr float DN_ALPHA = 1.4142135623730951f;

__constant__ unsigned char c_bucket[128] = {
  0, 1, 2, 3, 4, 5, 6, 7, 8, 9, 10, 11, 12, 13, 14, 15, 16, 16, 16, 17, 17, 18, 18, 18, 19, 19, 19, 20, 20, 20, 20, 21,
  21, 21, 21, 22, 22, 22, 22, 22, 23, 23, 23, 23, 23, 23, 24, 24, 24, 24, 24, 24, 25, 25, 25, 25, 25, 25, 25, 26, 26, 26, 26, 26,
  26, 26, 26, 27, 27, 27, 27, 27, 27, 27, 27, 27, 27, 28, 28, 28, 28, 28, 28, 28, 28, 28, 28, 29, 29, 29, 29, 29, 29, 29, 29, 29,
  29, 29, 29, 30, 30, 30, 30, 30, 30, 30, 30, 30, 30, 30, 30, 30, 30, 31, 31, 31, 31, 31, 31, 31, 31, 31, 31, 31, 31, 31, 31, 31};

__device__ __forceinline__ int t5_bucket(int dist) { int n = dist < 0 ? 0 : dist; return n >= 128 ? 31 : (int)c_bucket[n]; }
__device__ __forceinline__ float sigmoidf_(float x) { return 1.0f / (1.0f + expf(-x)); }
__device__ __forceinline__ float siluf_(float x) { return x / (1.0f + expf(-x)); }
__device__ __forceinline__ bf16_t f2bf(float f) { unsigned u = __float_as_uint(f); u += 0x7fffu + ((u >> 16) & 1u); return (bf16_t)(u >> 16); }
__device__ __forceinline__ float bf2f(bf16_t h) { return __uint_as_float(((unsigned)h) << 16); }

struct Params {
  const float *x, *meta, *rel_bias, *lbraw, *w_in, *kvg, *w_uk, *w_uv, *hng, *w_out, *ln_g, *ln_b;
  float* out;
  float *hF, *hFm;
  bf16_t *hHi, *hHim, *hLo, *hLom;
  bf16_t *qa, *qam;
  bf16_t *cN, *cNm;
  bf16_t *gates, *gatesm;
  bf16_t *qf, *qfm;
  float *gl, *glm;
  bf16_t *vv, *vvm;
  bf16_t *qiH, *qiL;
  bf16_t *kiH, *kiL;
  float* wi;
  int* sel; int* nsel;
  float* proj;
  float* ych;
  bf16_t* WmT;
  bf16_t* WsT;
  bf16_t* WoT;
  float* lbv;
  float* stats;
  float* statsm;
  float* vm;
  bf16_t* dummy;
  unsigned* bar;
  unsigned long long* ts;
  bf16_t* wukT;
  bf16_t* wuvT;
};

__device__ __forceinline__ unsigned f2key(float f) { unsigned u = __float_as_uint(f); return (u & 0x80000000u) ? ~u : (u | 0x80000000u); }

#define LAS __attribute__((address_space(3)))
typedef short bf16x8 __attribute__((ext_vector_type(8)));
typedef float f32x4 __attribute__((ext_vector_type(4)));
typedef unsigned u32x2 __attribute__((ext_vector_type(2)));
typedef unsigned u32x4 __attribute__((ext_vector_type(4)));
constexpr int NTHREADS = 512;
constexpr int LDS_BYTES = 160 * 1024;
constexpr int BM = 256, BK = 64, HALF = 128, HTB = HALF * BK * 2, STAGE_BYTES = 8 * HTB;
constexpr int LDS_EXTRA = STAGE_BYTES;
#define IDX_SPLIT 0
#define TPROBE 0
#define TP_S 0
#define TP_E 1
#define TP_LO 0
#define TP_HI 256
#define TS_MARK(k) do { if (TPROBE && threadIdx.x == 0) p.ts[(size_t)blockIdx.x * 64 + (k)] = __builtin_amdgcn_s_memrealtime(); } while (0)
#define TS_ACC_BEGIN() unsigned long long tacc_ = TPROBE ? __builtin_amdgcn_s_memrealtime() : 0ull
#define TS_ACC(k) do { if (TPROBE) { const unsigned long long t2_ = __builtin_amdgcn_s_memrealtime(); if (threadIdx.x == 0) p.ts[(size_t)blockIdx.x * 64 + (k)] += t2_ - tacc_; tacc_ = t2_; } } while (0)
#define PROBE_REP_SCORE 0
#define ABL_SCORE 0
#define PROBE_REP_SELECT 0
#define PROBE_REP_ATT 0
#define PROBE_REP_QLAT 0

typedef float f32x2v __attribute__((ext_vector_type(2)));
typedef __bf16 bf16x2v __attribute__((ext_vector_type(2)));
__device__ __forceinline__ unsigned pack_bf16(float lo, float hi) { const f32x2v v = {lo, hi}; const bf16x2v b = __builtin_convertvector(v, bf16x2v); return __builtin_bit_cast(unsigned, b); }
__device__ __forceinline__ bf16_t f2bf_fast(float x) { return (bf16_t)(pack_bf16(x, 0.f) & 0xffffu); }
__device__ __forceinline__ float fast_sigmoid(float x) { return __builtin_amdgcn_rcpf(1.0f + __expf(-x)); }
__device__ __forceinline__ float fast_silu(float x) { return x * __builtin_amdgcn_rcpf(1.0f + __expf(-x)); }

__device__ __forceinline__ int lds_byte(int r, int c) { const int st = (r >> 4) * 2 + (c >> 5), rr = r & 15, cc = c & 31, ob = rr * 64 + cc * 2; return st * 1024 + (ob ^ (((ob >> 9) & 1) << 5)); }
__device__ __forceinline__ void stage_rc(int b, int& Rr, int& Cc) { const int st = b / 1024, sb = b % 1024, swz = sb ^ (((sb >> 9) & 1) << 5); Rr = (st >> 1) * 16 + swz / 64; Cc = (st & 1) * 32 + (swz % 64) / 2; }

struct GUnit { int pm, pn; };
__device__ __forceinline__ bool unit_next(int i, int nM, int nN, GUnit& u) {
  const int nwg = nM * nN; const long L = (long)i * gridDim.x + blockIdx.x; if (L >= nwg) return false;
  int wgid = (int)L; { const int q = nwg / 8, r = nwg % 8, xcd = wgid % 8, off = wgid / 8; wgid = (xcd < r ? xcd * (q + 1) : r * (q + 1) + (xcd - r) * q) + off; }
  const int nig = 8 * nN, gid = wgid / nig, fm = gid * 8, gsz = (nM - fm) < 8 ? (nM - fm) : 8;
  u.pm = fm + ((wgid % nig) % gsz); u.pn = (wgid % nig) / gsz; return true;
}

struct SrcP1 {
  const char* Ahi; const char* Alo; const char* Wm; const char* Ws;
  __device__ __forceinline__ int nt(const GUnit& u) const { return (IDX_SPLIT && u.pn >= 12) ? 48 : 16; }
  __device__ __forceinline__ int ldb(const GUnit& u) const { return u.pn < 12 ? 1024 : 3072; }
  __device__ __forceinline__ const char* a(const GUnit& u, int kt) const { const char* b = (kt >= 16 && kt < 32) ? Alo : Ahi; return b + (size_t)u.pm * (256 * 1024 * 2) + (size_t)(kt & 15) * 128; }
  __device__ __forceinline__ const char* b(const GUnit& u, int kt) const { return u.pn < 12 ? Wm + (size_t)u.pn * (256 * 1024 * 2) + (size_t)kt * 128 : Ws + (size_t)(u.pn - 12) * (256 * 3072 * 2) + (size_t)kt * 128; }
};
struct SrcP3 {
  const char* A; const char* W;
  __device__ __forceinline__ int nt(const GUnit&) const { return 16; }
  __device__ __forceinline__ int ldb(const GUnit&) const { return 1024; }
  __device__ __forceinline__ const char* a(const GUnit& u, int kt) const { return A + (size_t)u.pm * (256 * 1024 * 2) + (size_t)kt * 128; }
  __device__ __forceinline__ const char* b(const GUnit& u, int kt) const { return W + (size_t)u.pn * (256 * 1024 * 2) + (size_t)kt * 128; }
};


template <int CTRL, int ROWMASK = 0xf, bool BC = true>
__device__ __forceinline__ float dppf(float v) { return __int_as_float(__builtin_amdgcn_update_dpp(0, __float_as_int(v), CTRL, ROWMASK, 0xf, BC)); }
__device__ __forceinline__ float row_sum16(float v) { v += dppf<0x128>(v); v += dppf<0x124>(v); v += dppf<0x122>(v); v += dppf<0x121>(v); return v; }
__device__ __forceinline__ unsigned wave_incl_scan(unsigned v) {
  v += (unsigned)__builtin_amdgcn_update_dpp(0, (int)v, 0x111, 0xf, 0xf, true);
  v += (unsigned)__builtin_amdgcn_update_dpp(0, (int)v, 0x112, 0xf, 0xf, true);
  v += (unsigned)__builtin_amdgcn_update_dpp(0, (int)v, 0x114, 0xf, 0xf, true);
  v += (unsigned)__builtin_amdgcn_update_dpp(0, (int)v, 0x118, 0xf, 0xf, true);
  v += (unsigned)__builtin_amdgcn_update_dpp(0, (int)v, 0x142, 0xa, 0xf, false);
  v += (unsigned)__builtin_amdgcn_update_dpp(0, (int)v, 0x143, 0xc, 0xf, false);
  return v;
}
__device__ __forceinline__ float rows_max(float x) {
  auto r = __builtin_amdgcn_permlane16_swap(__float_as_uint(x), __float_as_uint(x), false, false); x = fmaxf(__uint_as_float(r[0]), __uint_as_float(r[1]));
  auto q = __builtin_amdgcn_permlane32_swap(__float_as_uint(x), __float_as_uint(x), false, false); return fmaxf(__uint_as_float(q[0]), __uint_as_float(q[1])); }
__device__ __forceinline__ float rows_sum(float x) {
  auto r = __builtin_amdgcn_permlane16_swap(__float_as_uint(x), __float_as_uint(x), false, false); x = __uint_as_float(r[0]) + __uint_as_float(r[1]);
  auto q = __builtin_amdgcn_permlane32_swap(__float_as_uint(x), __float_as_uint(x), false, false); return __uint_as_float(q[0]) + __uint_as_float(q[1]); }
__device__ __forceinline__ size_t kfrag(size_t row, int c) { return (((((row >> 4) * 2 + (size_t)(c >> 5)) * 4 + (size_t)((c >> 3) & 3)) * 16 + (row & 15)) * 8) + (size_t)(c & 7); }

struct EpiP1 {
  Params p; int layer;
  __device__ __forceinline__ void operator()(const f32x4 (&acc)[2][2][4][2], const GUnit& u, int wr, int wc, int fr, int fq, LAS unsigned char* lds) const {
    const int row0 = u.pm * BM + wr * 64 + fr;
    if (u.pn < 12) {
      const int kind = u.pn >> 1; const int c00 = (u.pn & 1) * 256 + wc * 32 + 4 * fq;
#pragma unroll
      for (int ai = 0; ai < 2; ++ai)
#pragma unroll
        for (int m = 0; m < 4; ++m) {
          const size_t row = (size_t)(row0 + ai * HALF + m * 16);
#pragma unroll
          for (int bj = 0; bj < 2; ++bj)
#pragma unroll
            for (int n = 0; n < 2; ++n) {
              const int c = c00 + bj * HALF + n * 16; f32x4 v = acc[ai][bj][m][n];
              if (kind == 3) {
                const f32x4 lb = *(const f32x4*)(p.lbv + layer * 512 + c); f32x4 o;
#pragma unroll
                for (int j = 0; j < 4; ++j) o[j] = __logf(lb[j] + (1.0f - lb[j]) * fast_sigmoid(v[j]));
                *(f32x4*)(p.gl + row * 512 + c) = o;
              } else {
                if (kind == 1 || kind == 5) {
#pragma unroll
                  for (int j = 0; j < 4; ++j) v[j] = fast_silu(v[j]);
                } else if (kind == 2) {
#pragma unroll
                  for (int j = 0; j < 4; ++j) v[j] = fast_silu(v[j]) * 0.08838834764831845f;
                }
                u32x2 w; w.x = pack_bf16(v[0], v[1]); w.y = pack_bf16(v[2], v[3]);
                bf16_t* dst = kind == 0 ? p.qa + row * 512 + c : kind == 1 ? p.gates + row * 1024 + c : kind == 2 ? p.qf + row * 512 + c
                            : kind == 4 ? p.vv + row * 512 + c : p.gates + row * 1024 + 512 + c;
                *(u32x2*)dst = w;
              }
            }
        }
    } else if (u.pn == 12) {
      const int c00 = wc * 32 + 4 * fq;
#pragma unroll
      for (int ai = 0; ai < 2; ++ai)
#pragma unroll
        for (int m = 0; m < 4; ++m) {
          const size_t row = (size_t)(row0 + ai * HALF + m * 16);
#pragma unroll
          for (int bj = 0; bj < 2; ++bj)
#pragma unroll
            for (int n = 0; n < 2; ++n) {
              const int c = c00 + bj * HALF + n * 16; const f32x4 v = acc[ai][bj][m][n] * 0.125f;
              u32x2 wh, wl; wh.x = pack_bf16(v[0], v[1]); wh.y = pack_bf16(v[2], v[3]);
              wl.x = pack_bf16(v[0] - __uint_as_float(wh.x << 16), v[1] - __uint_as_float(wh.x & 0xffff0000u)); wl.y = pack_bf16(v[2] - __uint_as_float(wh.y << 16), v[3] - __uint_as_float(wh.y & 0xffff0000u));
              *(u32x2*)(p.qiH + row * 256 + c) = wh; *(u32x2*)(p.qiL + row * 256 + c) = wl;
            }
        }
    } else {
      LAS float* red = (LAS float*)(lds + LDS_EXTRA);
#pragma unroll
      for (int ai = 0; ai < 2; ++ai)
#pragma unroll
        for (int m = 0; m < 4; ++m) {
          float s = 0.f;
#pragma unroll
          for (int n = 0; n < 2; ++n) { const f32x4 v = acc[ai][0][m][n]; s += (v[0] * v[0] + v[1] * v[1]) + (v[2] * v[2] + v[3] * v[3]); }
          s = rows_sum(s);
          if (fq == 0) red[(ai * HALF + wr * 64 + m * 16 + fr) * 4 + wc] = s;
        }
      asm volatile("s_waitcnt lgkmcnt(0)" ::: "memory"); __builtin_amdgcn_s_barrier(); asm volatile("" ::: "memory");
#pragma unroll
      for (int ai = 0; ai < 2; ++ai)
#pragma unroll
        for (int m = 0; m < 4; ++m) {
          const int lr = ai * HALF + wr * 64 + m * 16 + fr; const size_t row = (size_t)(u.pm * BM + lr);
          const f32x4 pr = *(const LAS f32x4*)(red + lr * 4);
          const float rstd = rsqrtf(((pr[0] + pr[1]) + (pr[2] + pr[3])) * (1.0f / 128.0f) + EPS);
#pragma unroll
          for (int n = 0; n < 2; ++n) {
            const int c = wc * 32 + n * 16 + 4 * fq; const f32x4 g = *(const f32x4*)(p.kvg + layer * 128 + c); const f32x4 v = acc[ai][0][m][n] * rstd * g;
            u32x2 w; w.x = pack_bf16(v[0], v[1]); w.y = pack_bf16(v[2], v[3]); *(u32x2*)(p.cN + row * 128 + c) = w;
          }
          if (wc < 2) {
#pragma unroll
            for (int n = 0; n < 2; ++n) {
              const int c = wc * 32 + n * 16 + 4 * fq; const f32x4 v = acc[ai][1][m][n];
              u32x2 wh, wl; wh.x = pack_bf16(v[0], v[1]); wh.y = pack_bf16(v[2], v[3]);
              wl.x = pack_bf16(v[0] - __uint_as_float(wh.x << 16), v[1] - __uint_as_float(wh.x & 0xffff0000u)); wl.y = pack_bf16(v[2] - __uint_as_float(wh.y << 16), v[3] - __uint_as_float(wh.y & 0xffff0000u));
              *(u32x2*)(p.kiH + kfrag(row, c)) = wh; *(u32x2*)(p.kiL + kfrag(row, c)) = wl;
            }
          } else if (wc == 2 && fq == 0) {
            *(f32x4*)(p.wi + row * 4) = acc[ai][1][m][0] * 0.5f;
          }
        }
    }
  }
};

struct EpiP3 {
  Params p; const float* hres;
  __device__ __forceinline__ void operator()(const f32x4 (&acc)[2][2][4][2], const GUnit& u, int wr, int wc, int fr, int fq, LAS unsigned char* lds) const {
    const int row0 = u.pm * BM + wr * 64 + fr; const int c00 = u.pn * BM + wc * 32 + 4 * fq;
#pragma unroll
    for (int ai = 0; ai < 2; ++ai)
#pragma unroll
      for (int m = 0; m < 4; ++m) {
        const size_t row = (size_t)(row0 + ai * HALF + m * 16); float s = 0.f, q = 0.f;
#pragma unroll
        for (int bj = 0; bj < 2; ++bj)
#pragma unroll
          for (int n = 0; n < 2; ++n) {
            const int c = c00 + bj * HALF + n * 16; const f32x4 h = *(const f32x4*)(hres + row * D + c);
            const f32x4 v = h * DN_ALPHA + acc[ai][bj][m][n];
            *(f32x4*)(p.hF + row * D + c) = v;
            s += (v[0] + v[1]) + (v[2] + v[3]); q += (v[0] * v[0] + v[1] * v[1]) + (v[2] * v[2] + v[3] * v[3]);
          }
        s = rows_sum(s); q = rows_sum(q);
        if (fq == 0) { float2 st; st.x = s; st.y = q; *(float2*)(p.stats + (row * 16 + u.pn * 4 + wc) * 2) = st; }
        asm volatile("" ::: "memory");
      }
  }
};

template <class Src, class Epi>
__device__ __forceinline__ void gemm_phase(LAS unsigned char* lds, const Src S, const int nM, const int nN, const Epi& E) {
  int tid_ = threadIdx.x; asm volatile("" : "+v"(tid_));
  const int tid = tid_, wid = __builtin_amdgcn_readfirstlane(tid >> 6), lane = tid & 63, wr = wid >> 2, wc = wid & 3, fr = lane & 15, fq = lane >> 4;
  unsigned voffA[2], voffB1[2], voffB3[2];
#pragma unroll
  for (int i = 0; i < 2; ++i) { int Rr, Cc; stage_rc(tid * 16 + i * 8192, Rr, Cc); voffA[i] = (unsigned)(Rr * 1024 + Cc) * 2u; voffB1[i] = voffA[i]; voffB3[i] = (unsigned)(Rr * 3072 + Cc) * 2u; }
  const size_t hstepA = (size_t)HALF * 1024 * 2;
  const unsigned ldsw = (unsigned)wid * 1024u;
  const int aoff = lds_byte(wr * 64 + fr, fq * 8), boff = lds_byte(wc * 32 + fr, fq * 8);
#define G_SA(b, h) (((b) * 2 + (h)) * HTB)
#define G_SB(b, h) ((4 + (b) * 2 + (h)) * HTB)
#define G_STAGE(bufoff, gbase, v0, v1) do { \
    __builtin_amdgcn_global_load_lds((const unsigned*)((const char*)(gbase) + (v0)), (LAS unsigned*)(lds + (bufoff) + ldsw), 16, 0, 0); \
    __builtin_amdgcn_global_load_lds((const unsigned*)((const char*)(gbase) + (v1)), (LAS unsigned*)(lds + (bufoff) + ldsw + 8192), 16, 0, 0); } while (0)
#define G_STAGE_A(bufoff, gbase) G_STAGE(bufoff, gbase, voffA[0], voffA[1])
#define G_LDA(dst, b, h) do { _Pragma("unroll") for (int m = 0; m < 4; ++m) _Pragma("unroll") for (int k = 0; k < 2; ++k) dst[m][k] = *(const LAS bf16x8*)(lds + G_SA(b, h) + aoff + m * 2048 + k * 1024); } while (0)
#define G_LDB(dst, b, h) do { _Pragma("unroll") for (int n = 0; n < 2; ++n) _Pragma("unroll") for (int k = 0; k < 2; ++k) dst[n][k] = *(const LAS bf16x8*)(lds + G_SB(b, h) + boff + n * 2048 + k * 1024); } while (0)
#define G_MMA(ai, bj, At, Bt) do { __builtin_amdgcn_s_setprio(1); _Pragma("unroll") for (int m = 0; m < 4; ++m) _Pragma("unroll") for (int n = 0; n < 2; ++n) _Pragma("unroll") for (int k = 0; k < 2; ++k) \
    acc[ai][bj][m][n] = __builtin_amdgcn_mfma_f32_16x16x32_bf16(Bt[n][k], At[m][k], acc[ai][bj][m][n], 0, 0, 0); __builtin_amdgcn_s_setprio(0); } while (0)
#define G_WAIT_V(n) asm volatile("s_waitcnt vmcnt(" #n ")" ::: "memory")
#define G_WAIT_L(n) asm volatile("s_waitcnt lgkmcnt(" #n ")" ::: "memory")
#define G_BAR __builtin_amdgcn_s_barrier()
#define G_SCHED __builtin_amdgcn_sched_barrier(0)
  const Params& p = E.p;
  GUnit cur, nxt; int ui = 0;
  if (!unit_next(0, nM, nN, cur)) return;
  f32x4 acc[2][2][4][2];
#pragma unroll
  for (int a = 0; a < 2; ++a)
#pragma unroll
    for (int b = 0; b < 2; ++b)
#pragma unroll
      for (int m = 0; m < 4; ++m)
#pragma unroll
        for (int n = 0; n < 2; ++n) acc[a][b][m][n] = (f32x4){0.f, 0.f, 0.f, 0.f};
  bf16x8 At[4][2], B0[2][2], B1[2][2];
  {
    const bool w3 = S.ldb(cur) == 3072; const unsigned vb0 = w3 ? voffB3[0] : voffB1[0], vb1 = w3 ? voffB3[1] : voffB1[1]; const size_t hsB = (size_t)HALF * S.ldb(cur) * 2;
    const char* cA0 = S.a(cur, 0); const char* cB0 = S.b(cur, 0); const char* cA1 = S.a(cur, 1); const char* cB1 = S.b(cur, 1);
    G_STAGE(G_SB(0, 0), cB0, vb0, vb1); G_STAGE_A(G_SA(0, 0), cA0); G_STAGE(G_SB(0, 1), cB0 + hsB, vb0, vb1); G_STAGE_A(G_SA(0, 1), cA0 + hstepA);
    if (wr == 1) G_BAR;
    G_WAIT_V(4); G_BAR;
    G_STAGE(G_SB(1, 0), cB1, vb0, vb1); G_STAGE_A(G_SA(1, 0), cA1); G_STAGE(G_SB(1, 1), cB1 + hsB, vb0, vb1);
    G_WAIT_V(6); G_BAR;
  }
  for (;;) {
    TS_ACC_BEGIN();
    const bool has_next = unit_next(ui + 1, nM, nN, nxt);
    const GUnit nu = has_next ? nxt : cur;
    const int nt = S.nt(cur);
    const bool cw3 = S.ldb(cur) == 3072, nw3 = S.ldb(nu) == 3072;
    for (int t = 0; t < nt; t += 2) {
      const bool last = (t == nt - 2);
      const char* a1 = S.a(cur, t + 1);
      const char* a2 = last ? S.a(nu, 0) : S.a(cur, t + 2); const char* b2 = last ? S.b(nu, 0) : S.b(cur, t + 2);
      const char* a3 = last ? S.a(nu, 1) : S.a(cur, t + 3); const char* b3 = last ? S.b(nu, 1) : S.b(cur, t + 3);
      const bool w3 = last ? nw3 : cw3;
      const unsigned vb0 = w3 ? voffB3[0] : voffB1[0], vb1 = w3 ? voffB3[1] : voffB1[1]; const size_t hsB = w3 ? (size_t)HALF * 3072 * 2 : (size_t)HALF * 1024 * 2;
      G_LDB(B0, 0, 0); G_SCHED; G_LDA(At, 0, 0); G_STAGE_A(G_SA(1, 1), a1 + hstepA);
      G_WAIT_L(8); G_BAR; G_WAIT_L(0); G_MMA(0, 0, At, B0); G_BAR; G_SCHED;
      G_LDB(B1, 0, 1); G_STAGE(G_SB(0, 0), b2, vb0, vb1);
      G_BAR; G_WAIT_L(0); G_MMA(0, 1, At, B1); G_BAR;
      G_LDA(At, 0, 1); G_STAGE_A(G_SA(0, 0), a2);
      G_BAR; G_WAIT_L(0); G_MMA(1, 0, At, B0); G_BAR; G_SCHED;
      G_STAGE(G_SB(0, 1), b2 + hsB, vb0, vb1);
      G_WAIT_V(6); G_BAR; G_MMA(1, 1, At, B1); G_BAR;
      G_LDB(B0, 1, 0); G_SCHED; G_LDA(At, 1, 0); G_STAGE_A(G_SA(0, 1), a2 + hstepA);
      G_WAIT_L(8); G_BAR; G_WAIT_L(0); G_MMA(0, 0, At, B0); G_BAR; G_SCHED;
      G_LDB(B1, 1, 1); G_STAGE(G_SB(1, 0), b3, vb0, vb1);
      G_BAR; G_WAIT_L(0); G_MMA(0, 1, At, B1); G_BAR;
      G_LDA(At, 1, 1); G_STAGE_A(G_SA(1, 0), a3);
      G_BAR; G_WAIT_L(0); G_MMA(1, 0, At, B0); G_BAR; G_SCHED;
      G_STAGE(G_SB(1, 1), b3 + hsB, vb0, vb1);
      G_WAIT_V(6); G_BAR; G_MMA(1, 1, At, B1); G_BAR;
    }
    TS_ACC(56);
    E(acc, cur, wr, wc, fr, fq, lds);
    TS_ACC(57);
    if (!has_next) break;
#pragma unroll
    for (int a = 0; a < 2; ++a)
#pragma unroll
      for (int b = 0; b < 2; ++b)
#pragma unroll
        for (int m = 0; m < 4; ++m)
#pragma unroll
          for (int n = 0; n < 2; ++n) acc[a][b][m][n] = (f32x4){0.f, 0.f, 0.f, 0.f};
    cur = nxt; ++ui;
  }
  G_WAIT_V(0);
  if (wr == 0) G_BAR;
  G_BAR;
#undef G_SA
#undef G_SB
#undef G_STAGE
#undef G_STAGE_A
#undef G_LDA
#undef G_LDB
#undef G_MMA
#undef G_WAIT_V
#undef G_WAIT_L
#undef G_BAR
#undef G_SCHED
}

__device__ __forceinline__ void phase_prep(const Params& p, LAS unsigned char* lds) {
  int tid_ = threadIdx.x; asm volatile("" : "+v"(tid_));
  const int tid = tid_, nb = gridDim.x, bid = blockIdx.x;
  LAS float* tile = (LAS float*)lds;
  const int NJ = DEPTH * (48 + 8 + 16) * 16;
  for (int job = bid; job < NJ; job += nb) {
    const int l = job / ((48 + 8 + 16) * 16); int rem = job % ((48 + 8 + 16) * 16); const int ntile = rem / 16, kt = rem % 16;
    const int kind = ntile < 48 ? 0 : ntile < 56 ? 1 : 2; const int n0 = kind == 0 ? ntile * 64 : kind == 1 ? (ntile - 48) * 64 : (ntile - 56) * 64;
    const float* src = kind == 2 ? p.w_out + (size_t)l * D * D : p.w_in + (size_t)l * D * NIN; const int lds_ = kind == 2 ? D : NIN;
    for (int i = tid; i < 64 * 64; i += NTHREADS) {
      const int kk = i >> 6, nn = i & 63; const int n = n0 + nn; int col;
      if (kind == 0) { const int grp = n >> 9, cc = n & 511; col = (grp == 0 ? O_QA : grp == 1 ? O_GA : grp == 2 ? O_QH : grp == 3 ? O_FH : grp == 4 ? O_IH : O_GH) + cc; }
      else if (kind == 1) { col = n < 256 ? O_QI + n : n < 384 ? O_CKV + (n - 256) : n < 448 ? O_KI + (n - 384) : n < 452 ? O_WI + (n - 448) : -1; }
      else col = n;
      tile[kk * 65 + nn] = col >= 0 ? src[(size_t)(kt * 64 + kk) * lds_ + col] : 0.f;
    }
    __syncthreads();
    for (int i = tid; i < 64 * 64; i += NTHREADS) {
      const int nn = i >> 6, kk = i & 63; const float v = tile[kk * 65 + nn]; const int n = n0 + nn, k = kt * 64 + kk;
      if (kind == 0) p.WmT[((size_t)l * 3072 + n) * 1024 + k] = f2bf(v);
      else if (kind == 2) p.WoT[((size_t)l * 1024 + n) * 1024 + k] = f2bf(v);
      else { const bf16_t h = f2bf(v), lo = f2bf(v - bf2f(h)); bf16_t* d = p.WsT + ((size_t)l * 512 + n) * 3072; d[k] = h; d[1024 + k] = h; d[2048 + k] = lo; }
    }
    __syncthreads();
  }
  for (int i = bid * NTHREADS + tid; i < 512; i += nb * NTHREADS) {
    const float r0 = p.lbraw[i], r1 = p.lbraw[512 + i]; const float m = fmaxf(r0, r1); const float e0 = expf(r0 - m), e1 = expf(r1 - m);
    p.lbv[i] = 0.f; p.lbv[512 + i] = e1 / (e0 + e1);
  }
  for (int i = bid * NTHREADS + tid; i < DEPTH * 8 * 128 * 64; i += nb * NTHREADS) {
    const int d = i & 63, c = (i >> 6) & 127, lh = i >> 13;
    p.wukT[i] = f2bf(p.w_uk[((size_t)lh * 64 + d) * 128 + c]);
    const int c2 = i & 127, d2 = (i >> 7) & 63;
    p.wuvT[i] = f2bf(p.w_uv[((size_t)lh * 128 + c2) * 64 + d2]);
  }
  const size_t n4 = (size_t)(R + NM) * D / 4;
  for (size_t i = (size_t)bid * NTHREADS + tid; i < n4; i += (size_t)nb * NTHREADS) {
    const size_t row = i / (D / 4); const int c4 = (int)(i % (D / 4));
    const bool im = row >= (size_t)R; const size_t rr = im ? row - R : row;
    const f32x4 v = *(const f32x4*)((im ? p.meta : p.x) + rr * D + c4 * 4);
    u32x2 wh, wl; wh.x = pack_bf16(v[0], v[1]); wh.y = pack_bf16(v[2], v[3]);
    wl.x = pack_bf16(v[0] - __uint_as_float(wh.x << 16), v[1] - __uint_as_float(wh.x & 0xffff0000u)); wl.y = pack_bf16(v[2] - __uint_as_float(wh.y << 16), v[3] - __uint_as_float(wh.y & 0xffff0000u));
    *(u32x2*)((im ? p.hHim : p.hHi) + rr * D + c4 * 4) = wh; *(u32x2*)((im ? p.hLom : p.hLo) + rr * D + c4 * 4) = wl;
  }
}

__device__ __forceinline__ void phase_ln(const Params& p, int layer, float* dst, bool write_split) {
  int tid_ = threadIdx.x; asm volatile("" : "+v"(tid_));
  const int tid = tid_, wid = tid >> 6, lane = tid & 63;
  const float* g = p.ln_g + layer * D; const float* bb = p.ln_b + layer * D;
  for (int row = blockIdx.x * 8 + wid; row < R; row += gridDim.x * 8) {
    float s = 0.f, q = 0.f;
    if (lane < 16) { const float2 st = *(const float2*)(p.stats + ((size_t)row * 16 + lane) * 2); s = st.x; q = st.y; }
#pragma unroll
    for (int o = 8; o > 0; o >>= 1) { s += __shfl_xor(s, o); q += __shfl_xor(q, o); }
    s = __shfl(s, 0); q = __shfl(q, 0);
    const float mean = s * (1.0f / D); const float var = fmaxf(q * (1.0f / D) - mean * mean, 0.f); const float rstd = rsqrtf(var + EPS);
#pragma unroll
    for (int i = 0; i < 4; ++i) {
      const int c = (i * 64 + lane) * 4;
      const f32x4 v = *(const f32x4*)(p.hF + (size_t)row * D + c); const f32x4 gg = *(const f32x4*)(g + c); const f32x4 bv = *(const f32x4*)(bb + c);
      const f32x4 o = (v - mean) * rstd * gg + bv;
      *(f32x4*)(dst + (size_t)row * D + c) = o;
      if (write_split) {
        u32x2 wh, wl; wh.x = pack_bf16(o[0], o[1]); wh.y = pack_bf16(o[2], o[3]);
        wl.x = pack_bf16(o[0] - __uint_as_float(wh.x << 16), o[1] - __uint_as_float(wh.x & 0xffff0000u)); wl.y = pack_bf16(o[2] - __uint_as_float(wh.y << 16), o[3] - __uint_as_float(wh.y & 0xffff0000u));
        *(u32x2*)(p.hHi + (size_t)row * D + c) = wh; *(u32x2*)(p.hLo + (size_t)row * D + c) = wl;
      }
    }
  }
}

constexpr int K16_STRIDE = 8208;
constexpr int A_BIG = 0;
constexpr int A_SEL = 131328;
constexpr int A_CM = A_SEL + 8192;
constexpr int A_MISC = A_CM + 4096;
constexpr int A_HIST = A_MISC;
constexpr int A_CAND = A_MISC + 16448;
constexpr int A_RB = A_MISC + 16448 + 1024;
constexpr int A_BKT = A_RB + 1024;
constexpr int A_NSEL = A_BKT + 128;
static_assert(A_NSEL + 64 <= LDS_BYTES, "attention LDS map");

__device__ __forceinline__ unsigned off_b(unsigned row, unsigned ch) { return 256u * row + 16u * (ch ^ (((row & 3) << 2) | ((row >> 2) & 3))); }
__device__ __forceinline__ void glds16_asm(const void* gsrc, unsigned lds_dst) {
  unsigned keep;
  asm volatile("s_mov_b32 %0, m0\n\ts_mov_b32 m0, %2\n\ts_nop 0\n\tglobal_load_lds_dwordx4 %1, off\n\ts_mov_b32 m0, %0" : "=&s"(keep) : "v"(gsrc), "s"(lds_dst) : "memory");
}
__device__ __forceinline__ void wave_lds_sync() { asm volatile("s_waitcnt lgkmcnt(0)" ::: "memory"); }
typedef unsigned short u16x4 __attribute__((ext_vector_type(4)));
typedef unsigned short u16x8 __attribute__((ext_vector_type(8)));

typedef short s16x4 __attribute__((ext_vector_type(4)));
__device__ __forceinline__ s16x4 lds_tr(const LAS unsigned char* ptr) { return __builtin_amdgcn_ds_read_tr16_b64_v4i16((LAS s16x4*)ptr); }
__device__ __forceinline__ bf16x8 cat4(s16x4 a, s16x4 b) { return __builtin_shufflevector(a, b, 0, 1, 2, 3, 4, 5, 6, 7); }
__device__ __forceinline__ f32x4 mfma16(bf16x8 a, bf16x8 b, f32x4 c) { return __builtin_amdgcn_mfma_f32_16x16x32_bf16(a, b, c, 0, 0, 0); }

__device__ __forceinline__ void wave_find_bin(const unsigned (&c)[4], unsigned need, int lane, unsigned& bin, unsigned& above) {
  const unsigned tot = c[0] + c[1] + c[2] + c[3];
  unsigned cum = wave_incl_scan(tot) - tot;
  unsigned fb = 0xffffffffu, fa = 0;
#pragma unroll
  for (int i = 0; i < 4; ++i) { if (fb == 0xffffffffu && cum < need && cum + c[i] >= need) { fb = 255u - 4u * lane - i; fa = cum; } cum += c[i]; }
  const unsigned long long m = __ballot(fb != 0xffffffffu);
  const int src = m ? (int)__builtin_ctzll(m) : 0;
  bin = (unsigned)__builtin_amdgcn_readlane((int)fb, src); above = (unsigned)__builtin_amdgcn_readlane((int)fa, src);
  if (!m) { bin = 0; above = 0; }
}

__device__ __forceinline__ void attn_tile(const Params& p, const int layer, LAS unsigned char* lds, const bool is_meta, const int b, const int j,
                                          const bf16_t* wukT, const bf16_t* wuvT, const bool dry = false) {
  int tid_ = threadIdx.x; asm volatile("" : "+v"(tid_));
  const int tid = tid_, wid = __builtin_amdgcn_readfirstlane(tid >> 6), lane = tid & 63, fr = lane & 15, g = lane >> 4;
  const int t0 = 16 * j; const size_t r0 = is_meta ? 0 : (size_t)b * S + t0;
  const bf16_t* cNb = p.cN + (size_t)b * S * 128;
  LAS int* nselp = (LAS int*)(lds + A_NSEL);
  TS_ACC_BEGIN();
  if (!is_meta && j >= 16) {
    for (int rep_ = 0; rep_ <= PROBE_REP_SCORE; ++rep_) {
      bf16x8 qH[4][2], qL[4][2];
      const bf16_t* qh = p.qiH + (r0 + fr) * 256 + g * 8; const bf16_t* ql = p.qiL + (r0 + fr) * 256 + g * 8;
#pragma unroll
      for (int h = 0; h < 4; ++h)
#pragma unroll
        for (int ks = 0; ks < 2; ++ks) { qH[h][ks] = *(const bf16x8*)(qh + h * 64 + ks * 32); qL[h][ks] = IDX_SPLIT ? *(const bf16x8*)(ql + h * 64 + ks * 32) : qH[h][ks]; }
      const f32x4 w = *(const f32x4*)(p.wi + (r0 + fr) * 4);
      const int tq = t0 + fr;
      LAS unsigned* h1 = (LAS unsigned*)(lds + A_HIST) + fr * 257;
      const bf16_t* kbh = p.kiH + (size_t)b * S * 64 + lane * 8; const bf16_t* kbl = p.kiL + (size_t)b * S * 64 + lane * 8;
      bf16x8 nH[2], nL[2], mH[2], mL[2];
      if (wid <= j) {
#pragma unroll
        for (int ks = 0; ks < 2; ++ks) { nH[ks] = *(const bf16x8*)(kbh + (size_t)wid * 1024 + ks * 512); nL[ks] = IDX_SPLIT ? *(const bf16x8*)(kbl + (size_t)wid * 1024 + ks * 512) : nH[ks]; }
      }
      if (wid + 8 <= j) {
#pragma unroll
        for (int ks = 0; ks < 2; ++ks) { mH[ks] = *(const bf16x8*)(kbh + (size_t)(wid + 8) * 1024 + ks * 512); mL[ks] = IDX_SPLIT ? *(const bf16x8*)(kbl + (size_t)(wid + 8) * 1024 + ks * 512) : mH[ks]; }
      }
      for (int kt = wid; kt <= j; kt += 8) {
        bf16x8 kH[2], kL[2];
#pragma unroll
        for (int ks = 0; ks < 2; ++ks) { kH[ks] = nH[ks]; kL[ks] = nL[ks]; nH[ks] = mH[ks]; nL[ks] = mL[ks]; }
        if (kt + 16 <= j) {
#pragma unroll
          for (int ks = 0; ks < 2; ++ks) { mH[ks] = *(const bf16x8*)(kbh + (size_t)(kt + 16) * 1024 + ks * 512); mL[ks] = IDX_SPLIT ? *(const bf16x8*)(kbl + (size_t)(kt + 16) * 1024 + ks * 512) : mH[ks]; }
        }
        f32x4 sc = (f32x4){0.f, 0.f, 0.f, 0.f};
#pragma unroll
        for (int h = 0; h < 4; ++h) {
          f32x4 a = (f32x4){0.f, 0.f, 0.f, 0.f};
#pragma unroll
          for (int ks = 0; ks < 2; ++ks) { if (!(ABL_SCORE == 2 && rep_ < PROBE_REP_SCORE)) a = mfma16(kH[ks], qH[h][ks], a); if (IDX_SPLIT && !(ABL_SCORE >= 1 && rep_ < PROBE_REP_SCORE)) { a = mfma16(kL[ks], qH[h][ks], a); a = mfma16(kH[ks], qL[h][ks], a); } }
#pragma unroll
          for (int i = 0; i < 4; ++i) sc[i] = fmaf(w[h], fmaxf(a[i], 0.f), sc[i]);
        }
        u16x4 kk;
#pragma unroll
        for (int i = 0; i < 4; ++i) { const int s = kt * 16 + 4 * g + i; const unsigned k16 = f2key(sc[i]) >> 16; const bool ok = s <= tq; kk[i] = ok ? (unsigned short)k16 : (unsigned short)0;
          if (rep_ == PROBE_REP_SCORE && ok) __hip_atomic_fetch_add(h1 + (k16 >> 8), 1u, __ATOMIC_RELAXED, __HIP_MEMORY_SCOPE_WORKGROUP); }
        *(LAS u16x4*)(lds + A_BIG + fr * K16_STRIDE + (kt * 16 + 4 * g) * 2) = kk;
      }
    }
    TS_ACC(32);
    __syncthreads();
    TS_ACC(33);
    const int nkeys = 16 * (j + 1);
    LAS unsigned short* cand = (LAS unsigned short*)(lds + A_CAND + wid * 128);
    for (int rep_ = 0; rep_ <= PROBE_REP_SELECT; ++rep_)
    for (int qq = 0; qq < 2; ++qq) {
      const int qi = wid + 8 * qq;
      const LAS unsigned char* Kq = lds + A_BIG + qi * K16_STRIDE;
      LAS unsigned short* sel = (LAS unsigned short*)(lds + A_SEL + qi * 512);
      const int nit = (nkeys + 511) >> 9;
      const size_t qrow = r0 + qi;
      bf16x8 bqH[2], bqL[2];
#pragma unroll
      for (int ks = 0; ks < 2; ++ks) { bqH[ks] = fr < 4 ? *(const bf16x8*)(p.qiH + qrow * 256 + (fr & 3) * 64 + ks * 32 + g * 8) : (bf16x8){0, 0, 0, 0, 0, 0, 0, 0};
        bqL[ks] = (IDX_SPLIT && fr < 4) ? *(const bf16x8*)(p.qiL + qrow * 256 + (fr & 3) * 64 + ks * 32 + g * 8) : (bf16x8){0, 0, 0, 0, 0, 0, 0, 0}; }
      const f32x4 wq = *(const f32x4*)(p.wi + qrow * 4);
      LAS unsigned* hist = (LAS unsigned*)(lds + A_HIST) + qi * 257;
      unsigned c4[4];
#pragma unroll
      for (int i = 0; i < 4; ++i) c4[i] = hist[255 - 4 * lane - i];
      unsigned B1, above1; wave_find_bin(c4, (unsigned)TOPK, lane, B1, above1);
      wave_lds_sync();
      TS_ACC(48);
      u16x8 kr[8];
#pragma unroll
      for (int it = 0; it < 8; ++it) { const int base = (it * 64 + lane) * 8; kr[it] = (u16x8){0, 0, 0, 0, 0, 0, 0, 0}; if (it < nit && base < nkeys) kr[it] = *(const LAS u16x8*)(Kq + base * 2); }
#pragma unroll
      for (int i = 0; i < 4; ++i) hist[lane * 4 + i] = 0u;
      wave_lds_sync();
#pragma unroll
      for (int it = 0; it < 8; ++it) if (it < nit) {
#pragma unroll
        for (int e = 0; e < 8; ++e) if ((unsigned)(kr[it][e] >> 8) == B1) __hip_atomic_fetch_add(hist + (kr[it][e] & 255), 1u, __ATOMIC_RELAXED, __HIP_MEMORY_SCOPE_WORKGROUP);
      }
      wave_lds_sync();
#pragma unroll
      for (int i = 0; i < 4; ++i) c4[i] = hist[255 - 4 * lane - i];
      unsigned B2, above2; wave_find_bin(c4, (unsigned)TOPK - above1, lane, B2, above2);
      const unsigned T16 = (B1 << 8) | B2; const unsigned ngt = above1 + above2; const unsigned need = (unsigned)TOPK - ngt;
      TS_ACC(49);
      unsigned cg = 0, ce = 0;
#pragma unroll
      for (int it = 0; it < 8; ++it) if (it < nit) {
#pragma unroll
        for (int e = 0; e < 8; ++e) { cg += (unsigned)kr[it][e] > T16 ? 1u : 0u; ce += (unsigned)kr[it][e] == T16 ? 1u : 0u; }
      }
      const unsigned ig = wave_incl_scan(cg), ie = wave_incl_scan(ce);
      unsigned og = ig - cg, oe = ie - ce;
      const unsigned pos_eq = (unsigned)__builtin_amdgcn_readlane((int)ie, 63);
      TS_ACC(50);
      const bool slowpath = (T16 == 0x8000u || pos_eq > 64u);
#pragma unroll
      for (int it = 0; it < 8; ++it) if (it < nit) {
        const int base = (it * 64 + lane) * 8;
#pragma unroll
        for (int e = 0; e < 8; ++e) if ((unsigned)kr[it][e] == T16) { if (oe < 64u) cand[oe] = (unsigned short)(base + e); ++oe; }
      }
      wave_lds_sync();
      const int c = slowpath ? 0 : (int)pos_eq;
      const int myidx = lane < c ? (int)cand[lane] : 0;
      const int npass = (c + 15) >> 4;
      bf16x8 rkH[4][2], rkL[4][2];
#pragma unroll
      for (int pb = 0; pb < 4; ++pb) if (pb < npass) {
        const int ci = pb * 16 + fr; const int kidx_ = ci < c ? (int)cand[ci] : 0; const size_t krow = (size_t)b * S + kidx_;
#pragma unroll
        for (int ks = 0; ks < 2; ++ks) { rkH[pb][ks] = *(const bf16x8*)(p.kiH + kfrag(krow, ks * 32 + g * 8)); rkL[pb][ks] = IDX_SPLIT ? *(const bf16x8*)(p.kiL + kfrag(krow, ks * 32 + g * 8)) : rkH[pb][ks]; }
      }
#pragma unroll
      for (int it = 0; it < 8; ++it) if (it < nit) {
        const int base = (it * 64 + lane) * 8;
#pragma unroll
        for (int e = 0; e < 8; ++e) if ((unsigned)kr[it][e] > T16) { sel[og] = (unsigned short)(base + e); ++og; }
      }
      wave_lds_sync();
      TS_ACC(51);
      if (slowpath) {
        unsigned taken = 0;
        for (int s0 = 0; s0 < nkeys && taken < need; s0 += 64) {
          const int s = s0 + lane; const bool eq = s < nkeys && (unsigned)(*(const LAS unsigned short*)(Kq + s * 2)) == T16;
          const unsigned long long me = __ballot(eq);
          const unsigned o = taken + __builtin_amdgcn_mbcnt_hi((unsigned)(me >> 32), __builtin_amdgcn_mbcnt_lo((unsigned)me, 0u));
          if (eq && o < need) sel[ngt + o] = (unsigned short)s;
          taken += (unsigned)__popcll(me);
        }
      } else {
        const float wl_ = (fr & 3) == 0 ? wq[0] : (fr & 3) == 1 ? wq[1] : (fr & 3) == 2 ? wq[2] : wq[3];
        LAS float* scr = (LAS float*)hist;
#pragma unroll
        for (int pb = 0; pb < 4; ++pb) if (pb < npass) {
          f32x4 dacc = (f32x4){0.f, 0.f, 0.f, 0.f};
#pragma unroll
          for (int ks = 0; ks < 2; ++ks) { dacc = mfma16(rkH[pb][ks], bqH[ks], dacc); if (IDX_SPLIT) { dacc = mfma16(rkL[pb][ks], bqH[ks], dacc); dacc = mfma16(rkH[pb][ks], bqL[ks], dacc); } }
          f32x4 v;
#pragma unroll
          for (int i = 0; i < 4; ++i) { float t_ = fr < 4 ? wl_ * fmaxf(dacc[i], 0.f) : 0.f; t_ += dppf<0xB1>(t_); t_ += dppf<0x4E>(t_); v[i] = t_; }
          if (fr == 0) *(LAS f32x4*)(scr + pb * 16 + 4 * g) = v;
        }
        wave_lds_sync();
        const float sc = scr[lane];
        int rank = 0;
        for (int jj = 0; jj < c; ++jj) {
          const float sj = __uint_as_float(__builtin_amdgcn_readlane(__float_as_uint(sc), jj)); const int ij = __builtin_amdgcn_readlane(myidx, jj);
          rank += (sj > sc || (sj == sc && ij < myidx)) ? 1 : 0;
        }
        if (lane < c && (unsigned)rank < need) sel[ngt + rank] = (unsigned short)myidx;
        wave_lds_sync();
      }
      TS_ACC(52);
      if (rep_ == PROBE_REP_SELECT) {
#pragma unroll
        for (int i = 0; i < 4; ++i) hist[lane * 4 + i] = 0u;
      }
      if (lane == 0) nselp[qi] = TOPK;
      wave_lds_sync();
    }
  } else if (!is_meta) {
    for (int i = tid; i < 16 * 256; i += NTHREADS) { const int qi = i >> 8, s = i & 255; ((LAS unsigned short*)(lds + A_SEL))[i] = (unsigned short)(s <= t0 + qi ? s : 0); }
    if (tid < 16) nselp[tid] = t0 + tid + 1;
  } else {
    if (tid < 16) nselp[tid] = 0;
  }
  TS_ACC(34);
  __syncthreads();
  TS_ACC(35);
  {
    const bf16_t* qa = (is_meta ? p.qam : p.qa) + (r0 + fr) * 512 + wid * 64 + g * 8;
    bf16x8 bq[2];
#pragma unroll
    for (int ks = 0; ks < 2; ++ks) bq[ks] = *(const bf16x8*)(qa + ks * 32);
    const bf16_t* wk = wukT + ((size_t)wid * 128 + fr) * 64 + g * 8;
#pragma unroll
    for (int mt = 0; mt < 8; ++mt) {
      f32x4 a = (f32x4){0.f, 0.f, 0.f, 0.f};
#pragma unroll
      for (int ks = 0; ks < 2; ++ks) a = mfma16(*(const bf16x8*)(wk + (size_t)mt * 16 * 64 + ks * 32), bq[ks], a);
      u32x2 w2; w2.x = pack_bf16(a[0], a[1]); w2.y = pack_bf16(a[2], a[3]);
      *(LAS u32x2*)(lds + A_BIG + ((fr * 8 + wid) * 128 + mt * 16 + 4 * g) * 2) = w2;
    }
  }
  __syncthreads();
  bf16x8 qf_[2][4];
#pragma unroll
  for (int qq = 0; qq < 2; ++qq)
#pragma unroll
    for (int ks = 0; ks < 4; ++ks) {
      const bf16x8 v = *(const LAS bf16x8*)(lds + A_BIG + (((wid + 8 * qq) * 8 + (fr & 7)) * 128 + ks * 32 + g * 8) * 2);
      qf_[qq][ks] = fr < 8 ? v : (bf16x8){0, 0, 0, 0, 0, 0, 0, 0};
    }
  __syncthreads();
  TS_ACC(36);
  const LAS float* rb = (const LAS float*)(lds + A_RB);
  const LAS unsigned char* bkt = lds + A_BKT;
  f32x4 O[2][8];
  float linv[2];
  LAS unsigned char* gbuf = lds + A_BIG + wid * 16384;
  const unsigned gbase_u = (unsigned)__builtin_amdgcn_readfirstlane((int)(unsigned)(size_t)gbuf);
  const unsigned gq = (lane & 15) >> 2, gp = lane & 3;
  for (int rep_ = 0; rep_ <= PROBE_REP_ATT; ++rep_)
#pragma unroll
  for (int qq = 0; qq < 2; ++qq) {
    const int qi = wid + 8 * qq; const int nsel = nselp[qi];
    const int epos = is_meta ? qi : NM + t0 + qi;
    const LAS unsigned short* sel = (const LAS unsigned short*)(lds + A_SEL + qi * 512);
#pragma unroll
    for (int ct = 0; ct < 8; ++ct) O[qq][ct] = (f32x4){0.f, 0.f, 0.f, 0.f};
    float mrun = -INFINITY, lrun = 0.f;
    const int nch = (nsel + 31) >> 5;
#define ISSUE_GATHER(ch_) do { const unsigned dst_ = gbase_u + (unsigned)(((ch_) & 1) * 8192); \
      int idxs_[8]; \
      _Pragma("unroll") for (int i_ = 0; i_ < 8; ++i_) { const int si_ = (ch_) * 32 + 4 * i_ + g; const int v_ = (int)sel[si_ < 255 ? si_ : 255]; idxs_[i_] = si_ < nsel ? v_ : 0; } \
      asm volatile("s_waitcnt lgkmcnt(0)" ::: "memory"); \
      _Pragma("unroll") for (int i_ = 0; i_ < 8; ++i_) { \
        const int row_ = 4 * i_ + g; const unsigned f_ = (((unsigned)row_ & 3u) << 2) | (((unsigned)row_ >> 2) & 3u); \
        const bf16_t* src_ = cNb + (size_t)idxs_[i_] * 128 + (((unsigned)fr ^ f_) * 8); \
        glds16_asm(src_, dst_ + (unsigned)(i_ * 1024)); } } while (0)
    if (nch > 0) ISSUE_GATHER(0);
    if (nch > 1) ISSUE_GATHER(1);
    {
      f32x4 s0 = (f32x4){0.f, 0.f, 0.f, 0.f};
#pragma unroll
      for (int ks = 0; ks < 4; ++ks) s0 = mfma16(*(const LAS bf16x8*)(lds + A_CM + off_b(fr, 4 * ks + g)), qf_[qq][ks], s0);
      float lg[4]; float mx = -INFINITY;
#pragma unroll
      for (int i = 0; i < 4; ++i) { const int m = 4 * g + i; const int dist = epos - m; const bool valid = !is_meta || m <= qi;
        const int dcl = dist < 0 ? 0 : (dist > 127 ? 127 : dist); const int bkv = (int)bkt[dcl]; const int bk = dist >= 128 ? 31 : bkv;
        const float bias = rb[bk * 8 + (fr & 7)]; const float lv = s0[i] * 0.125f + bias;
        lg[i] = valid ? lv : -INFINITY; mx = fmaxf(mx, lg[i]); }
      mx = rows_max(mx);
      mrun = mx; float ps = 0.f; float pv[4];
#pragma unroll
      for (int i = 0; i < 4; ++i) { pv[i] = __expf(lg[i] - mrun); ps += pv[i]; }
      ps = rows_sum(ps); lrun = ps;
      bf16x8 pf; { const unsigned a0 = pack_bf16(pv[0], pv[1]), a1 = pack_bf16(pv[2], pv[3]); u32x4 t; t.x = a0; t.y = a1; t.z = 0u; t.w = 0u; pf = __builtin_bit_cast(bf16x8, t); }
      {
        s16x4 tm[8];
#pragma unroll
        for (int ct = 0; ct < 8; ++ct) tm[ct] = lds_tr(lds + A_CM + off_b(4 * g + gq, 2 * ct + (gp >> 1)) + 8 * (gp & 1));
        const s16x4 z4 = (s16x4){0, 0, 0, 0};
#pragma unroll
        for (int ct = 0; ct < 8; ++ct) O[qq][ct] = mfma16(cat4(tm[ct], z4), pf, O[qq][ct]);
      }
    }
    for (int ch = 0; ch < nch; ++ch) {
      if (ch + 1 < nch) asm volatile("s_waitcnt vmcnt(8)" ::: "memory"); else asm volatile("s_waitcnt vmcnt(0)" ::: "memory");
      const LAS unsigned char* buf = gbuf + (ch & 1) * 8192;
      f32x4 sA = (f32x4){0.f, 0.f, 0.f, 0.f}, sB = (f32x4){0.f, 0.f, 0.f, 0.f};
#pragma unroll
      for (int ks = 0; ks < 4; ++ks) {
        sA = mfma16(*(const LAS bf16x8*)(buf + off_b(fr, 4 * ks + g)), qf_[qq][ks], sA);
        sB = mfma16(*(const LAS bf16x8*)(buf + off_b(fr + 16, 4 * ks + g)), qf_[qq][ks], sB);
      }
      const u16x4 iA = *(const LAS u16x4*)(sel + ch * 32 + 4 * g); const u16x4 iB = *(const LAS u16x4*)(sel + ch * 32 + 16 + 4 * g);
      float lg[8]; float mx = -INFINITY;
#pragma unroll
      for (int i = 0; i < 8; ++i) {
        const int slot = ch * 32 + (i < 4 ? 4 * g + i : 16 + 4 * g + (i - 4)); const int kidx = i < 4 ? (int)iA[i] : (int)iB[i - 4];
        const int dist = t0 + qi - kidx; const int dcl = dist < 0 ? 0 : (dist > 127 ? 127 : dist); const int bkv = (int)bkt[dcl]; const int bk = dist >= 128 ? 31 : bkv;
        const float sv = i < 4 ? sA[i] : sB[i - 4];
        const float bias = rb[bk * 8 + (fr & 7)]; const float lv = sv * 0.125f + bias;
        lg[i] = slot < nsel ? lv : -INFINITY; mx = fmaxf(mx, lg[i]);
      }
      mx = rows_max(mx);
      const float mnew = fmaxf(mrun, mx); const float alpha = __expf(mrun - mnew); mrun = mnew;
      float pv[8]; float ps = 0.f;
#pragma unroll
      for (int i = 0; i < 8; ++i) { pv[i] = __expf(lg[i] - mnew); ps += pv[i]; }
      ps = rows_sum(ps); lrun = lrun * alpha + ps;
#pragma unroll
      for (int ct = 0; ct < 8; ++ct) O[qq][ct] *= alpha;
      bf16x8 pf; { u32x4 t; t.x = pack_bf16(pv[0], pv[1]); t.y = pack_bf16(pv[2], pv[3]); t.z = pack_bf16(pv[4], pv[5]); t.w = pack_bf16(pv[6], pv[7]); pf = __builtin_bit_cast(bf16x8, t); }
      {
        s16x4 ta[8], tb[8];
#pragma unroll
        for (int ct = 0; ct < 8; ++ct) { ta[ct] = lds_tr(buf + off_b(4 * g + gq, 2 * ct + (gp >> 1)) + 8 * (gp & 1)); tb[ct] = lds_tr(buf + off_b(16 + 4 * g + gq, 2 * ct + (gp >> 1)) + 8 * (gp & 1)); }
#pragma unroll
        for (int ct = 0; ct < 8; ++ct) O[qq][ct] = mfma16(cat4(ta[ct], tb[ct]), pf, O[qq][ct]);
      }
      if (ch + 2 < nch) ISSUE_GATHER(ch + 2);
    }
    linv[qq] = 1.0f / lrun;
  }
  TS_ACC(37);
  asm volatile("s_waitcnt vmcnt(0) lgkmcnt(0)" ::: "memory");
#pragma unroll
  for (int qq = 0; qq < 2; ++qq)
    if (fr < 8) {
#pragma unroll
      for (int ct = 0; ct < 8; ++ct) { const f32x4 o = O[qq][ct] * linv[qq]; u32x2 w2; w2.x = pack_bf16(o[0], o[1]); w2.y = pack_bf16(o[2], o[3]);
        *(LAS u32x2*)(gbuf + qq * 2048 + (fr * 128 + ct * 16 + 4 * g) * 2) = w2; }
    }
  __syncthreads();
  TS_ACC(38);
  {
    bf16x8 bo[4];
#pragma unroll
    for (int ks = 0; ks < 4; ++ks) bo[ks] = *(const LAS bf16x8*)(lds + A_BIG + (fr & 7) * 16384 + (fr >> 3) * 2048 + (wid * 128 + ks * 32 + g * 8) * 2);
    const bf16_t* wv = wuvT + ((size_t)wid * 64 + fr) * 128 + g * 8;
    bf16_t* grow = (is_meta ? p.gatesm : p.gates) + (r0 + fr) * 1024 + wid * 64 + 4 * g;
#pragma unroll
    for (int nt = 0; nt < 4; ++nt) {
      f32x4 a = (f32x4){0.f, 0.f, 0.f, 0.f};
#pragma unroll
      for (int ks = 0; ks < 4; ++ks) a = mfma16(*(const bf16x8*)(wv + (size_t)nt * 16 * 128 + ks * 32), bo[ks], a);
      const u32x2 gt = *(const u32x2*)(grow + nt * 16);
      const float g0 = __uint_as_float(gt.x << 16), g1 = __uint_as_float(gt.x & 0xffff0000u), g2 = __uint_as_float(gt.y << 16), g3 = __uint_as_float(gt.y & 0xffff0000u);
      u32x2 w2; w2.x = pack_bf16(a[0] * g0, a[1] * g1); w2.y = pack_bf16(a[2] * g2, a[3] * g3);
      *(u32x2*)((dry ? p.dummy + (r0 + fr) * 1024 + wid * 64 + 4 * g : grow) + nt * 16) = w2;
    }
  }
  __syncthreads();
  TS_ACC(39);
}

__device__ __forceinline__ void phase_attn(const Params& p, int layer, LAS unsigned char* lds, int ablk, int nablk, bool do_meta, const bool dry = false) {
  int tid_ = threadIdx.x; asm volatile("" : "+v"(tid_));
  const int tid = tid_;
  if (tid < 256) { const int row = tid >> 4, ch = tid & 15; *(LAS u32x4*)(lds + A_CM + off_b(row, ch)) = *(const u32x4*)(p.cNm + row * 128 + ch * 8); }
  if (tid < 256) ((LAS float*)(lds + A_RB))[tid] = p.rel_bias[tid];
  if (tid < 128) (lds + A_BKT)[tid] = c_bucket[tid];
  for (int i = tid; i < 16 * 257; i += NTHREADS) ((LAS unsigned*)(lds + A_HIST))[i] = 0u;
  __syncthreads();
  const bf16_t* wukT = p.wukT + (size_t)layer * 8 * 128 * 64; const bf16_t* wuvT = p.wuvT + (size_t)layer * 8 * 64 * 128;
  if ((nablk & 7) == 0 && (gridDim.x & 7) == 0) {
    const int xb = blockIdx.x & 7, nper = nablk >> 3, rank = ablk >> 3;
    for (int k = 0;; ++k) {
      const int idx = k * nper + ((k & 1) ? nper - 1 - rank : rank);
      if (idx >= 256) break;
      attn_tile(p, layer, lds, false, xb, 255 - idx, wukT, wuvT, dry);
    }
  } else {
    for (int item = ablk; item < NB * 256; item += nablk) {
      const int j = 255 - item / NB, b = item % NB;
      attn_tile(p, layer, lds, false, b, j, wukT, wuvT, dry);
    }
  }
  if (do_meta && !dry && ablk == nablk - 1) attn_tile(p, layer, lds, true, 0, 0, wukT, wuvT);
}

constexpr int H_QT = 0, H_KH = 8192, H_KT = 16384, H_VV = 24576, H_DEC = 32768, H_PART = 32768 + 512;

__device__ __forceinline__ void phase_hgrn(const Params& p, const int layer, LAS unsigned char* lds, const int hblk, const bool dry = false) {
  int tid_ = threadIdx.x; asm volatile("" : "+v"(tid_));
  const int tid = tid_, wid = __builtin_amdgcn_readfirstlane(tid >> 6), lane = tid & 63, fr = lane & 15, g = lane >> 4;
  const int b = hblk >> 2, h = hblk & 3;
  const unsigned gq = (lane & 15) >> 2, gp = lane & 3;
  f32x4 Sacc[8];
#pragma unroll
  for (int kt = 0; kt < 8; ++kt) Sacc[kt] = (f32x4){0.f, 0.f, 0.f, 0.f};
  const float gn = p.hng[layer * 128 + wid * 16 + fr];
  const int sk = wid * 16 + (lane & 15), stg = lane >> 4;
  const int vrow = tid >> 4, vch = tid & 15;
  const int otok[2] = {4 * g, 16 + 4 * g};
  float n_gv[8]; unsigned short n_q[8]; u32x4 n_v; unsigned short n_gate[8];
  {
#pragma unroll
    for (int i = 0; i < 8; ++i) {
      const int t = 8 * stg + i;
      n_gv[i] = t < NM ? p.glm[(size_t)t * 512 + h * 128 + sk] : 0.f;
      n_q[i] = t < NM ? p.qfm[(size_t)t * 512 + h * 128 + sk] : (unsigned short)0;
    }
    n_v = vrow < NM ? *(const u32x4*)(p.vvm + (size_t)vrow * 512 + h * 128 + vch * 8) : (u32x4){0u, 0u, 0u, 0u};
#pragma unroll
    for (int mt = 0; mt < 2; ++mt)
#pragma unroll
      for (int i = 0; i < 4; ++i) { const int t = otok[mt] + i; n_gate[mt * 4 + i] = t < NM ? p.gatesm[(size_t)t * 1024 + 512 + h * 128 + wid * 16 + fr] : (unsigned short)0; }
  }
  for (int step = 0; step <= S / 32; ++step) {
    const bool im = step == 0;
    const size_t rbase = im ? 0 : (size_t)b * S + (size_t)(step - 1) * 32;
    bf16_t* gt = (im ? p.gatesm : p.gates) + rbase * 1024 + 512 + h * 128;
    TS_ACC_BEGIN();
    float gv[8], qv[8];
#pragma unroll
    for (int i = 0; i < 8; ++i) { gv[i] = n_gv[i]; qv[i] = bf2f(n_q[i]); }
    const u32x4 vraw = n_v;
    float gate[8];
#pragma unroll
    for (int i = 0; i < 8; ++i) gate[i] = bf2f(n_gate[i]);
    if (step < S / 32) {
      const size_t rn = (size_t)b * S + (size_t)step * 32;
#pragma unroll
      for (int i = 0; i < 8; ++i) { n_gv[i] = p.gl[(rn + 8 * stg + i) * 512 + h * 128 + sk]; n_q[i] = p.qf[(rn + 8 * stg + i) * 512 + h * 128 + sk]; }
      n_v = *(const u32x4*)(p.vv + (rn + vrow) * 512 + h * 128 + vch * 8);
#pragma unroll
      for (int mt = 0; mt < 2; ++mt)
#pragma unroll
        for (int i = 0; i < 4; ++i) n_gate[mt * 4 + i] = p.gates[(rn + otok[mt] + i) * 1024 + 512 + h * 128 + wid * 16 + fr];
    }
    {
      float bc[8]; bc[0] = gv[0];
#pragma unroll
      for (int i = 1; i < 8; ++i) bc[i] = bc[i - 1] + gv[i];
      float x = bc[7];
      { const float u = __shfl_up(x, 16); if (lane >= 16) x += u; }
      { const float u = __shfl_up(x, 32); if (lane >= 32) x += u; }
      const float ex = x - bc[7];
      const float bl = __shfl(x, 48 + (lane & 15));
#pragma unroll
      for (int i = 0; i < 8; ++i) {
        const float bci = bc[i] + ex;
        const float kc = 1.0f - __expf(gv[i]);
        const float qt = qv[i] * __expf(bci), khv = kc * __expf(fminf(-bci, 80.f)), ktv = kc * __expf(bl - bci);
        const unsigned o1 = off_b(8 * stg + i, sk >> 3) + (sk & 7) * 2;
        *(LAS unsigned short*)(lds + H_QT + o1) = f2bf_fast(qt); *(LAS unsigned short*)(lds + H_KH + o1) = f2bf_fast(khv); *(LAS unsigned short*)(lds + H_KT + o1) = f2bf_fast(ktv);
      }
      if (stg == 3) *(LAS float*)(lds + H_DEC + sk * 4) = __expf(bl);
      *(LAS u32x4*)(lds + H_VV + off_b(vrow, vch)) = vraw;
    }
    TS_ACC(40);
    __syncthreads();
    TS_ACC(41);
    f32x4 o[2] = {(f32x4){0.f, 0.f, 0.f, 0.f}, (f32x4){0.f, 0.f, 0.f, 0.f}};
    {
      f32x4 s00 = (f32x4){0.f, 0.f, 0.f, 0.f}, s01 = s00, s11 = s00;
      {
        bf16x8 aK0[4], aK1[4], aQ0[4], aQ1[4];
#pragma unroll
        for (int ks = 0; ks < 4; ++ks) {
          aK0[ks] = *(const LAS bf16x8*)(lds + H_KH + off_b(fr, 4 * ks + g)); aK1[ks] = *(const LAS bf16x8*)(lds + H_KH + off_b(16 + fr, 4 * ks + g));
          aQ0[ks] = *(const LAS bf16x8*)(lds + H_QT + off_b(fr, 4 * ks + g)); aQ1[ks] = *(const LAS bf16x8*)(lds + H_QT + off_b(16 + fr, 4 * ks + g));
        }
#pragma unroll
        for (int ks = 0; ks < 4; ++ks) { s00 = mfma16(aK0[ks], aQ0[ks], s00); s01 = mfma16(aK0[ks], aQ1[ks], s01); s11 = mfma16(aK1[ks], aQ1[ks], s11); }
      }
#pragma unroll
      for (int ks = 0; ks < 4; ++ks) {
        u32x4 bv; bv.x = pack_bf16(Sacc[2 * ks][0], Sacc[2 * ks][1]); bv.y = pack_bf16(Sacc[2 * ks][2], Sacc[2 * ks][3]);
        bv.z = pack_bf16(Sacc[2 * ks + 1][0], Sacc[2 * ks + 1][1]); bv.w = pack_bf16(Sacc[2 * ks + 1][2], Sacc[2 * ks + 1][3]);
#pragma unroll
        for (int mt = 0; mt < 2; ++mt) {
          const u32x2 a0 = *(const LAS u32x2*)(lds + H_QT + off_b(16 * mt + fr, 4 * ks + (g >> 1)) + (g & 1) * 8);
          const u32x2 a1 = *(const LAS u32x2*)(lds + H_QT + off_b(16 * mt + fr, 4 * ks + 2 + (g >> 1)) + (g & 1) * 8);
          u32x4 av; av.x = a0.x; av.y = a0.y; av.z = a1.x; av.w = a1.y;
          o[mt] = mfma16(__builtin_bit_cast(bf16x8, av), __builtin_bit_cast(bf16x8, bv), o[mt]);
        }
      }
      const s16x4 vt0 = lds_tr(lds + H_VV + off_b(4 * g + gq, 2 * wid + (gp >> 1)) + 8 * (gp & 1));
      const s16x4 vt1 = lds_tr(lds + H_VV + off_b(16 + 4 * g + gq, 2 * wid + (gp >> 1)) + 8 * (gp & 1));
      const bf16x8 bfv = cat4(vt0, vt1);
      {
        float m0[4], m1[4];
#pragma unroll
        for (int i = 0; i < 4; ++i) { const bool keep = (4 * g + i) <= fr; m0[i] = keep ? s00[i] : 0.f; m1[i] = keep ? s11[i] : 0.f; }
        u32x4 a0; a0.x = pack_bf16(m0[0], m0[1]); a0.y = pack_bf16(m0[2], m0[3]); a0.z = 0u; a0.w = 0u;
        u32x4 a1; a1.x = pack_bf16(s01[0], s01[1]); a1.y = pack_bf16(s01[2], s01[3]); a1.z = pack_bf16(m1[0], m1[1]); a1.w = pack_bf16(m1[2], m1[3]);
        o[0] = mfma16(__builtin_bit_cast(bf16x8, a0), bfv, o[0]);
        o[1] = mfma16(__builtin_bit_cast(bf16x8, a1), bfv, o[1]);
      }
#pragma unroll
      for (int kt = 0; kt < 8; ++kt) {
        const s16x4 k0 = lds_tr(lds + H_KT + off_b(4 * g + gq, 2 * kt + (gp >> 1)) + 8 * (gp & 1));
        const s16x4 k1 = lds_tr(lds + H_KT + off_b(16 + 4 * g + gq, 2 * kt + (gp >> 1)) + 8 * (gp & 1));
        const f32x4 dv = *(const LAS f32x4*)(lds + H_DEC + (16 * kt + 4 * g) * 4);
        Sacc[kt] = mfma16(cat4(k0, k1), bfv, Sacc[kt] * dv);
      }
    }
    {
#pragma unroll
      for (int mt = 0; mt < 2; ++mt) {
        f32x4 sq = o[mt] * o[mt];
#pragma unroll
        for (int i = 0; i < 4; ++i) sq[i] = row_sum16(sq[i]);
        if (fr == 0) *(LAS f32x4*)(lds + H_PART + (wid * 32 + otok[mt]) * 4) = sq;
      }
    }
    TS_ACC(42);
    __syncthreads();
    TS_ACC(43);
    if (!im || (b == 0 && layer == 0)) {
      f32x4 pr[2][8];
#pragma unroll
      for (int mt = 0; mt < 2; ++mt)
#pragma unroll
        for (int w = 0; w < 8; ++w) pr[mt][w] = *(const LAS f32x4*)(lds + H_PART + (w * 32 + otok[mt]) * 4);
#pragma unroll
      for (int mt = 0; mt < 2; ++mt) {
        const f32x4 tot = ((pr[mt][0] + pr[mt][1]) + (pr[mt][2] + pr[mt][3])) + ((pr[mt][4] + pr[mt][5]) + (pr[mt][6] + pr[mt][7]));
#pragma unroll
        for (int i = 0; i < 4; ++i) {
          const int t = otok[mt] + i;
          if (!im || t < NM) {
            const float rstd = rsqrtf(tot[i] * (1.0f / 128.0f) + EPS);
            (dry ? p.dummy + rbase * 1024 + 512 + h * 128 : gt)[(size_t)t * 1024 + wid * 16 + fr] = f2bf_fast(o[mt][i] * rstd * gn * gate[mt * 4 + i]);
          }
        }
      }
    }
    TS_ACC(44);
  }
}

constexpr int M_A32T = 0;
constexpr int M_PART = 65536;
template <bool A_BF16>
__device__ __forceinline__ void meta_group_gemm(LAS unsigned char* lds, const void* A, const float* W, const int ldw, const int col0) {
  int tid_ = threadIdx.x; asm volatile("" : "+v"(tid_));
  const int tid = tid_, wid = __builtin_amdgcn_readfirstlane(tid >> 6), lane = tid & 63;
  LAS float* a32 = (LAS float*)(lds + M_A32T); LAS float* part = (LAS float*)(lds + M_PART);
  for (int i = tid; i < 16 * 1024; i += NTHREADS) { const int r = i >> 10, k = i & 1023; a32[k * 16 + r] = A_BF16 ? bf2f(((const bf16_t*)A)[i]) : ((const float*)A)[i]; }
  __syncthreads();
  float acc0[16], acc1[16];
#pragma unroll
  for (int r = 0; r < 16; ++r) { acc0[r] = 0.f; acc1[r] = 0.f; }
  const float* w0p = W + (size_t)(wid * 128) * ldw + col0 + lane;
#pragma unroll 4
  for (int kk = 0; kk < 128; ++kk) {
    const float w0 = w0p[(size_t)kk * ldw], w1 = w0p[(size_t)kk * ldw + 64];
    const LAS f32x4* ar = (const LAS f32x4*)(a32 + (wid * 128 + kk) * 16);
#pragma unroll
    for (int q = 0; q < 4; ++q) { const f32x4 a = ar[q];
#pragma unroll
      for (int j = 0; j < 4; ++j) { acc0[q * 4 + j] = fmaf(a[j], w0, acc0[q * 4 + j]); acc1[q * 4 + j] = fmaf(a[j], w1, acc1[q * 4 + j]); } }
  }
#pragma unroll
  for (int r = 0; r < 16; ++r) { part[(wid * 16 + r) * 128 + lane] = acc0[r]; part[(wid * 16 + r) * 128 + 64 + lane] = acc1[r]; }
  __syncthreads();
  for (int i = tid; i < 2048; i += NTHREADS) { float s = 0.f;
#pragma unroll
    for (int w = 0; w < 8; ++w) s += part[w * 2048 + i]; part[i] = s; }
  __syncthreads();
}


template <bool A_F32, bool SPLIT>
__device__ __forceinline__ void meta_group_mfma(LAS unsigned char* lds, const void* A, const bf16_t* Wt, const int ldw) {
  int tid_ = threadIdx.x; asm volatile("" : "+v"(tid_));
  const int tid = tid_, wid = __builtin_amdgcn_readfirstlane(tid >> 6), lane = tid & 63, fr = lane & 15, g = lane >> 4;
  LAS float* out = (LAS float*)(lds + M_PART);
  const bf16_t* wrow = Wt + (size_t)(wid * 16 + fr) * ldw + g * 8;
  f32x4 acc = (f32x4){0.f, 0.f, 0.f, 0.f};
#pragma unroll 4
  for (int ks = 0; ks < 32; ++ks) {
    bf16x8 ah, al;
    if (A_F32) {
      const f32x4 v0 = *(const f32x4*)((const float*)A + fr * 1024 + ks * 32 + g * 8), v1 = *(const f32x4*)((const float*)A + fr * 1024 + ks * 32 + g * 8 + 4);
      u32x4 h; h.x = pack_bf16(v0[0], v0[1]); h.y = pack_bf16(v0[2], v0[3]); h.z = pack_bf16(v1[0], v1[1]); h.w = pack_bf16(v1[2], v1[3]);
      ah = __builtin_bit_cast(bf16x8, h);
      if (SPLIT) { u32x4 l; l.x = pack_bf16(v0[0] - __uint_as_float(h.x << 16), v0[1] - __uint_as_float(h.x & 0xffff0000u)); l.y = pack_bf16(v0[2] - __uint_as_float(h.y << 16), v0[3] - __uint_as_float(h.y & 0xffff0000u));
        l.z = pack_bf16(v1[0] - __uint_as_float(h.z << 16), v1[1] - __uint_as_float(h.z & 0xffff0000u)); l.w = pack_bf16(v1[2] - __uint_as_float(h.w << 16), v1[3] - __uint_as_float(h.w & 0xffff0000u));
        al = __builtin_bit_cast(bf16x8, l); }
    } else {
      ah = *(const bf16x8*)((const bf16_t*)A + fr * 1024 + ks * 32 + g * 8);
    }
    acc = mfma16(ah, *(const bf16x8*)(wrow + ks * 32), acc);
    if (SPLIT) { acc = mfma16(al, *(const bf16x8*)(wrow + 1024 + ks * 32), acc); acc = mfma16(ah, *(const bf16x8*)(wrow + 2048 + ks * 32), acc); }
  }
#pragma unroll
  for (int i = 0; i < 4; ++i) out[(4 * g + i) * 128 + wid * 16 + fr] = acc[i];
  __syncthreads();
}

__device__ __forceinline__ void meta_inproj_group(const Params& p, const int layer, LAS unsigned char* lds, const int grp) {
  int tid_ = threadIdx.x; asm volatile("" : "+v"(tid_)); const int tid = tid_;
  const float* A = layer == 0 ? p.meta : p.hFm;
  int kind, sub;
  if (grp < 4) { kind = 0; sub = grp; } else if (grp == 4) { kind = 6; sub = 0; } else { kind = 1 + (grp - 5) / 4; sub = (grp - 5) % 4; }
  const int colbase = (kind == 0 ? O_QA : kind == 6 ? O_CKV : kind == 1 ? O_GA : kind == 2 ? O_QH : kind == 3 ? O_FH : kind == 4 ? O_IH : O_GH) + sub * 128;
  (void)colbase;
  if (kind == 6) meta_group_mfma<true, IDX_SPLIT != 0>(lds, A, p.WsT + ((size_t)layer * 512 + 256) * 3072, 3072);
  else meta_group_mfma<true, false>(lds, A, p.WmT + ((size_t)layer * 3072 + (size_t)kind * 512 + sub * 128) * 1024, 1024);
  LAS float* out = (LAS float*)(lds + M_PART);
  LAS float* rs = (LAS float*)(lds + M_PART + 2048 * 4);
  if (kind == 6) {
    if (tid < 16) { float s = 0.f; for (int c = 0; c < 128; ++c) { const float v = out[tid * 128 + c]; s = fmaf(v, v, s); } rs[tid] = rsqrtf(s * (1.0f / 128.0f) + EPS); }
    __syncthreads();
  }
  for (int i = tid; i < 2048; i += NTHREADS) {
    const int r = i >> 7, c = i & 127, cc = sub * 128 + c; const float v = out[i];
    if (kind == 0) p.qam[r * 512 + cc] = f2bf(v);
    else if (kind == 6) p.cNm[r * 128 + c] = f2bf(v * rs[r] * p.kvg[layer * 128 + c]);
    else if (kind == 1) p.gatesm[r * 1024 + cc] = f2bf(fast_silu(v));
    else if (kind == 2) p.qfm[r * 512 + cc] = f2bf(fast_silu(v) * 0.08838834764831845f);
    else if (kind == 3) { const float lb = p.lbv[layer * 512 + cc]; p.glm[r * 512 + cc] = __logf(lb + (1.0f - lb) * fast_sigmoid(v)); }
    else if (kind == 4) p.vvm[r * 512 + cc] = f2bf(v);
    else p.gatesm[r * 1024 + 512 + cc] = f2bf(fast_silu(v));
  }
  __syncthreads();
}
__device__ __forceinline__ void meta_outproj_group(const Params& p, LAS unsigned char* lds, const int grp) {
  int tid_ = threadIdx.x; asm volatile("" : "+v"(tid_)); const int tid = tid_;
  meta_group_mfma<false, false>(lds, p.gatesm, p.WoT + (size_t)grp * 128 * 1024, 1024);
  const LAS float* out = (const LAS float*)(lds + M_PART);
  for (int i = tid; i < 2048; i += NTHREADS) { const int r = i >> 7, c = grp * 128 + (i & 127); p.vm[r * D + c] = DN_ALPHA * p.meta[r * D + c] + out[i]; }
  __syncthreads();
}
__device__ __forceinline__ void meta_ln(const Params& p) {
  int tid_ = threadIdx.x; asm volatile("" : "+v"(tid_)); const int tid = tid_, wid = tid >> 6, lane = tid & 63;
  for (int row = wid; row < NM; row += 8) {
    f32x4 v[4]; float s = 0.f;
#pragma unroll
    for (int i = 0; i < 4; ++i) { v[i] = *(const f32x4*)(p.vm + row * D + (i * 64 + lane) * 4); s += (v[i][0] + v[i][1]) + (v[i][2] + v[i][3]); }
#pragma unroll
    for (int o = 32; o > 0; o >>= 1) s += __shfl_xor(s, o);
    const float mean = s * (1.0f / D); float q = 0.f;
#pragma unroll
    for (int i = 0; i < 4; ++i) { const f32x4 d = v[i] - mean; q += (d[0] * d[0] + d[1] * d[1]) + (d[2] * d[2] + d[3] * d[3]); }
#pragma unroll
    for (int o = 32; o > 0; o >>= 1) q += __shfl_xor(q, o);
    const float rstd = rsqrtf(q * (1.0f / D) + EPS);
#pragma unroll
    for (int i = 0; i < 4; ++i) { const int c = (i * 64 + lane) * 4; *(f32x4*)(p.hFm + row * D + c) = (v[i] - mean) * rstd * *(const f32x4*)(p.ln_g + c) + *(const f32x4*)(p.ln_b + c); }
  }
}


#define XB_TMO      128
#define XB_XCNT(j)  (256  + 64 * (j))
#define XB_XSUB(j)  (1280 + 64 * (j))
#define XB_XGEN(j)  (2304 + 64 * (j))
#define XB_TOP      3328
#define XB_TOPGEN   3392
#define XCD_BAR_WORDS 3456
#define XB_SPIN_CAP (1u << 20)
__device__ __forceinline__ unsigned xb_ld(unsigned* p)              { return __hip_atomic_load(p, __ATOMIC_RELAXED, __HIP_MEMORY_SCOPE_AGENT); }
__device__ __forceinline__ unsigned xb_add(unsigned* p, unsigned v) { return __hip_atomic_fetch_add(p, v, __ATOMIC_RELAXED, __HIP_MEMORY_SCOPE_AGENT); }
__device__ __forceinline__ unsigned xb_xcc_id() { return (unsigned)__builtin_amdgcn_s_getreg((3 << 11) | 20) & 0xFu; }
#define XB_SPIN(cond, bar) do { unsigned _sp = 0; while (cond) { __builtin_amdgcn_s_sleep(1); \
    if ((++_sp & 255u) == 0u) { if (xb_ld(&(bar)[XB_TMO])) break; if (_sp > XB_SPIN_CAP) { atomicAdd(&(bar)[XB_TMO], 1u); break; } } } } while (0)
struct XcdBarrier { unsigned* bar; unsigned x; volatile LAS unsigned* st; };
__device__ __forceinline__ XcdBarrier xcd_barrier_post(unsigned* bar, volatile LAS unsigned* st) {
  XcdBarrier b; b.bar = bar; b.x = xb_xcc_id(); b.st = st;
  if (threadIdx.x == 0) (void)xb_add(&bar[XB_XCNT(b.x)], 1u);
  return b;
}
__device__ __forceinline__ void xcd_barrier_complete(unsigned* bar, unsigned x, unsigned& nloc, unsigned& nx) {
  const unsigned G = gridDim.x * gridDim.y * gridDim.z;
  unsigned sum, cnt, mine, sp = 0u;
  for (;;) {
    sum = 0u; cnt = 0u; mine = 0u;
#pragma unroll
    for (unsigned j = 0; j < 16; ++j) { const unsigned c = xb_ld(&bar[XB_XCNT(j)]); sum += c; cnt += (c > 0u) ? 1u : 0u; mine = (j == x) ? c : mine; }
    if (sum == G) break;
    __builtin_amdgcn_s_sleep(1);
    if ((++sp & 255u) == 0u) { if (xb_ld(&bar[XB_TMO])) break; if (sp > XB_SPIN_CAP) { atomicAdd(&bar[XB_TMO], 1u); break; } }
  }
  nloc = mine > 0u ? mine : 1u; nx = cnt > 0u ? cnt : 1u;
}
__device__ __forceinline__ void xcd_barrier(const XcdBarrier& b) {
  asm volatile("s_waitcnt vmcnt(0)" ::: "memory");
  __syncthreads();
  if (threadIdx.x == 0) {
    unsigned* bar = b.bar;
    __builtin_amdgcn_s_waitcnt(0);
    unsigned nloc = b.st[0], nx = b.st[1];
    if (nloc == 0u) { xcd_barrier_complete(bar, b.x, nloc, nx); b.st[0] = nloc; b.st[1] = nx; }
    const unsigned old = xb_add(&bar[XB_XSUB(b.x)], 1u);
    const unsigned gen = old / nloc;
    if (old + 1u == (gen + 1u) * nloc) {
      __builtin_amdgcn_fence(__ATOMIC_RELEASE, "agent");
      asm volatile("s_waitcnt vmcnt(0)" ::: "memory");
      const unsigned og = xb_add(&bar[XB_TOP], 1u);
      const unsigned tg = og / nx;
      if (og + 1u == (tg + 1u) * nx) xb_add(&bar[XB_TOPGEN], 1u);
      else XB_SPIN(xb_ld(&bar[XB_TOPGEN]) == tg, bar);
      __builtin_amdgcn_fence(__ATOMIC_ACQUIRE, "agent");
      xb_add(&bar[XB_XGEN(b.x)], 1u);
      asm volatile("s_waitcnt vmcnt(0)" ::: "memory");
    } else {
      XB_SPIN(xb_ld(&bar[XB_XGEN(b.x)]) == gen, bar);
      __builtin_amdgcn_fence(__ATOMIC_ACQUIRE, "agent");
      asm volatile("s_waitcnt vmcnt(0)" ::: "memory");
    }
  }
  __syncthreads();
}

constexpr int N_HGRN_BLOCKS = NB * 4;
#ifndef PROBE_REP_PREP
#define PROBE_REP_PREP 0
#endif
#ifndef PROBE_REP_P1
#define PROBE_REP_P1 0
#endif
#ifndef PROBE_REP_P3
#define PROBE_REP_P3 0
#endif
#ifndef PROBE_DRY
#define PROBE_DRY 0
#endif
#ifndef PROBE_SYNC
#define PROBE_SYNC 0
#endif
__global__ void __launch_bounds__(NTHREADS, 2) k_mega(Params p) {
  extern __shared__ __attribute__((aligned(16))) unsigned char smem[];
  LAS unsigned char* lds = (LAS unsigned char*)smem;
  cooperative_groups::grid_group grid = cooperative_groups::this_grid();
  const int bid = blockIdx.x, G = gridDim.x;
  if (threadIdx.x < 4) ((LAS unsigned*)(lds + LDS_BYTES - 16))[threadIdx.x] = 0u;
  __syncthreads();
  const XcdBarrier xbar = xcd_barrier_post(p.bar, (volatile LAS unsigned*)(lds + LDS_BYTES - 16));
#define GRID_BAR() xcd_barrier(xbar)
  if (TPROBE) { for (int i = threadIdx.x; i < 64; i += NTHREADS) p.ts[(size_t)blockIdx.x * 64 + i] = 0ull; __syncthreads(); }
  TS_MARK(0);
  for (int i = 0; i < PROBE_SYNC; ++i) grid.sync();
  for (int i = 0; i < PROBE_REP_PREP; ++i) { phase_prep(p, lds); __syncthreads(); }
  phase_prep(p, lds);
  __syncthreads();
  TS_MARK(1); grid.sync(); TS_MARK(2);
#pragma unroll
  for (int layer = 0; layer < DEPTH; ++layer) {
    if (bid < 25) meta_inproj_group(p, layer, lds, bid);
    {
      SrcP1 Sp{(const char*)p.hHi, (const char*)p.hLo, (const char*)(p.WmT + (size_t)layer * 3072 * 1024), (const char*)(p.WsT + (size_t)layer * 512 * 3072)};
      EpiP1 E{p, layer};
      for (int i = 0; i < PROBE_REP_P1; ++i) gemm_phase<SrcP1, EpiP1>(lds, Sp, R / BM, 14, E);
      gemm_phase<SrcP1, EpiP1>(lds, Sp, R / BM, 14, E);
    }
    TS_MARK(3 + 8 * layer); GRID_BAR(); TS_MARK(4 + 8 * layer);
    if (PROBE_DRY) {
      if (bid < N_HGRN_BLOCKS) { if (PROBE_DRY != 2) phase_hgrn(p, layer, lds, bid, true); }
      else { if (PROBE_DRY != 3) phase_attn(p, layer, lds, bid - N_HGRN_BLOCKS, G - N_HGRN_BLOCKS, layer == 0, true); }
      grid.sync();
    }
    if (bid < N_HGRN_BLOCKS) phase_hgrn(p, layer, lds, bid);
    else phase_attn(p, layer, lds, bid - N_HGRN_BLOCKS, G - N_HGRN_BLOCKS, layer == 0);
    TS_MARK(5 + 8 * layer); GRID_BAR(); TS_MARK(6 + 8 * layer);
    if (layer == 0 && bid < 8) meta_outproj_group(p, lds, bid);
    {
      SrcP3 Sp{(const char*)p.gates, (const char*)(p.WoT + (size_t)layer * 1024 * 1024)};
      EpiP3 E{p, layer == 0 ? p.x : p.hF};
      if (layer == 0) for (int i = 0; i < PROBE_REP_P3; ++i) gemm_phase<SrcP3, EpiP3>(lds, Sp, R / BM, 4, E);
      gemm_phase<SrcP3, EpiP3>(lds, Sp, R / BM, 4, E);
    }
    TS_MARK(7 + 8 * layer); GRID_BAR(); TS_MARK(8 + 8 * layer);
    if (layer == 0) { phase_ln(p, 0, p.hF, true); if (bid == G - 1) meta_ln(p); TS_MARK(9); GRID_BAR(); TS_MARK(10); }
    else { phase_ln(p, 1, p.out, false); TS_MARK(17); }
  }
  if (TPROBE) {
    grid.sync();
    if (bid == 0 && threadIdx.x < 64) {
      unsigned long long mx = 0;
      for (int b2 = TP_LO + (int)threadIdx.x; b2 < TP_HI; b2 += 64) { const unsigned long long e_ = __hip_atomic_load(p.ts + (size_t)b2 * 64 + TP_E, __ATOMIC_RELAXED, __HIP_MEMORY_SCOPE_AGENT), s_ = __hip_atomic_load(p.ts + (size_t)b2 * 64 + TP_S, __ATOMIC_RELAXED, __HIP_MEMORY_SCOPE_AGENT); const unsigned long long d = TPROBE == 2 ? e_ : e_ - s_; mx = d > mx ? d : mx; }
      for (int o = 32; o > 0; o >>= 1) { const unsigned long long v = __shfl_xor(mx, o); mx = v > mx ? v : mx; }
      if (threadIdx.x == 0) p.out[0] += (float)mx * 0.0001f;
    }
  }
}

}

extern "C" void kernel_launch(void* const* d_in, const int* in_sizes, int n_in, void* d_out, int out_size, void* d_ws, size_t ws_size,
                              hipStream_t stream) {
  Params p{};
  p.x = (const float*)d_in[0]; p.meta = (const float*)d_in[1]; p.rel_bias = (const float*)d_in[2]; p.lbraw = (const float*)d_in[3];
  p.w_in = (const float*)d_in[4]; p.kvg = (const float*)d_in[5]; p.w_uk = (const float*)d_in[6]; p.w_uv = (const float*)d_in[7];
  p.hng = (const float*)d_in[8]; p.w_out = (const float*)d_in[9]; p.ln_g = (const float*)d_in[10]; p.ln_b = (const float*)d_in[11];
  p.out = (float*)d_out;
  char* w = (char*)d_ws; size_t off = 0;
  auto take = [&](size_t bytes) { char* q = w + off; off += (bytes + 255) & ~(size_t)255; return q; };
  p.hF = (float*)take((size_t)R * D * 4); p.hFm = (float*)take((size_t)NM * D * 4);
  p.hHi = (bf16_t*)take((size_t)R * D * 2); p.hHim = (bf16_t*)take((size_t)NM * D * 2);
  p.hLo = (bf16_t*)take((size_t)R * D * 2); p.hLom = (bf16_t*)take((size_t)NM * D * 2);
  p.qa = (bf16_t*)take((size_t)R * 512 * 2); p.qam = (bf16_t*)take((size_t)NM * 512 * 2);
  p.cN = (bf16_t*)take((size_t)R * 128 * 2); p.cNm = (bf16_t*)take((size_t)NM * 128 * 2);
  p.gates = (bf16_t*)take((size_t)R * 1024 * 2); p.gatesm = (bf16_t*)take((size_t)NM * 1024 * 2);
  p.qfm = (bf16_t*)take((size_t)NM * 512 * 2); p.glm = (float*)take((size_t)NM * 512 * 4); p.vvm = (bf16_t*)take((size_t)NM * 512 * 2);
  p.qiH = (bf16_t*)take((size_t)R * 256 * 2); p.qiL = (bf16_t*)take((size_t)R * 256 * 2);
  p.kiH = (bf16_t*)take((size_t)R * 64 * 2); p.kiL = (bf16_t*)take((size_t)R * 64 * 2);
  p.wi = (float*)take((size_t)R * 4 * 4);
  p.sel = (int*)take(256); p.nsel = (int*)take(256);
  p.proj = (float*)take((size_t)NM * NIN * 4);
  p.ych = (float*)take((size_t)NM * D * 4);
  p.WmT = (bf16_t*)take((size_t)DEPTH * 3072 * 1024 * 2); p.WsT = (bf16_t*)take((size_t)DEPTH * 512 * 3072 * 2); p.WoT = (bf16_t*)take((size_t)DEPTH * 1024 * 1024 * 2);
  p.lbv = (float*)take((size_t)DEPTH * 512 * 4);
  p.stats = (float*)take((size_t)R * 16 * 2 * 4); p.statsm = (float*)take(256);
  p.vm = (float*)take((size_t)NM * D * 4);
  p.dummy = (bf16_t*)take((size_t)(R + NM) * 1024 * 2);
  p.bar = (unsigned*)take(XCD_BAR_WORDS * 4);
  p.ts = (unsigned long long*)take(256 * 64 * 8);
  p.wukT = (bf16_t*)take((size_t)DEPTH * 8 * 128 * 64 * 2); p.wuvT = (bf16_t*)take((size_t)DEPTH * 8 * 64 * 128 * 2);
  if (off > ws_size) return;
  p.gl = (float*)d_out; p.qf = (bf16_t*)((char*)d_out + (size_t)R * 512 * 4); p.vv = (bf16_t*)((char*)d_out + (size_t)R * 512 * 4 + (size_t)R * 512 * 2);

  static int grid_blocks = 0;
  if (!grid_blocks) {
    (void)hipFuncSetAttribute((const void*)k_mega, hipFuncAttributeMaxDynamicSharedMemorySize, LDS_BYTES);
    int dev = 0, cus = 0, per_cu = 0;
    (void)hipGetDevice(&dev);
    (void)hipDeviceGetAttribute(&cus, hipDeviceAttributeMultiprocessorCount, dev);
    (void)hipOccupancyMaxActiveBlocksPerMultiprocessor(&per_cu, (const void*)k_mega, NTHREADS, LDS_BYTES);
    grid_blocks = per_cu >= 1 ? cus : 0;
    if (grid_blocks > 256) grid_blocks = 256;
  }
  if (grid_blocks < 64) return;
  (void)hipMemsetAsync(p.bar, 0, XCD_BAR_WORDS * 4, stream);
  void* args[] = {(void*)&p};
  (void)hipLaunchCooperativeKernel((const void*)k_mega, dim3(grid_blocks), dim3(NTHREADS), args, LDS_BYTES, stream);
}
```

```cpp
#include <hip/hip_runtime.h>
#include <hip/hip_cooperative_groups.h>
#include <stdint.h>

namespace {
typedef unsigned short bf16_t;
constexpr int D = 1024, NB = 8, S = 4096, NM = 16, NIN = 3524, DEPTH = 2;
constexpr int R = NB * S;
constexpr int O_QA = 0, O_CKV = 512, O_QI = 640, O_KI = 896, O_WI = 960, O_GA = 964, O_QH = 1476, O_FH = 1988, O_IH = 2500, O_GH = 3012;
constexpr int TOPK = 256;
constexpr float EPS = 1e-6f;
constexpr float DN_ALPHA = 1.4142135623730951f;

__constant__ unsigned char c_bucket[128] = {
  0, 1, 2, 3, 4, 5, 6, 7, 8, 9, 10, 11, 12, 13, 14, 15, 16, 16, 16, 17, 17, 18, 18, 18, 19, 19, 19, 20, 20, 20, 20, 21,
  21, 21, 21, 22, 22, 22, 22, 22, 23, 23, 23, 23, 23, 23, 24, 24, 24, 24, 24, 24, 25, 25, 25, 25, 25, 25, 25, 26, 26, 26, 26, 26,
  26, 26, 26, 27, 27, 27, 27, 27, 27, 27, 27, 27, 27, 28, 28, 28, 28, 28, 28, 28, 28, 28, 28, 29, 29, 29, 29, 29, 29, 29, 29, 29,
  29, 29, 29, 30, 30, 30, 30, 30, 30, 30, 30, 30, 30, 30, 30, 30, 30, 31, 31, 31, 31, 31, 31, 31, 31, 31, 31, 31, 31, 31, 31, 31};

__device__ __forceinline__ int t5_bucket(int dist) { int n = dist < 0 ? 0 : dist; return n >= 128 ? 31 : (int)c_bucket[n]; }
__device__ __forceinline__ float sigmoidf_(float x) { return 1.0f / (1.0f + expf(-x)); }
__device__ __forceinline__ float siluf_(float x) { return x / (1.0f + expf(-x)); }
__device__ __forceinline__ bf16_t f2bf(float f) { unsigned u = __float_as_uint(f); u += 0x7fffu + ((u >> 16) & 1u); return (bf16_t)(u >> 16); }
__device__ __forceinline__ float bf2f(bf16_t h) { return __uint_as_float(((unsigned)h) << 16); }

struct Params {
  const float *x, *meta, *rel_bias, *lbraw, *w_in, *kvg, *w_uk, *w_uv, *hng, *w_out, *ln_g, *ln_b;
  float* out;
  float *hF, *hFm;
  bf16_t *hHi, *hHim, *hLo, *hLom;
  bf16_t *qa, *qam;
  bf16_t *cN, *cNm;
  bf16_t *gates, *gatesm;
  bf16_t *qf, *qfm;
  float *gl, *glm;
  bf16_t *vv, *vvm;
  bf16_t *qiH, *qiL;
  bf16_t *kiH, *kiL;
  float* wi;
  int* sel; int* nsel;
  float* proj;
  float* ych;
  bf16_t* WmT;
  bf16_t* WsT;
  bf16_t* WoT;
  float* lbv;
  float* stats;
  float* statsm;
  float* vm;
  bf16_t* dummy;
  unsigned* bar;
  unsigned long long* ts;
  bf16_t* wukT;
  bf16_t* wuvT;
};

__device__ __forceinline__ unsigned f2key(float f) { unsigned u = __float_as_uint(f); return (u & 0x80000000u) ? ~u : (u | 0x80000000u); }

#define LAS __attribute__((address_space(3)))
typedef short bf16x8 __attribute__((ext_vector_type(8)));
typedef float f32x4 __attribute__((ext_vector_type(4)));
typedef unsigned u32x2 __attribute__((ext_vector_type(2)));
typedef unsigned u32x4 __attribute__((ext_vector_type(4)));
constexpr int NTHREADS = 512;
constexpr int LDS_BYTES = 160 * 1024;
constexpr int BM = 256, BK = 64, HALF = 128, HTB = HALF * BK * 2, STAGE_BYTES = 8 * HTB;
constexpr int LDS_EXTRA = STAGE_BYTES;
#define IDX_SPLIT 0
#define TPROBE 0
#define TP_S 0
#define TP_E 1
#define TP_LO 0
#define TP_HI 256
#define TS_MARK(k) do { if (TPROBE && threadIdx.x == 0) p.ts[(size_t)blockIdx.x * 64 + (k)] = __builtin_amdgcn_s_memrealtime(); } while (0)
#define TS_ACC_BEGIN() unsigned long long tacc_ = TPROBE ? __builtin_amdgcn_s_memrealtime() : 0ull
#define TS_ACC(k) do { if (TPROBE) { const unsigned long long t2_ = __builtin_amdgcn_s_memrealtime(); if (threadIdx.x == 0) p.ts[(size_t)blockIdx.x * 64 + (k)] += t2_ - tacc_; tacc_ = t2_; } } while (0)
#define PROBE_REP_SCORE 0
#define ABL_SCORE 0
#define PROBE_REP_SELECT 0
#define PROBE_REP_ATT 0
#define PROBE_REP_QLAT 0

typedef float f32x2v __attribute__((ext_vector_type(2)));
typedef __bf16 bf16x2v __attribute__((ext_vector_type(2)));
__device__ __forceinline__ unsigned pack_bf16(float lo, float hi) { const f32x2v v = {lo, hi}; const bf16x2v b = __builtin_convertvector(v, bf16x2v); return __builtin_bit_cast(unsigned, b); }
__device__ __forceinline__ bf16_t f2bf_fast(float x) { return (bf16_t)(pack_bf16(x, 0.f) & 0xffffu); }
__device__ __forceinline__ float fast_sigmoid(float x) { return __builtin_amdgcn_rcpf(1.0f + __expf(-x)); }
__device__ __forceinline__ float fast_silu(float x) { return x * __builtin_amdgcn_rcpf(1.0f + __expf(-x)); }

__device__ __forceinline__ int lds_byte(int r, int c) { const int st = (r >> 4) * 2 + (c >> 5), rr = r & 15, cc = c & 31, ob = rr * 64 + cc * 2; return st * 1024 + (ob ^ (((ob >> 9) & 1) << 5)); }
__device__ __forceinline__ void stage_rc(int b, int& Rr, int& Cc) { const int st = b / 1024, sb = b % 1024, swz = sb ^ (((sb >> 9) & 1) << 5); Rr = (st >> 1) * 16 + swz / 64; Cc = (st & 1) * 32 + (swz % 64) / 2; }

struct GUnit { int pm, pn; };
__device__ __forceinline__ bool unit_next(int i, int nM, int nN, GUnit& u) {
  const int nwg = nM * nN; const long L = (long)i * gridDim.x + blockIdx.x; if (L >= nwg) return false;
  int wgid = (int)L; { const int q = nwg / 8, r = nwg % 8, xcd = wgid % 8, off = wgid / 8; wgid = (xcd < r ? xcd * (q + 1) : r * (q + 1) + (xcd - r) * q) + off; }
  const int nig = 8 * nN, gid = wgid / nig, fm = gid * 8, gsz = (nM - fm) < 8 ? (nM - fm) : 8;
  u.pm = fm + ((wgid % nig) % gsz); u.pn = (wgid % nig) / gsz; return true;
}

struct SrcP1 {
  const char* Ahi; const char* Alo; const char* Wm; const char* Ws;
  __device__ __forceinline__ int nt(const GUnit& u) const { return (IDX_SPLIT && u.pn >= 12) ? 48 : 16; }
  __device__ __forceinline__ int ldb(const GUnit& u) const { return u.pn < 12 ? 1024 : 3072; }
  __device__ __forceinline__ const char* a(const GUnit& u, int kt) const { const char* b = (kt >= 16 && kt < 32) ? Alo : Ahi; return b + (size_t)u.pm * (256 * 1024 * 2) + (size_t)(kt & 15) * 128; }
  __device__ __forceinline__ const char* b(const GUnit& u, int kt) const { return u.pn < 12 ? Wm + (size_t)u.pn * (256 * 1024 * 2) + (size_t)kt * 128 : Ws + (size_t)(u.pn - 12) * (256 * 3072 * 2) + (size_t)kt * 128; }
};
struct SrcP3 {
  const char* A; const char* W;
  __device__ __forceinline__ int nt(const GUnit&) const { return 16; }
  __device__ __forceinline__ int ldb(const GUnit&) const { return 1024; }
  __device__ __forceinline__ const char* a(const GUnit& u, int kt) const { return A + (size_t)u.pm * (256 * 1024 * 2) + (size_t)kt * 128; }
  __device__ __forceinline__ const char* b(const GUnit& u, int kt) const { return W + (size_t)u.pn * (256 * 1024 * 2) + (size_t)kt * 128; }
};


template <int CTRL, int ROWMASK = 0xf, bool BC = true>
__device__ __forceinline__ float dppf(float v) { return __int_as_float(__builtin_amdgcn_update_dpp(0, __float_as_int(v), CTRL, ROWMASK, 0xf, BC)); }
__device__ __forceinline__ float row_sum16(float v) { v += dppf<0x128>(v); v += dppf<0x124>(v); v += dppf<0x122>(v); v += dppf<0x121>(v); return v; }
__device__ __forceinline__ unsigned wave_incl_scan(unsigned v) {
  v += (unsigned)__builtin_amdgcn_update_dpp(0, (int)v, 0x111, 0xf, 0xf, true);
  v += (unsigned)__builtin_amdgcn_update_dpp(0, (int)v, 0x112, 0xf, 0xf, true);
  v += (unsigned)__builtin_amdgcn_update_dpp(0, (int)v, 0x114, 0xf, 0xf, true);
  v += (unsigned)__builtin_amdgcn_update_dpp(0, (int)v, 0x118, 0xf, 0xf, true);
  v += (unsigned)__builtin_amdgcn_update_dpp(0, (int)v, 0x142, 0xa, 0xf, false);
  v += (unsigned)__builtin_amdgcn_update_dpp(0, (int)v, 0x143, 0xc, 0xf, false);
  return v;
}
__device__ __forceinline__ float rows_max(float x) {
  auto r = __builtin_amdgcn_permlane16_swap(__float_as_uint(x), __float_as_uint(x), false, false); x = fmaxf(__uint_as_float(r[0]), __uint_as_float(r[1]));
  auto q = __builtin_amdgcn_permlane32_swap(__float_as_uint(x), __float_as_uint(x), false, false); return fmaxf(__uint_as_float(q[0]), __uint_as_float(q[1])); }
__device__ __forceinline__ float rows_sum(float x) {
  auto r = __builtin_amdgcn_permlane16_swap(__float_as_uint(x), __float_as_uint(x), false, false); x = __uint_as_float(r[0]) + __uint_as_float(r[1]);
  auto q = __builtin_amdgcn_permlane32_swap(__float_as_uint(x), __float_as_uint(x), false, false); return __uint_as_float(q[0]) + __uint_as_float(q[1]); }
__device__ __forceinline__ size_t kfrag(size_t row, int c) { return (((((row >> 4) * 2 + (size_t)(c >> 5)) * 4 + (size_t)((c >> 3) & 3)) * 16 + (row & 15)) * 8) + (size_t)(c & 7); }

struct EpiP1 {
  Params p; int layer;
  __device__ __forceinline__ void operator()(const f32x4 (&acc)[2][2][4][2], const GUnit& u, int wr, int wc, int fr, int fq, LAS unsigned char* lds) const {
    const int row0 = u.pm * BM + wr * 64 + fr;
    if (u.pn < 12) {
      const int kind = u.pn >> 1; const int c00 = (u.pn & 1) * 256 + wc * 32 + 4 * fq;
#pragma unroll
      for (int ai = 0; ai < 2; ++ai)
#pragma unroll
        for (int m = 0; m < 4; ++m) {
          const size_t row = (size_t)(row0 + ai * HALF + m * 16);
#pragma unroll
          for (int bj = 0; bj < 2; ++bj)
#pragma unroll
            for (int n = 0; n < 2; ++n) {
              const int c = c00 + bj * HALF + n * 16; f32x4 v = acc[ai][bj][m][n];
              if (kind == 3) {
                const f32x4 lb = *(const f32x4*)(p.lbv + layer * 512 + c); f32x4 o;
#pragma unroll
                for (int j = 0; j < 4; ++j) o[j] = __logf(lb[j] + (1.0f - lb[j]) * fast_sigmoid(v[j]));
                *(f32x4*)(p.gl + row * 512 + c) = o;
              } else {
                if (kind == 1 || kind == 5) {
#pragma unroll
                  for (int j = 0; j < 4; ++j) v[j] = fast_silu(v[j]);
                } else if (kind == 2) {
#pragma unroll
                  for (int j = 0; j < 4; ++j) v[j] = fast_silu(v[j]) * 0.08838834764831845f;
                }
                u32x2 w; w.x = pack_bf16(v[0], v[1]); w.y = pack_bf16(v[2], v[3]);
                bf16_t* dst = kind == 0 ? p.qa + row * 512 + c : kind == 1 ? p.gates + row * 1024 + c : kind == 2 ? p.qf + row * 512 + c
                            : kind == 4 ? p.vv + row * 512 + c : p.gates + row * 1024 + 512 + c;
                *(u32x2*)dst = w;
              }
            }
        }
    } else if (u.pn == 12) {
      const int c00 = wc * 32 + 4 * fq;
#pragma unroll
      for (int ai = 0; ai < 2; ++ai)
#pragma unroll
        for (int m = 0; m < 4; ++m) {
          const size_t row = (size_t)(row0 + ai * HALF + m * 16);
#pragma unroll
          for (int bj = 0; bj < 2; ++bj)
#pragma unroll
            for (int n = 0; n < 2; ++n) {
              const int c = c00 + bj * HALF + n * 16; const f32x4 v = acc[ai][bj][m][n] * 0.125f;
              u32x2 wh, wl; wh.x = pack_bf16(v[0], v[1]); wh.y = pack_bf16(v[2], v[3]);
              wl.x = pack_bf16(v[0] - __uint_as_float(wh.x << 16), v[1] - __uint_as_float(wh.x & 0xffff0000u)); wl.y = pack_bf16(v[2] - __uint_as_float(wh.y << 16), v[3] - __uint_as_float(wh.y & 0xffff0000u));
              *(u32x2*)(p.qiH + row * 256 + c) = wh; if (IDX_SPLIT) *(u32x2*)(p.qiL + row * 256 + c) = wl;
            }
        }
    } else {
      LAS float* red = (LAS float*)(lds + LDS_EXTRA);
#pragma unroll
      for (int ai = 0; ai < 2; ++ai)
#pragma unroll
        for (int m = 0; m < 4; ++m) {
          float s = 0.f;
#pragma unroll
          for (int n = 0; n < 2; ++n) { const f32x4 v = acc[ai][0][m][n]; s += (v[0] * v[0] + v[1] * v[1]) + (v[2] * v[2] + v[3] * v[3]); }
          s = rows_sum(s);
          if (fq == 0) red[(ai * HALF + wr * 64 + m * 16 + fr) * 4 + wc] = s;
        }
      asm volatile("s_waitcnt lgkmcnt(0)" ::: "memory"); __builtin_amdgcn_s_barrier(); asm volatile("" ::: "memory");
#pragma unroll
      for (int ai = 0; ai < 2; ++ai)
#pragma unroll
        for (int m = 0; m < 4; ++m) {
          const int lr = ai * HALF + wr * 64 + m * 16 + fr; const size_t row = (size_t)(u.pm * BM + lr);
          const f32x4 pr = *(const LAS f32x4*)(red + lr * 4);
          const float rstd = rsqrtf(((pr[0] + pr[1]) + (pr[2] + pr[3])) * (1.0f / 128.0f) + EPS);
#pragma unroll
          for (int n = 0; n < 2; ++n) {
            const int c = wc * 32 + n * 16 + 4 * fq; const f32x4 g = *(const f32x4*)(p.kvg + layer * 128 + c); const f32x4 v = acc[ai][0][m][n] * rstd * g;
            u32x2 w; w.x = pack_bf16(v[0], v[1]); w.y = pack_bf16(v[2], v[3]); *(u32x2*)(p.cN + row * 128 + c) = w;
          }
          if (wc < 2) {
#pragma unroll
            for (int n = 0; n < 2; ++n) {
              const int c = wc * 32 + n * 16 + 4 * fq; const f32x4 v = acc[ai][1][m][n];
              u32x2 wh, wl; wh.x = pack_bf16(v[0], v[1]); wh.y = pack_bf16(v[2], v[3]);
              wl.x = pack_bf16(v[0] - __uint_as_float(wh.x << 16), v[1] - __uint_as_float(wh.x & 0xffff0000u)); wl.y = pack_bf16(v[2] - __uint_as_float(wh.y << 16), v[3] - __uint_as_float(wh.y & 0xffff0000u));
              *(u32x2*)(p.kiH + kfrag(row, c)) = wh; if (IDX_SPLIT) *(u32x2*)(p.kiL + kfrag(row, c)) = wl;
            }
          } else if (wc == 2 && fq == 0) {
            *(f32x4*)(p.wi + row * 4) = acc[ai][1][m][0] * 0.5f;
          }
        }
    }
  }
};

struct EpiP3 {
  Params p; const float* hres;
  __device__ __forceinline__ void operator()(const f32x4 (&acc)[2][2][4][2], const GUnit& u, int wr, int wc, int fr, int fq, LAS unsigned char* lds) const {
    const int row0 = u.pm * BM + wr * 64 + fr; const int c00 = u.pn * BM + wc * 32 + 4 * fq;
#pragma unroll
    for (int ai = 0; ai < 2; ++ai)
#pragma unroll
      for (int m = 0; m < 4; ++m) {
        const size_t row = (size_t)(row0 + ai * HALF + m * 16); float s = 0.f, q = 0.f;
#pragma unroll
        for (int bj = 0; bj < 2; ++bj)
#pragma unroll
          for (int n = 0; n < 2; ++n) {
            const int c = c00 + bj * HALF + n * 16; const f32x4 h = *(const f32x4*)(hres + row * D + c);
            const f32x4 v = h * DN_ALPHA + acc[ai][bj][m][n];
            *(f32x4*)(p.hF + row * D + c) = v;
            s += (v[0] + v[1]) + (v[2] + v[3]); q += (v[0] * v[0] + v[1] * v[1]) + (v[2] * v[2] + v[3] * v[3]);
          }
        s = rows_sum(s); q = rows_sum(q);
        if (fq == 0) { float2 st; st.x = s; st.y = q; *(float2*)(p.stats + (row * 16 + u.pn * 4 + wc) * 2) = st; }
        asm volatile("" ::: "memory");
      }
  }
};

template <class Src, class Epi>
__device__ __forceinline__ void gemm_phase(LAS unsigned char* lds, const Src S, const int nM, const int nN, const Epi& E) {
  int tid_ = threadIdx.x; asm volatile("" : "+v"(tid_));
  const int tid = tid_, wid = __builtin_amdgcn_readfirstlane(tid >> 6), lane = tid & 63, wr = wid >> 2, wc = wid & 3, fr = lane & 15, fq = lane >> 4;
  unsigned voffA[2], voffB1[2], voffB3[2];
#pragma unroll
  for (int i = 0; i < 2; ++i) { int Rr, Cc; stage_rc(tid * 16 + i * 8192, Rr, Cc); voffA[i] = (unsigned)(Rr * 1024 + Cc) * 2u; voffB1[i] = voffA[i]; voffB3[i] = (unsigned)(Rr * 3072 + Cc) * 2u; }
  const size_t hstepA = (size_t)HALF * 1024 * 2;
  const unsigned ldsw = (unsigned)wid * 1024u;
  const int aoff = lds_byte(wr * 64 + fr, fq * 8), boff = lds_byte(wc * 32 + fr, fq * 8);
#define G_SA(b, h) (((b) * 2 + (h)) * HTB)
#define G_SB(b, h) ((4 + (b) * 2 + (h)) * HTB)
#define G_STAGE(bufoff, gbase, v0, v1) do { \
    __builtin_amdgcn_global_load_lds((const unsigned*)((const char*)(gbase) + (v0)), (LAS unsigned*)(lds + (bufoff) + ldsw), 16, 0, 0); \
    __builtin_amdgcn_global_load_lds((const unsigned*)((const char*)(gbase) + (v1)), (LAS unsigned*)(lds + (bufoff) + ldsw + 8192), 16, 0, 0); } while (0)
#define G_STAGE_A(bufoff, gbase) G_STAGE(bufoff, gbase, voffA[0], voffA[1])
#define G_LDA(dst, b, h) do { _Pragma("unroll") for (int m = 0; m < 4; ++m) _Pragma("unroll") for (int k = 0; k < 2; ++k) dst[m][k] = *(const LAS bf16x8*)(lds + G_SA(b, h) + aoff + m * 2048 + k * 1024); } while (0)
#define G_LDB(dst, b, h) do { _Pragma("unroll") for (int n = 0; n < 2; ++n) _Pragma("unroll") for (int k = 0; k < 2; ++k) dst[n][k] = *(const LAS bf16x8*)(lds + G_SB(b, h) + boff + n * 2048 + k * 1024); } while (0)
#define G_MMA(ai, bj, At, Bt) do { __builtin_amdgcn_s_setprio(1); _Pragma("unroll") for (int m = 0; m < 4; ++m) _Pragma("unroll") for (int n = 0; n < 2; ++n) _Pragma("unroll") for (int k = 0; k < 2; ++k) \
    acc[ai][bj][m][n] = __builtin_amdgcn_mfma_f32_16x16x32_bf16(Bt[n][k], At[m][k], acc[ai][bj][m][n], 0, 0, 0); __builtin_amdgcn_s_setprio(0); } while (0)
#define G_WAIT_V(n) asm volatile("s_waitcnt vmcnt(" #n ")" ::: "memory")
#define G_WAIT_L(n) asm volatile("s_waitcnt lgkmcnt(" #n ")" ::: "memory")
#define G_BAR __builtin_amdgcn_s_barrier()
#define G_SCHED __builtin_amdgcn_sched_barrier(0)
  const Params& p = E.p;
  GUnit cur, nxt; int ui = 0;
  if (!unit_next(0, nM, nN, cur)) return;
  f32x4 acc[2][2][4][2];
#pragma unroll
  for (int a = 0; a < 2; ++a)
#pragma unroll
    for (int b = 0; b < 2; ++b)
#pragma unroll
      for (int m = 0; m < 4; ++m)
#pragma unroll
        for (int n = 0; n < 2; ++n) acc[a][b][m][n] = (f32x4){0.f, 0.f, 0.f, 0.f};
  bf16x8 At[4][2], B0[2][2], B1[2][2];
  {
    const bool w3 = S.ldb(cur) == 3072; const unsigned vb0 = w3 ? voffB3[0] : voffB1[0], vb1 = w3 ? voffB3[1] : voffB1[1]; const size_t hsB = (size_t)HALF * S.ldb(cur) * 2;
    const char* cA0 = S.a(cur, 0); const char* cB0 = S.b(cur, 0); const char* cA1 = S.a(cur, 1); const char* cB1 = S.b(cur, 1);
    G_STAGE(G_SB(0, 0), cB0, vb0, vb1); G_STAGE_A(G_SA(0, 0), cA0); G_STAGE(G_SB(0, 1), cB0 + hsB, vb0, vb1); G_STAGE_A(G_SA(0, 1), cA0 + hstepA);
    if (wr == 1) G_BAR;
    G_WAIT_V(4); G_BAR;
    G_STAGE(G_SB(1, 0), cB1, vb0, vb1); G_STAGE_A(G_SA(1, 0), cA1); G_STAGE(G_SB(1, 1), cB1 + hsB, vb0, vb1);
    G_WAIT_V(6); G_BAR;
  }
  for (;;) {
    TS_ACC_BEGIN();
    const bool has_next = unit_next(ui + 1, nM, nN, nxt);
    const GUnit nu = has_next ? nxt : cur;
    const int nt = S.nt(cur);
    const bool cw3 = S.ldb(cur) == 3072, nw3 = S.ldb(nu) == 3072;
    for (int t = 0; t < nt; t += 2) {
      const bool last = (t == nt - 2);
      const char* a1 = S.a(cur, t + 1);
      const char* a2 = last ? S.a(nu, 0) : S.a(cur, t + 2); const char* b2 = last ? S.b(nu, 0) : S.b(cur, t + 2);
      const char* a3 = last ? S.a(nu, 1) : S.a(cur, t + 3); const char* b3 = last ? S.b(nu, 1) : S.b(cur, t + 3);
      const bool w3 = last ? nw3 : cw3;
      const unsigned vb0 = w3 ? voffB3[0] : voffB1[0], vb1 = w3 ? voffB3[1] : voffB1[1]; const size_t hsB = w3 ? (size_t)HALF * 3072 * 2 : (size_t)HALF * 1024 * 2;
      G_LDB(B0, 0, 0); G_SCHED; G_LDA(At, 0, 0); G_STAGE_A(G_SA(1, 1), a1 + hstepA);
      G_WAIT_L(8); G_BAR; G_WAIT_L(0); G_MMA(0, 0, At, B0); G_BAR; G_SCHED;
      G_LDB(B1, 0, 1); G_STAGE(G_SB(0, 0), b2, vb0, vb1);
      G_BAR; G_WAIT_L(0); G_MMA(0, 1, At, B1); G_BAR;
      G_LDA(At, 0, 1); G_STAGE_A(G_SA(0, 0), a2);
      G_BAR; G_WAIT_L(0); G_MMA(1, 0, At, B0); G_BAR; G_SCHED;
      G_STAGE(G_SB(0, 1), b2 + hsB, vb0, vb1);
      G_WAIT_V(6); G_BAR; G_MMA(1, 1, At, B1); G_BAR;
      G_LDB(B0, 1, 0); G_SCHED; G_LDA(At, 1, 0); G_STAGE_A(G_SA(0, 1), a2 + hstepA);
      G_WAIT_L(8); G_BAR; G_WAIT_L(0); G_MMA(0, 0, At, B0); G_BAR; G_SCHED;
      G_LDB(B1, 1, 1); G_STAGE(G_SB(1, 0), b3, vb0, vb1);
      G_BAR; G_WAIT_L(0); G_MMA(0, 1, At, B1); G_BAR;
      G_LDA(At, 1, 1); G_STAGE_A(G_SA(1, 0), a3);
      G_BAR; G_WAIT_L(0); G_MMA(1, 0, At, B0); G_BAR; G_SCHED;
      G_STAGE(G_SB(1, 1), b3 + hsB, vb0, vb1);
      G_WAIT_V(6); G_BAR; G_MMA(1, 1, At, B1); G_BAR;
    }
    TS_ACC(56);
    E(acc, cur, wr, wc, fr, fq, lds);
    TS_ACC(57);
    if (!has_next) break;
#pragma unroll
    for (int a = 0; a < 2; ++a)
#pragma unroll
      for (int b = 0; b < 2; ++b)
#pragma unroll
        for (int m = 0; m < 4; ++m)
#pragma unroll
          for (int n = 0; n < 2; ++n) acc[a][b][m][n] = (f32x4){0.f, 0.f, 0.f, 0.f};
    cur = nxt; ++ui;
  }
  G_WAIT_V(0);
  if (wr == 0) G_BAR;
  G_BAR;
#undef G_SA
#undef G_SB
#undef G_STAGE
#undef G_STAGE_A
#undef G_LDA
#undef G_LDB
#undef G_MMA
#undef G_WAIT_V
#undef G_WAIT_L
#undef G_BAR
#undef G_SCHED
}

__device__ __forceinline__ void phase_prep(const Params& p, LAS unsigned char* lds) {
  int tid_ = threadIdx.x; asm volatile("" : "+v"(tid_));
  const int tid = tid_, nb = gridDim.x, bid = blockIdx.x;
  LAS float* tile = (LAS float*)lds;
  const int NJ = DEPTH * (48 + 8 + 16) * 16;
  for (int job = bid; job < NJ; job += nb) {
    const int l = job / ((48 + 8 + 16) * 16); int rem = job % ((48 + 8 + 16) * 16); const int ntile = rem / 16, kt = rem % 16;
    const int kind = ntile < 48 ? 0 : ntile < 56 ? 1 : 2; const int n0 = kind == 0 ? ntile * 64 : kind == 1 ? (ntile - 48) * 64 : (ntile - 56) * 64;
    const float* src = kind == 2 ? p.w_out + (size_t)l * D * D : p.w_in + (size_t)l * D * NIN; const int lds_ = kind == 2 ? D : NIN;
    for (int i = tid; i < 64 * 64; i += NTHREADS) {
      const int kk = i >> 6, nn = i & 63; const int n = n0 + nn; int col;
      if (kind == 0) { const int grp = n >> 9, cc = n & 511; col = (grp == 0 ? O_QA : grp == 1 ? O_GA : grp == 2 ? O_QH : grp == 3 ? O_FH : grp == 4 ? O_IH : O_GH) + cc; }
      else if (kind == 1) { col = n < 256 ? O_QI + n : n < 384 ? O_CKV + (n - 256) : n < 448 ? O_KI + (n - 384) : n < 452 ? O_WI + (n - 448) : -1; }
      else col = n;
      tile[kk * 65 + nn] = col >= 0 ? src[(size_t)(kt * 64 + kk) * lds_ + col] : 0.f;
    }
    __syncthreads();
    for (int i = tid; i < 64 * 64; i += NTHREADS) {
      const int nn = i >> 6, kk = i & 63; const float v = tile[kk * 65 + nn]; const int n = n0 + nn, k = kt * 64 + kk;
      if (kind == 0) p.WmT[((size_t)l * 3072 + n) * 1024 + k] = f2bf(v);
      else if (kind == 2) p.WoT[((size_t)l * 1024 + n) * 1024 + k] = f2bf(v);
      else { const bf16_t h = f2bf(v), lo = f2bf(v - bf2f(h)); bf16_t* d = p.WsT + ((size_t)l * 512 + n) * 3072; d[k] = h; d[1024 + k] = h; d[2048 + k] = lo; }
    }
    __syncthreads();
  }
  for (int i = bid * NTHREADS + tid; i < 512; i += nb * NTHREADS) {
    const float r0 = p.lbraw[i], r1 = p.lbraw[512 + i]; const float m = fmaxf(r0, r1); const float e0 = expf(r0 - m), e1 = expf(r1 - m);
    p.lbv[i] = 0.f; p.lbv[512 + i] = e1 / (e0 + e1);
  }
  for (int i = bid * NTHREADS + tid; i < DEPTH * 8 * 128 * 64; i += nb * NTHREADS) {
    const int d = i & 63, c = (i >> 6) & 127, lh = i >> 13;
    p.wukT[i] = f2bf(p.w_uk[((size_t)lh * 64 + d) * 128 + c]);
    const int c2 = i & 127, d2 = (i >> 7) & 63;
    p.wuvT[i] = f2bf(p.w_uv[((size_t)lh * 128 + c2) * 64 + d2]);
  }
  const size_t n4 = (size_t)(R + NM) * D / 4;
  for (size_t i = (size_t)bid * NTHREADS + tid; i < n4; i += (size_t)nb * NTHREADS) {
    const size_t row = i / (D / 4); const int c4 = (int)(i % (D / 4));
    const bool im = row >= (size_t)R; const size_t rr = im ? row - R : row;
    const f32x4 v = *(const f32x4*)((im ? p.meta : p.x) + rr * D + c4 * 4);
    u32x2 wh, wl; wh.x = pack_bf16(v[0], v[1]); wh.y = pack_bf16(v[2], v[3]);
    wl.x = pack_bf16(v[0] - __uint_as_float(wh.x << 16), v[1] - __uint_as_float(wh.x & 0xffff0000u)); wl.y = pack_bf16(v[2] - __uint_as_float(wh.y << 16), v[3] - __uint_as_float(wh.y & 0xffff0000u));
    *(u32x2*)((im ? p.hHim : p.hHi) + rr * D + c4 * 4) = wh; if (IDX_SPLIT) *(u32x2*)((im ? p.hLom : p.hLo) + rr * D + c4 * 4) = wl;
  }
}

__device__ __forceinline__ void phase_ln(const Params& p, int layer, float* dst, bool write_split) {
  int tid_ = threadIdx.x; asm volatile("" : "+v"(tid_));
  const int tid = tid_, wid = tid >> 6, lane = tid & 63;
  const float* g = p.ln_g + layer * D; const float* bb = p.ln_b + layer * D;
  for (int row = blockIdx.x * 8 + wid; row < R; row += gridDim.x * 8) {
    float s = 0.f, q = 0.f;
    if (lane < 16) { const float2 st = *(const float2*)(p.stats + ((size_t)row * 16 + lane) * 2); s = st.x; q = st.y; }
#pragma unroll
    for (int o = 8; o > 0; o >>= 1) { s += __shfl_xor(s, o); q += __shfl_xor(q, o); }
    s = __shfl(s, 0); q = __shfl(q, 0);
    const float mean = s * (1.0f / D); const float var = fmaxf(q * (1.0f / D) - mean * mean, 0.f); const float rstd = rsqrtf(var + EPS);
#pragma unroll
    for (int i = 0; i < 4; ++i) {
      const int c = (i * 64 + lane) * 4;
      const f32x4 v = *(const f32x4*)(p.hF + (size_t)row * D + c); const f32x4 gg = *(const f32x4*)(g + c); const f32x4 bv = *(const f32x4*)(bb + c);
      const f32x4 o = (v - mean) * rstd * gg + bv;
      *(f32x4*)(dst + (size_t)row * D + c) = o;
      if (write_split) {
        u32x2 wh, wl; wh.x = pack_bf16(o[0], o[1]); wh.y = pack_bf16(o[2], o[3]);
        wl.x = pack_bf16(o[0] - __uint_as_float(wh.x << 16), o[1] - __uint_as_float(wh.x & 0xffff0000u)); wl.y = pack_bf16(o[2] - __uint_as_float(wh.y << 16), o[3] - __uint_as_float(wh.y & 0xffff0000u));
        *(u32x2*)(p.hHi + (size_t)row * D + c) = wh; if (IDX_SPLIT) *(u32x2*)(p.hLo + (size_t)row * D + c) = wl;
      }
    }
  }
}

constexpr int K16_STRIDE = 8208;
constexpr int A_BIG = 0;
constexpr int A_SEL = 131328;
constexpr int A_CM = A_SEL + 8192;
constexpr int A_MISC = A_CM + 4096;
constexpr int A_HIST = A_MISC;
constexpr int A_CAND = A_MISC + 16448;
constexpr int A_RB = A_MISC + 16448 + 1024;
constexpr int A_BKT = A_RB + 1024;
constexpr int A_NSEL = A_BKT + 128;
static_assert(A_NSEL + 64 <= LDS_BYTES, "attention LDS map");

__device__ __forceinline__ unsigned off_b(unsigned row, unsigned ch) { return 256u * row + 16u * (ch ^ (((row & 3) << 2) | ((row >> 2) & 3))); }
__device__ __forceinline__ void glds16_asm(const void* gsrc, unsigned lds_dst) {
  unsigned keep;
  asm volatile("s_mov_b32 %0, m0\n\ts_mov_b32 m0, %2\n\ts_nop 0\n\tglobal_load_lds_dwordx4 %1, off\n\ts_mov_b32 m0, %0" : "=&s"(keep) : "v"(gsrc), "s"(lds_dst) : "memory");
}
__device__ __forceinline__ void wave_lds_sync() { asm volatile("s_waitcnt lgkmcnt(0)" ::: "memory"); }
typedef unsigned short u16x4 __attribute__((ext_vector_type(4)));
typedef unsigned short u16x8 __attribute__((ext_vector_type(8)));

typedef short s16x4 __attribute__((ext_vector_type(4)));
__device__ __forceinline__ s16x4 lds_tr(const LAS unsigned char* ptr) { return __builtin_amdgcn_ds_read_tr16_b64_v4i16((LAS s16x4*)ptr); }
__device__ __forceinline__ bf16x8 cat4(s16x4 a, s16x4 b) { return __builtin_shufflevector(a, b, 0, 1, 2, 3, 4, 5, 6, 7); }
__device__ __forceinline__ f32x4 mfma16(bf16x8 a, bf16x8 b, f32x4 c) { return __builtin_amdgcn_mfma_f32_16x16x32_bf16(a, b, c, 0, 0, 0); }

__device__ __forceinline__ void wave_find_bin(const unsigned (&c)[4], unsigned need, int lane, unsigned& bin, unsigned& above) {
  const unsigned tot = c[0] + c[1] + c[2] + c[3];
  unsigned cum = wave_incl_scan(tot) - tot;
  unsigned fb = 0xffffffffu, fa = 0;
#pragma unroll
  for (int i = 0; i < 4; ++i) { if (fb == 0xffffffffu && cum < need && cum + c[i] >= need) { fb = 255u - 4u * lane - i; fa = cum; } cum += c[i]; }
  const unsigned long long m = __ballot(fb != 0xffffffffu);
  const int src = m ? (int)__builtin_ctzll(m) : 0;
  bin = (unsigned)__builtin_amdgcn_readlane((int)fb, src); above = (unsigned)__builtin_amdgcn_readlane((int)fa, src);
  if (!m) { bin = 0; above = 0; }
}

__device__ __forceinline__ void attn_tile(const Params& p, const int layer, LAS unsigned char* lds, const bool is_meta, const int b, const int j,
                                          const bf16_t* wukT, const bf16_t* wuvT, const bool dry = false) {
  int tid_ = threadIdx.x; asm volatile("" : "+v"(tid_));
  const int tid = tid_, wid = __builtin_amdgcn_readfirstlane(tid >> 6), lane = tid & 63, fr = lane & 15, g = lane >> 4;
  const int t0 = 16 * j; const size_t r0 = is_meta ? 0 : (size_t)b * S + t0;
  const bf16_t* cNb = p.cN + (size_t)b * S * 128;
  LAS int* nselp = (LAS int*)(lds + A_NSEL);
  TS_ACC_BEGIN();
  {
    const bf16_t* qa = (is_meta ? p.qam : p.qa) + (r0 + fr) * 512 + wid * 64 + g * 8;
    bf16x8 bq[2];
#pragma unroll
    for (int ks = 0; ks < 2; ++ks) bq[ks] = *(const bf16x8*)(qa + ks * 32);
    const bf16_t* wk = wukT + ((size_t)wid * 128 + fr) * 64 + g * 8;
    bf16x8 wf[8][2];
#pragma unroll
    for (int mt = 0; mt < 8; ++mt)
#pragma unroll
      for (int ks = 0; ks < 2; ++ks) wf[mt][ks] = *(const bf16x8*)(wk + (size_t)mt * 16 * 64 + ks * 32);
#pragma unroll
    for (int mt = 0; mt < 8; ++mt) {
      f32x4 a = (f32x4){0.f, 0.f, 0.f, 0.f};
#pragma unroll
      for (int ks = 0; ks < 2; ++ks) a = mfma16(wf[mt][ks], bq[ks], a);
      u32x2 w2; w2.x = pack_bf16(a[0], a[1]); w2.y = pack_bf16(a[2], a[3]);
      *(LAS u32x2*)(lds + A_BIG + ((fr * 8 + wid) * 128 + mt * 16 + 4 * g) * 2) = w2;
    }
  }
  __syncthreads();
  bf16x8 qf_[2][4];
#pragma unroll
  for (int qq = 0; qq < 2; ++qq)
#pragma unroll
    for (int ks = 0; ks < 4; ++ks) {
      const bf16x8 v = *(const LAS bf16x8*)(lds + A_BIG + (((2 * wid + qq) * 8 + (fr & 7)) * 128 + ks * 32 + g * 8) * 2);
      qf_[qq][ks] = fr < 8 ? v : (bf16x8){0, 0, 0, 0, 0, 0, 0, 0};
    }
  __syncthreads();
  TS_ACC(36);
  if (!is_meta && j >= 16) {
    for (int rep_ = 0; rep_ <= PROBE_REP_SCORE; ++rep_) {
      bf16x8 qH[4][2], qL[4][2];
      const bf16_t* qh = p.qiH + (r0 + fr) * 256 + g * 8; const bf16_t* ql = p.qiL + (r0 + fr) * 256 + g * 8;
#pragma unroll
      for (int h = 0; h < 4; ++h)
#pragma unroll
        for (int ks = 0; ks < 2; ++ks) { qH[h][ks] = *(const bf16x8*)(qh + h * 64 + ks * 32); qL[h][ks] = IDX_SPLIT ? *(const bf16x8*)(ql + h * 64 + ks * 32) : qH[h][ks]; }
      const f32x4 w = *(const f32x4*)(p.wi + (r0 + fr) * 4);
      const int tq = t0 + fr;
      LAS unsigned* h1 = (LAS unsigned*)(lds + A_HIST) + fr * 257;
      const bf16_t* kbh = p.kiH + (size_t)b * S * 64 + lane * 8; const bf16_t* kbl = p.kiL + (size_t)b * S * 64 + lane * 8;
      bf16x8 nH[2], nL[2], mH[2], mL[2];
      if (wid <= j) {
#pragma unroll
        for (int ks = 0; ks < 2; ++ks) { nH[ks] = *(const bf16x8*)(kbh + (size_t)wid * 1024 + ks * 512); nL[ks] = IDX_SPLIT ? *(const bf16x8*)(kbl + (size_t)wid * 1024 + ks * 512) : nH[ks]; }
      }
      if (wid + 8 <= j) {
#pragma unroll
        for (int ks = 0; ks < 2; ++ks) { mH[ks] = *(const bf16x8*)(kbh + (size_t)(wid + 8) * 1024 + ks * 512); mL[ks] = IDX_SPLIT ? *(const bf16x8*)(kbl + (size_t)(wid + 8) * 1024 + ks * 512) : mH[ks]; }
      }
      for (int kt = wid; kt <= j; kt += 8) {
        bf16x8 kH[2], kL[2];
#pragma unroll
        for (int ks = 0; ks < 2; ++ks) { kH[ks] = nH[ks]; kL[ks] = nL[ks]; nH[ks] = mH[ks]; nL[ks] = mL[ks]; }
        if (kt + 16 <= j) {
#pragma unroll
          for (int ks = 0; ks < 2; ++ks) { mH[ks] = *(const bf16x8*)(kbh + (size_t)(kt + 16) * 1024 + ks * 512); mL[ks] = IDX_SPLIT ? *(const bf16x8*)(kbl + (size_t)(kt + 16) * 1024 + ks * 512) : mH[ks]; }
        }
        f32x4 sc = (f32x4){0.f, 0.f, 0.f, 0.f};
#pragma unroll
        for (int h = 0; h < 4; ++h) {
          f32x4 a = (f32x4){0.f, 0.f, 0.f, 0.f};
#pragma unroll
          for (int ks = 0; ks < 2; ++ks) { if (!(ABL_SCORE == 2 && rep_ < PROBE_REP_SCORE)) a = mfma16(kH[ks], qH[h][ks], a); if (IDX_SPLIT && !(ABL_SCORE >= 1 && rep_ < PROBE_REP_SCORE)) { a = mfma16(kL[ks], qH[h][ks], a); a = mfma16(kH[ks], qL[h][ks], a); } }
#pragma unroll
          for (int i = 0; i < 4; ++i) sc[i] = fmaf(w[h], fmaxf(a[i], 0.f), sc[i]);
        }
        u16x4 kk;
#pragma unroll
        for (int i = 0; i < 4; ++i) { const int s = kt * 16 + 4 * g + i; const unsigned k16 = f2key(sc[i]) >> 16; const bool ok = s <= tq; kk[i] = ok ? (unsigned short)k16 : (unsigned short)0;
          if (rep_ == PROBE_REP_SCORE && ok) __hip_atomic_fetch_add(h1 + (k16 >> 8), 1u, __ATOMIC_RELAXED, __HIP_MEMORY_SCOPE_WORKGROUP); }
        *(LAS u16x4*)(lds + A_BIG + fr * K16_STRIDE + (kt * 16 + 4 * g) * 2) = kk;
      }
    }
    TS_ACC(32);
    __syncthreads();
    TS_ACC(33);
    const int nkeys = 16 * (j + 1);
    LAS unsigned short* cand = (LAS unsigned short*)(lds + A_CAND + wid * 128);
    for (int rep_ = 0; rep_ <= PROBE_REP_SELECT; ++rep_)
    for (int qq = 0; qq < 2; ++qq) {
      const int qi = 2 * wid + qq;
      const LAS unsigned char* Kq = lds + A_BIG + qi * K16_STRIDE;
      LAS unsigned short* sel = (LAS unsigned short*)(lds + A_SEL + qi * 512);
      const int nit = (nkeys + 511) >> 9;
      const size_t qrow = r0 + qi;
      bf16x8 bqH[2], bqL[2];
#pragma unroll
      for (int ks = 0; ks < 2; ++ks) { bqH[ks] = fr < 4 ? *(const bf16x8*)(p.qiH + qrow * 256 + (fr & 3) * 64 + ks * 32 + g * 8) : (bf16x8){0, 0, 0, 0, 0, 0, 0, 0};
        bqL[ks] = (IDX_SPLIT && fr < 4) ? *(const bf16x8*)(p.qiL + qrow * 256 + (fr & 3) * 64 + ks * 32 + g * 8) : (bf16x8){0, 0, 0, 0, 0, 0, 0, 0}; }
      const f32x4 wq = *(const f32x4*)(p.wi + qrow * 4);
      LAS unsigned* hist = (LAS unsigned*)(lds + A_HIST) + qi * 257;
      unsigned c4[4];
#pragma unroll
      for (int i = 0; i < 4; ++i) c4[i] = hist[255 - 4 * lane - i];
      unsigned B1, above1; wave_find_bin(c4, (unsigned)TOPK, lane, B1, above1);
      wave_lds_sync();
      TS_ACC(48);
      u16x8 kr[8];
#pragma unroll
      for (int it = 0; it < 8; ++it) { const int base = (it * 64 + lane) * 8; kr[it] = (u16x8){0, 0, 0, 0, 0, 0, 0, 0}; if (it < nit && base < nkeys) kr[it] = *(const LAS u16x8*)(Kq + base * 2); }
#pragma unroll
      for (int i = 0; i < 4; ++i) hist[lane * 4 + i] = 0u;
      wave_lds_sync();
#pragma unroll
      for (int it = 0; it < 8; ++it) if (it < nit) {
#pragma unroll
        for (int e = 0; e < 8; ++e) if ((unsigned)(kr[it][e] >> 8) == B1) __hip_atomic_fetch_add(hist + (kr[it][e] & 255), 1u, __ATOMIC_RELAXED, __HIP_MEMORY_SCOPE_WORKGROUP);
      }
      wave_lds_sync();
#pragma unroll
      for (int i = 0; i < 4; ++i) c4[i] = hist[255 - 4 * lane - i];
      unsigned B2, above2; wave_find_bin(c4, (unsigned)TOPK - above1, lane, B2, above2);
      const unsigned T16 = (B1 << 8) | B2; const unsigned ngt = above1 + above2; const unsigned need = (unsigned)TOPK - ngt;
      TS_ACC(49);
      unsigned cg = 0, ce = 0;
#pragma unroll
      for (int it = 0; it < 8; ++it) if (it < nit) {
#pragma unroll
        for (int e = 0; e < 8; ++e) { cg += (unsigned)kr[it][e] > T16 ? 1u : 0u; ce += (unsigned)kr[it][e] == T16 ? 1u : 0u; }
      }
      const unsigned ig = wave_incl_scan(cg), ie = wave_incl_scan(ce);
      unsigned og = ig - cg, oe = ie - ce;
      const unsigned pos_eq = (unsigned)__builtin_amdgcn_readlane((int)ie, 63);
      TS_ACC(50);
      const bool slowpath = (T16 == 0x8000u || pos_eq > 64u);
#pragma unroll
      for (int it = 0; it < 8; ++it) if (it < nit) {
        const int base = (it * 64 + lane) * 8;
#pragma unroll
        for (int e = 0; e < 8; ++e) if ((unsigned)kr[it][e] == T16) { if (oe < 64u) cand[oe] = (unsigned short)(base + e); ++oe; }
      }
      wave_lds_sync();
      const int c = slowpath ? 0 : (int)pos_eq;
      const int myidx = lane < c ? (int)cand[lane] : 0;
      const int npass = (c + 15) >> 4;
      bf16x8 rkH[4][2], rkL[4][2];
#pragma unroll
      for (int pb = 0; pb < 4; ++pb) if (pb < npass) {
        const int ci = pb * 16 + fr; const int kidx_ = ci < c ? (int)cand[ci] : 0; const size_t krow = (size_t)b * S + kidx_;
#pragma unroll
        for (int ks = 0; ks < 2; ++ks) { rkH[pb][ks] = *(const bf16x8*)(p.kiH + kfrag(krow, ks * 32 + g * 8)); rkL[pb][ks] = IDX_SPLIT ? *(const bf16x8*)(p.kiL + kfrag(krow, ks * 32 + g * 8)) : rkH[pb][ks]; }
      }
#pragma unroll
      for (int it = 0; it < 8; ++it) if (it < nit) {
        const int base = (it * 64 + lane) * 8;
#pragma unroll
        for (int e = 0; e < 8; ++e) if ((unsigned)kr[it][e] > T16) { sel[og] = (unsigned short)(base + e); ++og; }
      }
      wave_lds_sync();
      TS_ACC(51);
      if (slowpath) {
        unsigned taken = 0;
#pragma unroll
        for (int it = 0; it < 8; ++it) if (it < nit && taken < need) {
          unsigned cnt = 0;
#pragma unroll
          for (int e = 0; e < 8; ++e) cnt += (unsigned)kr[it][e] == T16 ? 1u : 0u;
          const unsigned inc = wave_incl_scan(cnt);
          unsigned o = taken + inc - cnt;
          const int base = (it * 64 + lane) * 8;
#pragma unroll
          for (int e = 0; e < 8; ++e) if ((unsigned)kr[it][e] == T16) { if (o < need) sel[ngt + o] = (unsigned short)(base + e); ++o; }
          taken += (unsigned)__builtin_amdgcn_readlane((int)inc, 63);
        }
      } else {
        const float wl_ = (fr & 3) == 0 ? wq[0] : (fr & 3) == 1 ? wq[1] : (fr & 3) == 2 ? wq[2] : wq[3];
        LAS float* scr = (LAS float*)hist;
#pragma unroll
        for (int pb = 0; pb < 4; ++pb) if (pb < npass) {
          f32x4 dacc = (f32x4){0.f, 0.f, 0.f, 0.f};
#pragma unroll
          for (int ks = 0; ks < 2; ++ks) { dacc = mfma16(rkH[pb][ks], bqH[ks], dacc); if (IDX_SPLIT) { dacc = mfma16(rkL[pb][ks], bqH[ks], dacc); dacc = mfma16(rkH[pb][ks], bqL[ks], dacc); } }
          f32x4 v;
#pragma unroll
          for (int i = 0; i < 4; ++i) { float t_ = fr < 4 ? wl_ * fmaxf(dacc[i], 0.f) : 0.f; t_ += dppf<0xB1>(t_); t_ += dppf<0x4E>(t_); v[i] = t_; }
          if (fr == 0) *(LAS f32x4*)(scr + pb * 16 + 4 * g) = v;
        }
        wave_lds_sync();
        const float sc = scr[lane];
        int rank = 0;
        for (int jj = 0; jj < c; ++jj) {
          const float sj = __uint_as_float(__builtin_amdgcn_readlane(__float_as_uint(sc), jj)); const int ij = __builtin_amdgcn_readlane(myidx, jj);
          rank += (sj > sc || (sj == sc && ij < myidx)) ? 1 : 0;
        }
        if (lane < c && (unsigned)rank < need) sel[ngt + rank] = (unsigned short)myidx;
        wave_lds_sync();
      }
      TS_ACC(52);
      if (rep_ == PROBE_REP_SELECT) {
#pragma unroll
        for (int i = 0; i < 4; ++i) hist[lane * 4 + i] = 0u;
      }
      if (lane == 0) nselp[qi] = TOPK;
      wave_lds_sync();
    }
  } else if (!is_meta) {
    for (int i = lane; i < 2 * 256; i += 64) { const int qi = 2 * wid + (i >> 8), s = i & 255; ((LAS unsigned short*)(lds + A_SEL))[qi * 256 + s] = (unsigned short)(s <= t0 + qi ? s : 0); }
    if (lane < 2) nselp[2 * wid + lane] = t0 + 2 * wid + lane + 1;
  } else {
    if (lane < 2) nselp[2 * wid + lane] = 0;
  }
  TS_ACC(34);
  wave_lds_sync();
  const LAS float* rb = (const LAS float*)(lds + A_RB);
  const LAS unsigned char* bkt = lds + A_BKT;
  f32x4 O[2][8];
  float linv[2];
  LAS unsigned char* gbuf = lds + A_BIG + wid * (2 * K16_STRIDE);
  const unsigned gbase_u = (unsigned)__builtin_amdgcn_readfirstlane((int)(unsigned)(size_t)gbuf);
  const unsigned gq = (lane & 15) >> 2, gp = lane & 3;
  for (int rep_ = 0; rep_ <= PROBE_REP_ATT; ++rep_)
#pragma unroll
  for (int qq = 0; qq < 2; ++qq) {
    const int qi = 2 * wid + qq; const int nsel = nselp[qi];
    const int epos = is_meta ? qi : NM + t0 + qi;
    const LAS unsigned short* sel = (const LAS unsigned short*)(lds + A_SEL + qi * 512);
#pragma unroll
    for (int ct = 0; ct < 8; ++ct) O[qq][ct] = (f32x4){0.f, 0.f, 0.f, 0.f};
    float mrun = -INFINITY, lrun = 0.f;
    const int nch = (nsel + 31) >> 5;
#define ISSUE_GATHER(ch_) do { const unsigned dst_ = gbase_u + (unsigned)(((ch_) & 1) * 8192); \
      int idxs_[8]; \
      _Pragma("unroll") for (int i_ = 0; i_ < 8; ++i_) { const int si_ = (ch_) * 32 + 4 * i_ + g; const int v_ = (int)sel[si_ < 255 ? si_ : 255]; idxs_[i_] = si_ < nsel ? v_ : 0; } \
      asm volatile("s_waitcnt lgkmcnt(0)" ::: "memory"); \
      _Pragma("unroll") for (int i_ = 0; i_ < 8; ++i_) { \
        const int row_ = 4 * i_ + g; const unsigned f_ = (((unsigned)row_ & 3u) << 2) | (((unsigned)row_ >> 2) & 3u); \
        const bf16_t* src_ = cNb + (size_t)idxs_[i_] * 128 + (((unsigned)fr ^ f_) * 8); \
        glds16_asm(src_, dst_ + (unsigned)(i_ * 1024)); } } while (0)
    if (nch > 0) ISSUE_GATHER(0);
    if (nch > 1) ISSUE_GATHER(1);
    {
      f32x4 s0 = (f32x4){0.f, 0.f, 0.f, 0.f};
#pragma unroll
      for (int ks = 0; ks < 4; ++ks) s0 = mfma16(*(const LAS bf16x8*)(lds + A_CM + off_b(fr, 4 * ks + g)), qf_[qq][ks], s0);
      float lg[4]; float mx = -INFINITY;
#pragma unroll
      for (int i = 0; i < 4; ++i) { const int m = 4 * g + i; const int dist = epos - m; const bool valid = !is_meta || m <= qi;
        const int dcl = dist < 0 ? 0 : (dist > 127 ? 127 : dist); const int bkv = (int)bkt[dcl]; const int bk = dist >= 128 ? 31 : bkv;
        const float bias = rb[bk * 8 + (fr & 7)]; const float lv = s0[i] * 0.125f + bias;
        lg[i] = valid ? lv : -INFINITY; mx = fmaxf(mx, lg[i]); }
      mx = rows_max(mx);
      mrun = mx; float ps = 0.f; float pv[4];
#pragma unroll
      for (int i = 0; i < 4; ++i) { pv[i] = __expf(lg[i] - mrun); ps += pv[i]; }
      ps = rows_sum(ps); lrun = ps;
      bf16x8 pf; { const unsigned a0 = pack_bf16(pv[0], pv[1]), a1 = pack_bf16(pv[2], pv[3]); u32x4 t; t.x = a0; t.y = a1; t.z = 0u; t.w = 0u; pf = __builtin_bit_cast(bf16x8, t); }
      {
        s16x4 tm[8];
#pragma unroll
        for (int ct = 0; ct < 8; ++ct) tm[ct] = lds_tr(lds + A_CM + off_b(4 * g + gq, 2 * ct + (gp >> 1)) + 8 * (gp & 1));
        const s16x4 z4 = (s16x4){0, 0, 0, 0};
#pragma unroll
        for (int ct = 0; ct < 8; ++ct) O[qq][ct] = mfma16(cat4(tm[ct], z4), pf, O[qq][ct]);
      }
    }
    for (int ch = 0; ch < nch; ++ch) {
      if (ch + 1 < nch) asm volatile("s_waitcnt vmcnt(8)" ::: "memory"); else asm volatile("s_waitcnt vmcnt(0)" ::: "memory");
      const LAS unsigned char* buf = gbuf + (ch & 1) * 8192;
      f32x4 sA = (f32x4){0.f, 0.f, 0.f, 0.f}, sB = (f32x4){0.f, 0.f, 0.f, 0.f};
#pragma unroll
      for (int ks = 0; ks < 4; ++ks) {
        sA = mfma16(*(const LAS bf16x8*)(buf + off_b(fr, 4 * ks + g)), qf_[qq][ks], sA);
        sB = mfma16(*(const LAS bf16x8*)(buf + off_b(fr + 16, 4 * ks + g)), qf_[qq][ks], sB);
      }
      const u16x4 iA = *(const LAS u16x4*)(sel + ch * 32 + 4 * g); const u16x4 iB = *(const LAS u16x4*)(sel + ch * 32 + 16 + 4 * g);
      float lg[8]; float mx = -INFINITY;
#pragma unroll
      for (int i = 0; i < 8; ++i) {
        const int slot = ch * 32 + (i < 4 ? 4 * g + i : 16 + 4 * g + (i - 4)); const int kidx = i < 4 ? (int)iA[i] : (int)iB[i - 4];
        const int dist = t0 + qi - kidx; const int dcl = dist < 0 ? 0 : (dist > 127 ? 127 : dist); const int bkv = (int)bkt[dcl]; const int bk = dist >= 128 ? 31 : bkv;
        const float sv = i < 4 ? sA[i] : sB[i - 4];
        const float bias = rb[bk * 8 + (fr & 7)]; const float lv = sv * 0.125f + bias;
        lg[i] = slot < nsel ? lv : -INFINITY; mx = fmaxf(mx, lg[i]);
      }
      mx = rows_max(mx);
      const float mnew = fmaxf(mrun, mx); const float alpha = __expf(mrun - mnew); mrun = mnew;
      float pv[8]; float ps = 0.f;
#pragma unroll
      for (int i = 0; i < 8; ++i) { pv[i] = __expf(lg[i] - mnew); ps += pv[i]; }
      ps = rows_sum(ps); lrun = lrun * alpha + ps;
#pragma unroll
      for (int ct = 0; ct < 8; ++ct) O[qq][ct] *= alpha;
      bf16x8 pf; { u32x4 t; t.x = pack_bf16(pv[0], pv[1]); t.y = pack_bf16(pv[2], pv[3]); t.z = pack_bf16(pv[4], pv[5]); t.w = pack_bf16(pv[6], pv[7]); pf = __builtin_bit_cast(bf16x8, t); }
      {
        s16x4 ta[8], tb[8];
#pragma unroll
        for (int ct = 0; ct < 8; ++ct) { ta[ct] = lds_tr(buf + off_b(4 * g + gq, 2 * ct + (gp >> 1)) + 8 * (gp & 1)); tb[ct] = lds_tr(buf + off_b(16 + 4 * g + gq, 2 * ct + (gp >> 1)) + 8 * (gp & 1)); }
#pragma unroll
        for (int ct = 0; ct < 8; ++ct) O[qq][ct] = mfma16(cat4(ta[ct], tb[ct]), pf, O[qq][ct]);
      }
      if (ch + 2 < nch) ISSUE_GATHER(ch + 2);
    }
    linv[qq] = 1.0f / lrun;
  }
  TS_ACC(37);
  asm volatile("s_waitcnt vmcnt(0) lgkmcnt(0)" ::: "memory");
#pragma unroll
  for (int qq = 0; qq < 2; ++qq)
    if (fr < 8) {
#pragma unroll
      for (int ct = 0; ct < 8; ++ct) { const f32x4 o = O[qq][ct] * linv[qq]; u32x2 w2; w2.x = pack_bf16(o[0], o[1]); w2.y = pack_bf16(o[2], o[3]);
        *(LAS u32x2*)(gbuf + qq * 2048 + (fr * 128 + ct * 16 + 4 * g) * 2) = w2; }
    }
  bf16x8 wvf[4][4]; u32x2 gtv[4];
  const bf16_t* wv = wuvT + ((size_t)wid * 64 + fr) * 128 + g * 8;
  bf16_t* grow = (is_meta ? p.gatesm : p.gates) + (r0 + fr) * 1024 + wid * 64 + 4 * g;
#pragma unroll
  for (int nt = 0; nt < 4; ++nt) {
#pragma unroll
    for (int ks = 0; ks < 4; ++ks) wvf[nt][ks] = *(const bf16x8*)(wv + (size_t)nt * 16 * 128 + ks * 32);
    gtv[nt] = *(const u32x2*)(grow + nt * 16);
  }
  __syncthreads();
  TS_ACC(38);
  {
    bf16x8 bo[4];
#pragma unroll
    for (int ks = 0; ks < 4; ++ks) bo[ks] = *(const LAS bf16x8*)(lds + A_BIG + (fr >> 1) * (2 * K16_STRIDE) + (fr & 1) * 2048 + (wid * 128 + ks * 32 + g * 8) * 2);
#pragma unroll
    for (int nt = 0; nt < 4; ++nt) {
      f32x4 a = (f32x4){0.f, 0.f, 0.f, 0.f};
#pragma unroll
      for (int ks = 0; ks < 4; ++ks) a = mfma16(wvf[nt][ks], bo[ks], a);
      const u32x2 gt = gtv[nt];
      const float g0 = __uint_as_float(gt.x << 16), g1 = __uint_as_float(gt.x & 0xffff0000u), g2 = __uint_as_float(gt.y << 16), g3 = __uint_as_float(gt.y & 0xffff0000u);
      u32x2 w2; w2.x = pack_bf16(a[0] * g0, a[1] * g1); w2.y = pack_bf16(a[2] * g2, a[3] * g3);
      *(u32x2*)((dry ? p.dummy + (r0 + fr) * 1024 + wid * 64 + 4 * g : grow) + nt * 16) = w2;
    }
  }
  __syncthreads();
  TS_ACC(39);
}

__device__ __forceinline__ void phase_attn(const Params& p, int layer, LAS unsigned char* lds, int ablk, int nablk, bool do_meta, const bool dry = false) {
  int tid_ = threadIdx.x; asm volatile("" : "+v"(tid_));
  const int tid = tid_;
  if (tid < 256) { const int row = tid >> 4, ch = tid & 15; *(LAS u32x4*)(lds + A_CM + off_b(row, ch)) = *(const u32x4*)(p.cNm + row * 128 + ch * 8); }
  if (tid < 256) ((LAS float*)(lds + A_RB))[tid] = p.rel_bias[tid];
  if (tid < 128) (lds + A_BKT)[tid] = c_bucket[tid];
  for (int i = tid; i < 16 * 257; i += NTHREADS) ((LAS unsigned*)(lds + A_HIST))[i] = 0u;
  __syncthreads();
  const bf16_t* wukT = p.wukT + (size_t)layer * 8 * 128 * 64; const bf16_t* wuvT = p.wuvT + (size_t)layer * 8 * 64 * 128;
  if ((nablk & 7) == 0 && (gridDim.x & 7) == 0) {
    const int xb = blockIdx.x & 7, nper = nablk >> 3, rank = ablk >> 3;
    for (int k = 0;; ++k) {
      const int idx = k * nper + ((k & 1) ? nper - 1 - rank : rank);
      if (idx >= 256) break;
      attn_tile(p, layer, lds, false, xb, 255 - idx, wukT, wuvT, dry);
    }
  } else {
    for (int item = ablk; item < NB * 256; item += nablk) {
      const int j = 255 - item / NB, b = item % NB;
      attn_tile(p, layer, lds, false, b, j, wukT, wuvT, dry);
    }
  }
  if (do_meta && !dry && ablk == nablk - 1) attn_tile(p, layer, lds, true, 0, 0, wukT, wuvT);
}

constexpr int H_QT = 0, H_KH = 8192, H_KT = 16384, H_VV = 24576, H_DEC = 32768, H_PART = 32768 + 512, H_OT = 32768 + 512 + 1024;

__device__ __forceinline__ void phase_hgrn(const Params& p, const int layer, LAS unsigned char* lds, const int hblk, const bool dry = false) {
  int tid_ = threadIdx.x; asm volatile("" : "+v"(tid_));
  const int tid = tid_, wid = __builtin_amdgcn_readfirstlane(tid >> 6), lane = tid & 63, fr = lane & 15, g = lane >> 4;
  const int b = hblk >> 2, h = hblk & 3;
  const unsigned gq = (lane & 15) >> 2, gp = lane & 3;
  f32x4 Sacc[8];
#pragma unroll
  for (int kt = 0; kt < 8; ++kt) Sacc[kt] = (f32x4){0.f, 0.f, 0.f, 0.f};
  const int sk = wid * 16 + (lane & 15), stg = lane >> 4;
  const int vrow = tid >> 4, vch = tid & 15;
  const int otok[2] = {4 * g, 16 + 4 * g};
  float n_gv[8]; unsigned short n_q[8]; u32x4 n_v; u32x4 n_gate;
  const int ot = tid >> 4, ov0 = (tid & 15) * 8;
  float gnv[8];
#pragma unroll
  for (int j = 0; j < 8; ++j) gnv[j] = p.hng[layer * 128 + ov0 + j];
  {
#pragma unroll
    for (int i = 0; i < 8; ++i) {
      const int t = 8 * stg + i;
      n_gv[i] = t < NM ? p.glm[(size_t)t * 512 + h * 128 + sk] : 0.f;
      n_q[i] = t < NM ? p.qfm[(size_t)t * 512 + h * 128 + sk] : (unsigned short)0;
    }
    n_v = vrow < NM ? *(const u32x4*)(p.vvm + (size_t)vrow * 512 + h * 128 + vch * 8) : (u32x4){0u, 0u, 0u, 0u};
    n_gate = ot < NM ? *(const u32x4*)(p.gatesm + (size_t)ot * 1024 + 512 + h * 128 + ov0) : (u32x4){0u, 0u, 0u, 0u};
  }
  for (int step = 0; step <= S / 32; ++step) {
    const bool im = step == 0;
    const size_t rbase = im ? 0 : (size_t)b * S + (size_t)(step - 1) * 32;
    bf16_t* gt = (im ? p.gatesm : p.gates) + rbase * 1024 + 512 + h * 128;
    TS_ACC_BEGIN();
    float gv[8], qv[8];
#pragma unroll
    for (int i = 0; i < 8; ++i) { gv[i] = n_gv[i]; qv[i] = bf2f(n_q[i]); }
    const u32x4 vraw = n_v;
    const u32x4 gate = n_gate;
    if (step < S / 32) {
      const size_t rn = (size_t)b * S + (size_t)step * 32;
#pragma unroll
      for (int i = 0; i < 8; ++i) { n_gv[i] = p.gl[(rn + 8 * stg + i) * 512 + h * 128 + sk]; n_q[i] = p.qf[(rn + 8 * stg + i) * 512 + h * 128 + sk]; }
      n_v = *(const u32x4*)(p.vv + (rn + vrow) * 512 + h * 128 + vch * 8);
      n_gate = *(const u32x4*)(p.gates + (rn + ot) * 1024 + 512 + h * 128 + ov0);
    }
    {
      float bc[8]; bc[0] = gv[0];
#pragma unroll
      for (int i = 1; i < 8; ++i) bc[i] = bc[i - 1] + gv[i];
      float x = bc[7];
      { const float u = __shfl_up(x, 16); if (lane >= 16) x += u; }
      { const float u = __shfl_up(x, 32); if (lane >= 32) x += u; }
      const float ex = x - bc[7];
      const float bl = __shfl(x, 48 + (lane & 15));
      const float dec_ = __expf(bl);
      float Er = __expf(ex);
#pragma unroll
      for (int i = 0; i < 8; ++i) {
        const float f = __expf(gv[i]);
        Er *= f;
        const float kc = 1.0f - f;
        const float qt = qv[i] * Er, khv = kc * fminf(__builtin_amdgcn_rcpf(Er), 5.5e34f), ktv = khv * dec_;
        const unsigned o1 = off_b(8 * stg + i, sk >> 3) + (sk & 7) * 2;
        *(LAS unsigned short*)(lds + H_QT + o1) = f2bf_fast(qt); *(LAS unsigned short*)(lds + H_KH + o1) = f2bf_fast(khv); *(LAS unsigned short*)(lds + H_KT + o1) = f2bf_fast(ktv);
      }
      if (stg == 3) *(LAS float*)(lds + H_DEC + sk * 4) = dec_;
      *(LAS u32x4*)(lds + H_VV + off_b(vrow, vch)) = vraw;
    }
    TS_ACC(40);
    __syncthreads();
    TS_ACC(41);
    f32x4 o[2] = {(f32x4){0.f, 0.f, 0.f, 0.f}, (f32x4){0.f, 0.f, 0.f, 0.f}};
    {
      f32x4 s00 = (f32x4){0.f, 0.f, 0.f, 0.f}, s01 = s00, s11 = s00;
      {
        bf16x8 aK0[4], aK1[4], aQ0[4], aQ1[4];
#pragma unroll
        for (int ks = 0; ks < 4; ++ks) {
          aK0[ks] = *(const LAS bf16x8*)(lds + H_KH + off_b(fr, 4 * ks + g)); aK1[ks] = *(const LAS bf16x8*)(lds + H_KH + off_b(16 + fr, 4 * ks + g));
          aQ0[ks] = *(const LAS bf16x8*)(lds + H_QT + off_b(fr, 4 * ks + g)); aQ1[ks] = *(const LAS bf16x8*)(lds + H_QT + off_b(16 + fr, 4 * ks + g));
        }
#pragma unroll
        for (int ks = 0; ks < 4; ++ks) { s00 = mfma16(aK0[ks], aQ0[ks], s00); s01 = mfma16(aK0[ks], aQ1[ks], s01); s11 = mfma16(aK1[ks], aQ1[ks], s11); }
      }
#pragma unroll
      for (int ks = 0; ks < 4; ++ks) {
        u32x4 bv; bv.x = pack_bf16(Sacc[2 * ks][0], Sacc[2 * ks][1]); bv.y = pack_bf16(Sacc[2 * ks][2], Sacc[2 * ks][3]);
        bv.z = pack_bf16(Sacc[2 * ks + 1][0], Sacc[2 * ks + 1][1]); bv.w = pack_bf16(Sacc[2 * ks + 1][2], Sacc[2 * ks + 1][3]);
#pragma unroll
        for (int mt = 0; mt < 2; ++mt) {
          const u32x2 a0 = *(const LAS u32x2*)(lds + H_QT + off_b(16 * mt + fr, 4 * ks + (g >> 1)) + (g & 1) * 8);
          const u32x2 a1 = *(const LAS u32x2*)(lds + H_QT + off_b(16 * mt + fr, 4 * ks + 2 + (g >> 1)) + (g & 1) * 8);
          u32x4 av; av.x = a0.x; av.y = a0.y; av.z = a1.x; av.w = a1.y;
          o[mt] = mfma16(__builtin_bit_cast(bf16x8, av), __builtin_bit_cast(bf16x8, bv), o[mt]);
        }
      }
      const s16x4 vt0 = lds_tr(lds + H_VV + off_b(4 * g + gq, 2 * wid + (gp >> 1)) + 8 * (gp & 1));
      const s16x4 vt1 = lds_tr(lds + H_VV + off_b(16 + 4 * g + gq, 2 * wid + (gp >> 1)) + 8 * (gp & 1));
      const bf16x8 bfv = cat4(vt0, vt1);
      {
        float m0[4], m1[4];
#pragma unroll
        for (int i = 0; i < 4; ++i) { const bool keep = (4 * g + i) <= fr; m0[i] = keep ? s00[i] : 0.f; m1[i] = keep ? s11[i] : 0.f; }
        u32x4 a0; a0.x = pack_bf16(m0[0], m0[1]); a0.y = pack_bf16(m0[2], m0[3]); a0.z = 0u; a0.w = 0u;
        u32x4 a1; a1.x = pack_bf16(s01[0], s01[1]); a1.y = pack_bf16(s01[2], s01[3]); a1.z = pack_bf16(m1[0], m1[1]); a1.w = pack_bf16(m1[2], m1[3]);
        o[0] = mfma16(__builtin_bit_cast(bf16x8, a0), bfv, o[0]);
        o[1] = mfma16(__builtin_bit_cast(bf16x8, a1), bfv, o[1]);
      }
#pragma unroll
      for (int kt = 0; kt < 8; ++kt) {
        const s16x4 k0 = lds_tr(lds + H_KT + off_b(4 * g + gq, 2 * kt + (gp >> 1)) + 8 * (gp & 1));
        const s16x4 k1 = lds_tr(lds + H_KT + off_b(16 + 4 * g + gq, 2 * kt + (gp >> 1)) + 8 * (gp & 1));
        const f32x4 dv = *(const LAS f32x4*)(lds + H_DEC + (16 * kt + 4 * g) * 4);
        Sacc[kt] = mfma16(cat4(k0, k1), bfv, Sacc[kt] * dv);
      }
    }
    {
#pragma unroll
      for (int mt = 0; mt < 2; ++mt) {
        f32x4 sq = o[mt] * o[mt];
#pragma unroll
        for (int i = 0; i < 4; ++i) sq[i] = row_sum16(sq[i]);
        if (fr == 0) *(LAS f32x4*)(lds + H_PART + (wid * 32 + otok[mt]) * 4) = sq;
#pragma unroll
        for (int i = 0; i < 4; ++i) *(LAS float*)(lds + H_OT + ((otok[mt] + i) * 128 + wid * 16 + fr) * 4) = o[mt][i];
      }
    }
    TS_ACC(42);
    __syncthreads();
    TS_ACC(43);
    if ((!im || (b == 0 && layer == 0)) && (!im || ot < NM)) {
      float tot = 0.f;
#pragma unroll
      for (int w = 0; w < 8; ++w) tot += *(const LAS float*)(lds + H_PART + (w * 32 + ot) * 4);
      const float rstd = rsqrtf(tot * (1.0f / 128.0f) + EPS);
      const f32x4 o0 = *(const LAS f32x4*)(lds + H_OT + (ot * 128 + ov0) * 4), o1 = *(const LAS f32x4*)(lds + H_OT + (ot * 128 + ov0 + 4) * 4);
      u32x4 w4;
      w4.x = pack_bf16(o0[0] * rstd * gnv[0] * __uint_as_float(gate.x << 16), o0[1] * rstd * gnv[1] * __uint_as_float(gate.x & 0xffff0000u));
      w4.y = pack_bf16(o0[2] * rstd * gnv[2] * __uint_as_float(gate.y << 16), o0[3] * rstd * gnv[3] * __uint_as_float(gate.y & 0xffff0000u));
      w4.z = pack_bf16(o1[0] * rstd * gnv[4] * __uint_as_float(gate.z << 16), o1[1] * rstd * gnv[5] * __uint_as_float(gate.z & 0xffff0000u));
      w4.w = pack_bf16(o1[2] * rstd * gnv[6] * __uint_as_float(gate.w << 16), o1[3] * rstd * gnv[7] * __uint_as_float(gate.w & 0xffff0000u));
      *(u32x4*)((dry ? p.dummy + rbase * 1024 + 512 + h * 128 : gt) + (size_t)ot * 1024 + ov0) = w4;
    }
    TS_ACC(44);
  }
}

constexpr int M_A32T = 0;
constexpr int M_PART = 65536;
template <bool A_BF16>
__device__ __forceinline__ void meta_group_gemm(LAS unsigned char* lds, const void* A, const float* W, const int ldw, const int col0) {
  int tid_ = threadIdx.x; asm volatile("" : "+v"(tid_));
  const int tid = tid_, wid = __builtin_amdgcn_readfirstlane(tid >> 6), lane = tid & 63;
  LAS float* a32 = (LAS float*)(lds + M_A32T); LAS float* part = (LAS float*)(lds + M_PART);
  for (int i = tid; i < 16 * 1024; i += NTHREADS) { const int r = i >> 10, k = i & 1023; a32[k * 16 + r] = A_BF16 ? bf2f(((const bf16_t*)A)[i]) : ((const float*)A)[i]; }
  __syncthreads();
  float acc0[16], acc1[16];
#pragma unroll
  for (int r = 0; r < 16; ++r) { acc0[r] = 0.f; acc1[r] = 0.f; }
  const float* w0p = W + (size_t)(wid * 128) * ldw + col0 + lane;
#pragma unroll 4
  for (int kk = 0; kk < 128; ++kk) {
    const float w0 = w0p[(size_t)kk * ldw], w1 = w0p[(size_t)kk * ldw + 64];
    const LAS f32x4* ar = (const LAS f32x4*)(a32 + (wid * 128 + kk) * 16);
#pragma unroll
    for (int q = 0; q < 4; ++q) { const f32x4 a = ar[q];
#pragma unroll
      for (int j = 0; j < 4; ++j) { acc0[q * 4 + j] = fmaf(a[j], w0, acc0[q * 4 + j]); acc1[q * 4 + j] = fmaf(a[j], w1, acc1[q * 4 + j]); } }
  }
#pragma unroll
  for (int r = 0; r < 16; ++r) { part[(wid * 16 + r) * 128 + lane] = acc0[r]; part[(wid * 16 + r) * 128 + 64 + lane] = acc1[r]; }
  __syncthreads();
  for (int i = tid; i < 2048; i += NTHREADS) { float s = 0.f;
#pragma unroll
    for (int w = 0; w < 8; ++w) s += part[w * 2048 + i]; part[i] = s; }
  __syncthreads();
}


template <bool A_F32, bool SPLIT>
__device__ __forceinline__ void meta_group_mfma(LAS unsigned char* lds, const void* A, const bf16_t* Wt, const int ldw) {
  int tid_ = threadIdx.x; asm volatile("" : "+v"(tid_));
  const int tid = tid_, wid = __builtin_amdgcn_readfirstlane(tid >> 6), lane = tid & 63, fr = lane & 15, g = lane >> 4;
  LAS float* out = (LAS float*)(lds + M_PART);
  const bf16_t* wrow = Wt + (size_t)(wid * 16 + fr) * ldw + g * 8;
  f32x4 acc = (f32x4){0.f, 0.f, 0.f, 0.f};
#pragma unroll 4
  for (int ks = 0; ks < 32; ++ks) {
    bf16x8 ah, al;
    if (A_F32) {
      const f32x4 v0 = *(const f32x4*)((const float*)A + fr * 1024 + ks * 32 + g * 8), v1 = *(const f32x4*)((const float*)A + fr * 1024 + ks * 32 + g * 8 + 4);
      u32x4 h; h.x = pack_bf16(v0[0], v0[1]); h.y = pack_bf16(v0[2], v0[3]); h.z = pack_bf16(v1[0], v1[1]); h.w = pack_bf16(v1[2], v1[3]);
      ah = __builtin_bit_cast(bf16x8, h);
      if (SPLIT) { u32x4 l; l.x = pack_bf16(v0[0] - __uint_as_float(h.x << 16), v0[1] - __uint_as_float(h.x & 0xffff0000u)); l.y = pack_bf16(v0[2] - __uint_as_float(h.y << 16), v0[3] - __uint_as_float(h.y & 0xffff0000u));
        l.z = pack_bf16(v1[0] - __uint_as_float(h.z << 16), v1[1] - __uint_as_float(h.z & 0xffff0000u)); l.w = pack_bf16(v1[2] - __uint_as_float(h.w << 16), v1[3] - __uint_as_float(h.w & 0xffff0000u));
        al = __builtin_bit_cast(bf16x8, l); }
    } else {
      ah = *(const bf16x8*)((const bf16_t*)A + fr * 1024 + ks * 32 + g * 8);
    }
    acc = mfma16(ah, *(const bf16x8*)(wrow + ks * 32), acc);
    if (SPLIT) { acc = mfma16(al, *(const bf16x8*)(wrow + 1024 + ks * 32), acc); acc = mfma16(ah, *(const bf16x8*)(wrow + 2048 + ks * 32), acc); }
  }
#pragma unroll
  for (int i = 0; i < 4; ++i) out[(4 * g + i) * 128 + wid * 16 + fr] = acc[i];
  __syncthreads();
}

__device__ __forceinline__ void meta_inproj_group(const Params& p, const int layer, LAS unsigned char* lds, const int grp) {
  int tid_ = threadIdx.x; asm volatile("" : "+v"(tid_)); const int tid = tid_;
  const float* A = layer == 0 ? p.meta : p.hFm;
  int kind, sub;
  if (grp < 4) { kind = 0; sub = grp; } else if (grp == 4) { kind = 6; sub = 0; } else { kind = 1 + (grp - 5) / 4; sub = (grp - 5) % 4; }
  const int colbase = (kind == 0 ? O_QA : kind == 6 ? O_CKV : kind == 1 ? O_GA : kind == 2 ? O_QH : kind == 3 ? O_FH : kind == 4 ? O_IH : O_GH) + sub * 128;
  (void)colbase;
  if (kind == 6) meta_group_mfma<true, IDX_SPLIT != 0>(lds, A, p.WsT + ((size_t)layer * 512 + 256) * 3072, 3072);
  else meta_group_mfma<true, false>(lds, A, p.WmT + ((size_t)layer * 3072 + (size_t)kind * 512 + sub * 128) * 1024, 1024);
  LAS float* out = (LAS float*)(lds + M_PART);
  LAS float* rs = (LAS float*)(lds + M_PART + 2048 * 4);
  if (kind == 6) {
    if (tid < 16) { float s = 0.f; for (int c = 0; c < 128; ++c) { const float v = out[tid * 128 + c]; s = fmaf(v, v, s); } rs[tid] = rsqrtf(s * (1.0f / 128.0f) + EPS); }
    __syncthreads();
  }
  for (int i = tid; i < 2048; i += NTHREADS) {
    const int r = i >> 7, c = i & 127, cc = sub * 128 + c; const float v = out[i];
    if (kind == 0) p.qam[r * 512 + cc] = f2bf(v);
    else if (kind == 6) p.cNm[r * 128 + c] = f2bf(v * rs[r] * p.kvg[layer * 128 + c]);
    else if (kind == 1) p.gatesm[r * 1024 + cc] = f2bf(fast_silu(v));
    else if (kind == 2) p.qfm[r * 512 + cc] = f2bf(fast_silu(v) * 0.08838834764831845f);
    else if (kind == 3) { const float lb = p.lbv[layer * 512 + cc]; p.glm[r * 512 + cc] = __logf(lb + (1.0f - lb) * fast_sigmoid(v)); }
    else if (kind == 4) p.vvm[r * 512 + cc] = f2bf(v);
    else p.gatesm[r * 1024 + 512 + cc] = f2bf(fast_silu(v));
  }
  __syncthreads();
}
__device__ __forceinline__ void meta_outproj_group(const Params& p, LAS unsigned char* lds, const int grp) {
  int tid_ = threadIdx.x; asm volatile("" : "+v"(tid_)); const int tid = tid_;
  meta_group_mfma<false, false>(lds, p.gatesm, p.WoT + (size_t)grp * 128 * 1024, 1024);
  const LAS float* out = (const LAS float*)(lds + M_PART);
  for (int i = tid; i < 2048; i += NTHREADS) { const int r = i >> 7, c = grp * 128 + (i & 127); p.vm[r * D + c] = DN_ALPHA * p.meta[r * D + c] + out[i]; }
  __syncthreads();
}
__device__ __forceinline__ void meta_ln(const Params& p) {
  int tid_ = threadIdx.x; asm volatile("" : "+v"(tid_)); const int tid = tid_, wid = tid >> 6, lane = tid & 63;
  for (int row = wid; row < NM; row += 8) {
    f32x4 v[4]; float s = 0.f;
#pragma unroll
    for (int i = 0; i < 4; ++i) { v[i] = *(const f32x4*)(p.vm + row * D + (i * 64 + lane) * 4); s += (v[i][0] + v[i][1]) + (v[i][2] + v[i][3]); }
#pragma unroll
    for (int o = 32; o > 0; o >>= 1) s += __shfl_xor(s, o);
    const float mean = s * (1.0f / D); float q = 0.f;
#pragma unroll
    for (int i = 0; i < 4; ++i) { const f32x4 d = v[i] - mean; q += (d[0] * d[0] + d[1] * d[1]) + (d[2] * d[2] + d[3] * d[3]); }
#pragma unroll
    for (int o = 32; o > 0; o >>= 1) q += __shfl_xor(q, o);
    const float rstd = rsqrtf(q * (1.0f / D) + EPS);
#pragma unroll
    for (int i = 0; i < 4; ++i) { const int c = (i * 64 + lane) * 4; *(f32x4*)(p.hFm + row * D + c) = (v[i] - mean) * rstd * *(const f32x4*)(p.ln_g + c) + *(const f32x4*)(p.ln_b + c); }
  }
}


#define XB_TMO      128
#define XB_XCNT(j)  (256  + 64 * (j))
#define XB_XSUB(j)  (1280 + 64 * (j))
#define XB_XGEN(j)  (2304 + 64 * (j))
#define XB_TOP      3328
#define XB_TOPGEN   3392
#define XCD_BAR_WORDS 3456
#define XB_SPIN_CAP (1u << 20)
__device__ __forceinline__ unsigned xb_ld(unsigned* p)              { return __hip_atomic_load(p, __ATOMIC_RELAXED, __HIP_MEMORY_SCOPE_AGENT); }
__device__ __forceinline__ unsigned xb_add(unsigned* p, unsigned v) { return __hip_atomic_fetch_add(p, v, __ATOMIC_RELAXED, __HIP_MEMORY_SCOPE_AGENT); }
__device__ __forceinline__ unsigned xb_xcc_id() { return (unsigned)__builtin_amdgcn_s_getreg((3 << 11) | 20) & 0xFu; }
#define XB_SPIN(cond, bar) do { unsigned _sp = 0; while (cond) { __builtin_amdgcn_s_sleep(1); \
    if ((++_sp & 255u) == 0u) { if (xb_ld(&(bar)[XB_TMO])) break; if (_sp > XB_SPIN_CAP) { atomicAdd(&(bar)[XB_TMO], 1u); break; } } } } while (0)
struct XcdBarrier { unsigned* bar; unsigned x; volatile LAS unsigned* st; };
__device__ __forceinline__ XcdBarrier xcd_barrier_post(unsigned* bar, volatile LAS unsigned* st) {
  XcdBarrier b; b.bar = bar; b.x = xb_xcc_id(); b.st = st;
  if (threadIdx.x == 0) (void)xb_add(&bar[XB_XCNT(b.x)], 1u);
  return b;
}
__device__ __forceinline__ void xcd_barrier_complete(unsigned* bar, unsigned x, unsigned& nloc, unsigned& nx) {
  const unsigned G = gridDim.x * gridDim.y * gridDim.z;
  unsigned sum, cnt, mine, sp = 0u;
  for (;;) {
    sum = 0u; cnt = 0u; mine = 0u;
#pragma unroll
    for (unsigned j = 0; j < 16; ++j) { const unsigned c = xb_ld(&bar[XB_XCNT(j)]); sum += c; cnt += (c > 0u) ? 1u : 0u; mine = (j == x) ? c : mine; }
    if (sum == G) break;
    __builtin_amdgcn_s_sleep(1);
    if ((++sp & 255u) == 0u) { if (xb_ld(&bar[XB_TMO])) break; if (sp > XB_SPIN_CAP) { atomicAdd(&bar[XB_TMO], 1u); break; } }
  }
  nloc = mine > 0u ? mine : 1u; nx = cnt > 0u ? cnt : 1u;
}
__device__ __forceinline__ void xcd_barrier(const XcdBarrier& b) {
  asm volatile("s_waitcnt vmcnt(0)" ::: "memory");
  __syncthreads();
  if (threadIdx.x == 0) {
    unsigned* bar = b.bar;
    __builtin_amdgcn_s_waitcnt(0);
    unsigned nloc = b.st[0], nx = b.st[1];
    if (nloc == 0u) { xcd_barrier_complete(bar, b.x, nloc, nx); b.st[0] = nloc; b.st[1] = nx; }
    const unsigned old = xb_add(&bar[XB_XSUB(b.x)], 1u);
    const unsigned gen = old / nloc;
    if (old + 1u == (gen + 1u) * nloc) {
      __builtin_amdgcn_fence(__ATOMIC_RELEASE, "agent");
      asm volatile("s_waitcnt vmcnt(0)" ::: "memory");
      const unsigned og = xb_add(&bar[XB_TOP], 1u);
      const unsigned tg = og / nx;
      if (og + 1u == (tg + 1u) * nx) xb_add(&bar[XB_TOPGEN], 1u);
      else XB_SPIN(xb_ld(&bar[XB_TOPGEN]) == tg, bar);
      __builtin_amdgcn_fence(__ATOMIC_ACQUIRE, "agent");
      xb_add(&bar[XB_XGEN(b.x)], 1u);
      asm volatile("s_waitcnt vmcnt(0)" ::: "memory");
    } else {
      XB_SPIN(xb_ld(&bar[XB_XGEN(b.x)]) == gen, bar);
      __builtin_amdgcn_fence(__ATOMIC_ACQUIRE, "agent");
      asm volatile("s_waitcnt vmcnt(0)" ::: "memory");
    }
  }
  __syncthreads();
}

constexpr int N_HGRN_BLOCKS = NB * 4;
#ifndef PROBE_REP_PREP
#define PROBE_REP_PREP 0
#endif
#ifndef PROBE_REP_P1
#define PROBE_REP_P1 0
#endif
#ifndef PROBE_REP_P3
#define PROBE_REP_P3 0
#endif
#ifndef PROBE_DRY
#define PROBE_DRY 0
#endif
#ifndef PROBE_SYNC
#define PROBE_SYNC 0
#endif
__global__ void __launch_bounds__(NTHREADS, 2) k_mega(Params p) {
  extern __shared__ __attribute__((aligned(16))) unsigned char smem[];
  LAS unsigned char* lds = (LAS unsigned char*)smem;
  cooperative_groups::grid_group grid = cooperative_groups::this_grid();
  const int bid = blockIdx.x, G = gridDim.x;
  if (threadIdx.x < 4) ((LAS unsigned*)(lds + LDS_BYTES - 16))[threadIdx.x] = 0u;
  __syncthreads();
  const XcdBarrier xbar = xcd_barrier_post(p.bar, (volatile LAS unsigned*)(lds + LDS_BYTES - 16));
#define GRID_BAR() xcd_barrier(xbar)
  if (TPROBE) { for (int i = threadIdx.x; i < 64; i += NTHREADS) p.ts[(size_t)blockIdx.x * 64 + i] = 0ull; __syncthreads(); }
  TS_MARK(0);
  for (int i = 0; i < PROBE_SYNC; ++i) grid.sync();
  for (int i = 0; i < PROBE_REP_PREP; ++i) { phase_prep(p, lds); __syncthreads(); }
  phase_prep(p, lds);
  __syncthreads();
  TS_MARK(1); grid.sync(); TS_MARK(2);
#pragma unroll
  for (int layer = 0; layer < DEPTH; ++layer) {
    if (bid < 25) meta_inproj_group(p, layer, lds, bid);
    {
      SrcP1 Sp{(const char*)p.hHi, (const char*)p.hLo, (const char*)(p.WmT + (size_t)layer * 3072 * 1024), (const char*)(p.WsT + (size_t)layer * 512 * 3072)};
      EpiP1 E{p, layer};
      for (int i = 0; i < PROBE_REP_P1; ++i) gemm_phase<SrcP1, EpiP1>(lds, Sp, R / BM, 14, E);
      gemm_phase<SrcP1, EpiP1>(lds, Sp, R / BM, 14, E);
    }
    TS_MARK(3 + 8 * layer); GRID_BAR(); TS_MARK(4 + 8 * layer);
    if (PROBE_DRY) {
      if (bid < N_HGRN_BLOCKS) { if (PROBE_DRY != 2) phase_hgrn(p, layer, lds, bid, true); }
      else { if (PROBE_DRY != 3) phase_attn(p, layer, lds, bid - N_HGRN_BLOCKS, G - N_HGRN_BLOCKS, layer == 0, true); }
      grid.sync();
    }
    if (bid < N_HGRN_BLOCKS) phase_hgrn(p, layer, lds, bid);
    else phase_attn(p, layer, lds, bid - N_HGRN_BLOCKS, G - N_HGRN_BLOCKS, layer == 0);
    TS_MARK(5 + 8 * layer); GRID_BAR(); TS_MARK(6 + 8 * layer);
    if (layer == 0 && bid < 8) meta_outproj_group(p, lds, bid);
    {
      SrcP3 Sp{(const char*)p.gates, (const char*)(p.WoT + (size_t)layer * 1024 * 1024)};
      EpiP3 E{p, layer == 0 ? p.x : p.hF};
      if (layer == 0) for (int i = 0; i < PROBE_REP_P3; ++i) gemm_phase<SrcP3, EpiP3>(lds, Sp, R / BM, 4, E);
      gemm_phase<SrcP3, EpiP3>(lds, Sp, R / BM, 4, E);
    }
    TS_MARK(7 + 8 * layer); GRID_BAR(); TS_MARK(8 + 8 * layer);
    if (layer == 0) { phase_ln(p, 0, p.hF, true); if (bid == G - 1) meta_ln(p); TS_MARK(9); GRID_BAR(); TS_MARK(10); }
    else { phase_ln(p, 1, p.out, false); TS_MARK(17); }
  }
  if (TPROBE) {
    grid.sync();
    if (bid == 0 && threadIdx.x < 64) {
      unsigned long long mx = 0;
      for (int b2 = TP_LO + (int)threadIdx.x; b2 < TP_HI; b2 += 64) { const unsigned long long e_ = __hip_atomic_load(p.ts + (size_t)b2 * 64 + TP_E, __ATOMIC_RELAXED, __HIP_MEMORY_SCOPE_AGENT), s_ = __hip_atomic_load(p.ts + (size_t)b2 * 64 + TP_S, __ATOMIC_RELAXED, __HIP_MEMORY_SCOPE_AGENT); const unsigned long long d = TPROBE == 2 ? e_ : e_ - s_; mx = d > mx ? d : mx; }
      for (int o = 32; o > 0; o >>= 1) { const unsigned long long v = __shfl_xor(mx, o); mx = v > mx ? v : mx; }
      if (threadIdx.x == 0) p.out[0] += (float)mx * 0.0001f;
    }
  }
}

}

extern "C" void kernel_launch(void* const* d_in, const int* in_sizes, int n_in, void* d_out, int out_size, void* d_ws, size_t ws_size,
                              hipStream_t stream) {
  Params p{};
  p.x = (const float*)d_in[0]; p.meta = (const float*)d_in[1]; p.rel_bias = (const float*)d_in[2]; p.lbraw = (const float*)d_in[3];
  p.w_in = (const float*)d_in[4]; p.kvg = (const float*)d_in[5]; p.w_uk = (const float*)d_in[6]; p.w_uv = (const float*)d_in[7];
  p.hng = (const float*)d_in[8]; p.w_out = (const float*)d_in[9]; p.ln_g = (const float*)d_in[10]; p.ln_b = (const float*)d_in[11];
  p.out = (float*)d_out;
  char* w = (char*)d_ws; size_t off = 0;
  auto take = [&](size_t bytes) { char* q = w + off; off += (bytes + 255) & ~(size_t)255; return q; };
  p.hF = (float*)take((size_t)R * D * 4); p.hFm = (float*)take((size_t)NM * D * 4);
  p.hHi = (bf16_t*)take((size_t)R * D * 2); p.hHim = (bf16_t*)take((size_t)NM * D * 2);
  p.hLo = (bf16_t*)take((size_t)R * D * 2); p.hLom = (bf16_t*)take((size_t)NM * D * 2);
  p.qa = (bf16_t*)take((size_t)R * 512 * 2); p.qam = (bf16_t*)take((size_t)NM * 512 * 2);
  p.cN = (bf16_t*)take((size_t)R * 128 * 2); p.cNm = (bf16_t*)take((size_t)NM * 128 * 2);
  p.gates = (bf16_t*)take((size_t)R * 1024 * 2); p.gatesm = (bf16_t*)take((size_t)NM * 1024 * 2);
  p.qfm = (bf16_t*)take((size_t)NM * 512 * 2); p.glm = (float*)take((size_t)NM * 512 * 4); p.vvm = (bf16_t*)take((size_t)NM * 512 * 2);
  p.qiH = (bf16_t*)take((size_t)R * 256 * 2); p.qiL = (bf16_t*)take((size_t)R * 256 * 2);
  p.kiH = (bf16_t*)take((size_t)R * 64 * 2); p.kiL = (bf16_t*)take((size_t)R * 64 * 2);
  p.wi = (float*)take((size_t)R * 4 * 4);
  p.sel = (int*)take(256); p.nsel = (int*)take(256);
  p.proj = (float*)take((size_t)NM * NIN * 4);
  p.ych = (float*)take((size_t)NM * D * 4);
  p.WmT = (bf16_t*)take((size_t)DEPTH * 3072 * 1024 * 2); p.WsT = (bf16_t*)take((size_t)DEPTH * 512 * 3072 * 2); p.WoT = (bf16_t*)take((size_t)DEPTH * 1024 * 1024 * 2);
  p.lbv = (float*)take((size_t)DEPTH * 512 * 4);
  p.stats = (float*)take((size_t)R * 16 * 2 * 4); p.statsm = (float*)take(256);
  p.vm = (float*)take((size_t)NM * D * 4);
  p.dummy = (bf16_t*)take((size_t)(R + NM) * 1024 * 2);
  p.bar = (unsigned*)take(XCD_BAR_WORDS * 4);
  p.ts = (unsigned long long*)take(256 * 64 * 8);
  p.wukT = (bf16_t*)take((size_t)DEPTH * 8 * 128 * 64 * 2); p.wuvT = (bf16_t*)take((size_t)DEPTH * 8 * 64 * 128 * 2);
  if (off > ws_size) return;
  p.gl = (float*)d_out; p.qf = (bf16_t*)((char*)d_out + (size_t)R * 512 * 4); p.vv = (bf16_t*)((char*)d_out + (size_t)R * 512 * 4 + (size_t)R * 512 * 2);

  static int grid_blocks = 0;
  if (!grid_blocks) {
    (void)hipFuncSetAttribute((const void*)k_mega, hipFuncAttributeMaxDynamicSharedMemorySize, LDS_BYTES);
    int dev = 0, cus = 0, per_cu = 0;
    (void)hipGetDevice(&dev);
    (void)hipDeviceGetAttribute(&cus, hipDeviceAttributeMultiprocessorCount, dev);
    (void)hipOccupancyMaxActiveBlocksPerMultiprocessor(&per_cu, (const void*)k_mega, NTHREADS, LDS_BYTES);
    grid_blocks = per_cu >= 1 ? cus : 0;
    if (grid_blocks > 256) grid_blocks = 256;
  }
  if (grid_blocks < 64) return;
  (void)hipMemsetAsync(p.bar, 0, XCD_BAR_WORDS * 4, stream);
  void* args[] = {(void*)&p};
  (void)hipLaunchCooperativeKernel((const void*)k_mega, dim3(grid_blocks), dim3(NTHREADS), args, LDS_BYTES, stream);
}
```
